# Optimizing an MI355X kernel written in HIP

```python
import math
import jax, jax.numpy as jnp
from jax import lax
import numpy as np

D_MODEL = 2048
BATCH = 1
SEQ = 8192
DEPTH = 1

BRANCH_WIDTH = 1024
N_BRANCH = 3
A_HEADS = 8
A_KV_HEADS = 2
A_HEAD_DIM = 128
A_WIDTH = A_HEADS * A_HEAD_DIM
IDX_HEADS = 16
IDX_DIM = 64
TOPK_MAX = 256
IDX_SCALE = (IDX_DIM ** -0.5) * (IDX_HEADS ** -0.5)
A_SCALE = A_HEAD_DIM ** -0.5
B_HEADS = 8
B_Q_RANK = 512
B_KV_RANK = 256
B_NOPE = 128
B_ROPE = 64
B_QK_DIM = B_NOPE + B_ROPE
B_V = 128
B_WIDTH = B_HEADS * B_V
B_SCALE = B_QK_DIM ** -0.5
ROPE_THETA = 10000.0
N_MEM = 256
C_HEADS = 4
C_HEAD_DIM = 256
C_WIDTH = C_HEADS * C_HEAD_DIM
C_SCALE = C_HEAD_DIM ** -0.5
REL_BUCKETS = 32
REL_MAX_DIST = 128
Q_BLOCK = 128
EPS = 1e-6

IN_SIZES = (
    A_WIDTH,
    A_KV_HEADS * A_HEAD_DIM,
    A_KV_HEADS * A_HEAD_DIM,
    A_WIDTH,
    IDX_HEADS * IDX_DIM,
    IDX_DIM,
    IDX_HEADS,
    B_Q_RANK,
    B_KV_RANK,
    B_ROPE,
    B_WIDTH,
    C_WIDTH,
    C_WIDTH,
    N_BRANCH * D_MODEL,
)
IN_WIDTH = int(sum(IN_SIZES))
IN_OFFSETS = [int(o) for o in np.cumsum(IN_SIZES)[:-1]]

kernel_name = "hybrid_dsa_mla_memory_gated_block"


def rms_norm(x, g):
    x32 = x.astype(jnp.float32)
    y = x32 * lax.rsqrt(jnp.mean(x32 * x32, axis=-1, keepdims=True) + EPS)
    return (y * g.astype(jnp.float32)).astype(x.dtype)


def apply_rope(x, cos, sin):
    x32 = x.astype(jnp.float32)
    half = x.shape[-1] // 2
    x1, x2 = x32[..., :half], x32[..., half:]
    return jnp.concatenate([x1 * cos - x2 * sin, x2 * cos + x1 * sin], axis=-1).astype(x.dtype)


def t5_bucket(dist):
    n = jnp.maximum(dist, 0)
    max_exact = REL_BUCKETS // 2
    nf = jnp.maximum(n, 1).astype(jnp.float32)
    large = max_exact + (jnp.log(nf / max_exact) / math.log(REL_MAX_DIST / max_exact)
                         * (REL_BUCKETS - max_exact)).astype(jnp.int32)
    large = jnp.minimum(large, REL_BUCKETS - 1)
    return jnp.where(n < max_exact, n, large)


_gather_rows = jax.vmap(lambda a, i: a[i])


def dsa_attention(q, k, v, q_idx, k_idx, w_idx, pos, rel_table):
    bsz, seq = q.shape[0], q.shape[1]
    topk = min(TOPK_MAX, seq // 4)
    n_blocks = seq // Q_BLOCK
    rep = A_HEADS // A_KV_HEADS
    key_ids = jnp.arange(seq)
    k_idx32 = k_idx.astype(jnp.float32)

    def block(i):
        start = i * Q_BLOCK
        qi = lax.dynamic_slice_in_dim(q_idx, start, Q_BLOCK, axis=1).astype(jnp.float32)
        wi = lax.dynamic_slice_in_dim(w_idx, start, Q_BLOCK, axis=1).astype(jnp.float32)
        qb = lax.dynamic_slice_in_dim(q, start, Q_BLOCK, axis=1)
        pq = lax.dynamic_slice_in_dim(pos, start, Q_BLOCK, axis=1)
        t_ids = start + jnp.arange(Q_BLOCK)
        causal = key_ids[None, :] <= t_ids[:, None]
        dots = jnp.einsum('bthd,bsd->bths', qi, k_idx32)
        score = jnp.einsum('bths,bth->bts', jax.nn.relu(dots), wi) * IDX_SCALE
        score = jnp.where(causal[None], score, -jnp.inf)
        _, sel = lax.top_k(score, topk)
        kg = _gather_rows(k, sel)
        vg = _gather_rows(v, sel)
        pk = _gather_rows(pos, sel)
        qg = qb.reshape(bsz, Q_BLOCK, A_KV_HEADS, rep, A_HEAD_DIM)
        logits = jnp.einsum('btgrd,btkgd->btgrk', qg, kg).astype(jnp.float32) * A_SCALE
        bias = rel_table[t5_bucket(pq[:, :, None] - pk)].astype(jnp.float32)
        bias = bias.reshape(bsz, Q_BLOCK, topk, A_KV_HEADS, rep).transpose(0, 1, 3, 4, 2)
        valid = sel <= t_ids[None, :, None]
        logits = jnp.where(valid[:, :, None, None, :], logits + bias, -jnp.inf)
        p = jax.nn.softmax(logits, axis=-1).astype(v.dtype)
        o = jnp.einsum('btgrk,btkgd->btgrd', p, vg)
        return o.reshape(bsz, Q_BLOCK, A_HEADS, A_HEAD_DIM)

    out = lax.map(block, jnp.arange(n_blocks))
    return jnp.moveaxis(out, 0, 1).reshape(bsz, seq, A_HEADS, A_HEAD_DIM)


def mla_attention(q, k, v):
    bsz, seq = q.shape[0], q.shape[1]
    n_blocks = seq // Q_BLOCK
    key_ids = jnp.arange(seq)

    def block(i):
        start = i * Q_BLOCK
        qb = lax.dynamic_slice_in_dim(q, start, Q_BLOCK, axis=1)
        logits = jnp.einsum('bthd,bshd->bhts', qb, k).astype(jnp.float32) * B_SCALE
        causal = key_ids[None, :] <= (start + jnp.arange(Q_BLOCK))[:, None]
        logits = jnp.where(causal, logits, -jnp.inf)
        p = jax.nn.softmax(logits, axis=-1).astype(v.dtype)
        return jnp.einsum('bhts,bshd->bthd', p, v)

    out = lax.map(block, jnp.arange(n_blocks))
    return jnp.moveaxis(out, 0, 1).reshape(bsz, seq, q.shape[2], v.shape[-1])


def memory_attention(q, k, v):
    logits = jnp.einsum('bshd,bmhd->bhsm', q, k).astype(jnp.float32) * C_SCALE
    p = jax.nn.softmax(logits, axis=-1).astype(v.dtype)
    return jnp.einsum('bhsm,bmhd->bshd', p, v)


def setup_inputs(seed: int = 0) -> dict:
    key = jax.random.key(seed)
    ks = jax.random.split(key, 24)
    f32 = jnp.float32

    def nrm(k, shape, fan_in):
        return jax.random.normal(k, shape, f32) * (fan_in ** -0.5)

    def gain(k, shape):
        return 1.0 + 0.02 * jax.random.normal(k, shape, f32)

    x = jax.random.normal(ks[0], (BATCH, SEQ, D_MODEL), f32)
    mem = jax.random.normal(ks[1], (BATCH, N_MEM, D_MODEL), f32)
    positions = jnp.broadcast_to(jnp.arange(SEQ, dtype=jnp.int32)[None, :], (BATCH, SEQ))
    rel_bias = 0.5 * jax.random.normal(ks[2], (REL_BUCKETS, A_HEADS), f32)
    return {
        "x": x,
        "mem": mem,
        "positions": positions,
        "rel_bias": rel_bias,
        "norm_g": gain(ks[3], (DEPTH, D_MODEL)),
        "mem_norm_g": gain(ks[4], (DEPTH, D_MODEL)),
        "w_in": nrm(ks[5], (DEPTH, D_MODEL, IN_WIDTH), D_MODEL),
        "a_q_norm_g": gain(ks[6], (DEPTH, A_HEAD_DIM)),
        "a_k_norm_g": gain(ks[7], (DEPTH, A_HEAD_DIM)),
        "b_q_lat_norm_g": gain(ks[8], (DEPTH, B_Q_RANK)),
        "b_kv_lat_norm_g": gain(ks[9], (DEPTH, B_KV_RANK)),
        "w_b_uq": nrm(ks[10], (DEPTH, B_Q_RANK, B_HEADS * B_QK_DIM), B_Q_RANK),
        "w_b_ukv": nrm(ks[11], (DEPTH, B_KV_RANK, B_HEADS * (B_NOPE + B_V)), B_KV_RANK),
        "b_q_norm_g": gain(ks[12], (DEPTH, B_QK_DIM)),
        "b_k_norm_g": gain(ks[13], (DEPTH, B_QK_DIM)),
        "w_mem_kv": nrm(ks[14], (DEPTH, D_MODEL, 2 * C_WIDTH), D_MODEL),
        "c_q_norm_g": gain(ks[15], (DEPTH, C_HEAD_DIM)),
        "c_k_norm_g": gain(ks[16], (DEPTH, C_HEAD_DIM)),
        "w_branch": nrm(ks[17], (DEPTH, N_BRANCH, BRANCH_WIDTH, D_MODEL), BRANCH_WIDTH),
        "w_out": nrm(ks[18], (DEPTH, D_MODEL, D_MODEL), D_MODEL),
    }


def reference(x, mem, positions, rel_bias, norm_g, mem_norm_g, w_in, a_q_norm_g, a_k_norm_g,
              b_q_lat_norm_g, b_kv_lat_norm_g, w_b_uq, w_b_ukv, b_q_norm_g, b_k_norm_g,
              w_mem_kv, c_q_norm_g, c_k_norm_g, w_branch, w_out):
    bsz, seq, d = x.shape
    n_mem = mem.shape[1]
    inv_freq = 1.0 / (ROPE_THETA ** (jnp.arange(0, B_ROPE, 2, dtype=jnp.float32) / B_ROPE))
    ang = positions.astype(jnp.float32)[..., None] * inv_freq
    cos = jnp.cos(ang)[:, :, None, :]
    sin = jnp.sin(ang)[:, :, None, :]

    for l in range(DEPTH):
        h = rms_norm(x, norm_g[l])
        proj = h @ w_in[l]
        (aq, ak, av, az, iq, ik, iw, bcq, bckv, bkpe, bz, cq, cz, gates) = jnp.split(
            proj, IN_OFFSETS, axis=-1)

        aq = rms_norm(aq.reshape(bsz, seq, A_HEADS, A_HEAD_DIM), a_q_norm_g[l])
        ak = rms_norm(ak.reshape(bsz, seq, A_KV_HEADS, A_HEAD_DIM), a_k_norm_g[l])
        av = av.reshape(bsz, seq, A_KV_HEADS, A_HEAD_DIM)
        iq = iq.reshape(bsz, seq, IDX_HEADS, IDX_DIM)
        o_a = dsa_attention(aq, ak, av, iq, ik, iw, positions, rel_bias).reshape(bsz, seq, A_WIDTH)

        qb = (rms_norm(bcq, b_q_lat_norm_g[l]) @ w_b_uq[l]).reshape(bsz, seq, B_HEADS, B_QK_DIM)
        qb = rms_norm(qb, b_q_norm_g[l])
        qb = jnp.concatenate([qb[..., :B_NOPE], apply_rope(qb[..., B_NOPE:], cos, sin)], axis=-1)
        kv = (rms_norm(bckv, b_kv_lat_norm_g[l]) @ w_b_ukv[l]).reshape(bsz, seq, B_HEADS, B_NOPE + B_V)
        k_nope, vb = kv[..., :B_NOPE], kv[..., B_NOPE:]
        k_pe = jnp.broadcast_to(bkpe[:, :, None, :], (bsz, seq, B_HEADS, B_ROPE))
        kb = rms_norm(jnp.concatenate([k_nope, k_pe], axis=-1), b_k_norm_g[l])
        kb = jnp.concatenate([kb[..., :B_NOPE], apply_rope(kb[..., B_NOPE:], cos, sin)], axis=-1)
        o_b = mla_attention(qb, kb, vb).reshape(bsz, seq, B_WIDTH)

        mkv = rms_norm(mem, mem_norm_g[l]) @ w_mem_kv[l]
        ck = rms_norm(mkv[..., :C_WIDTH].reshape(bsz, n_mem, C_HEADS, C_HEAD_DIM), c_k_norm_g[l])
        cv = mkv[..., C_WIDTH:].reshape(bsz, n_mem, C_HEADS, C_HEAD_DIM)
        cq = rms_norm(cq.reshape(bsz, seq, C_HEADS, C_HEAD_DIM), c_q_norm_g[l])
        o_c = memory_attention(cq, ck, cv).reshape(bsz, seq, C_WIDTH)

        u = jnp.stack([o_a * jax.nn.silu(az), o_b * jax.nn.silu(bz), o_c * jax.nn.silu(cz)],
                      axis=2)
        y_br = jnp.einsum('bsnw,nwd->bsnd', u, w_branch[l])
        g = jax.nn.sigmoid(gates.reshape(bsz, seq, N_BRANCH, d))
        merged = jnp.einsum('bsnd,bsnd->bsd', g, y_br)
        x = x + merged @ w_out[l]
    return x
```

```cpp
#include <hip/hip_runtime.h>
#include <hip/hip_bf16.h>
#include <stdint.h>
#include <stdio.h>

typedef unsigned short u16;

constexpr int SEQ = 8192, DM = 2048, INW = 13712, NMEM = 256;
constexpr int OFF_AQ = 0, OFF_AK = 1024, OFF_AV = 1280, OFF_AZ = 1536, OFF_IQ = 2560, OFF_IK = 3584, OFF_IW = 3648,
              OFF_BCQ = 3664, OFF_BCKV = 4176, OFF_BKPE = 4432, OFF_BZ = 4496, OFF_CQ = 5520, OFF_CZ = 6544, OFF_G = 7568;
constexpr float EPS = 1e-6f;
constexpr float A_SCALE = 0.08838834764831845f;
constexpr float B_SCALE = 0.07216878364870322f;
constexpr float C_SCALE = 0.0625f;
constexpr int TOPK = 256;

constexpr size_t MiB = 1024 * 1024;
constexpr size_t WS_H = 0;
constexpr size_t WS_WINT = 32 * MiB;
constexpr size_t WS_WUQT = 86 * MiB;
constexpr size_t WS_WUKVT = 88 * MiB;
constexpr size_t WS_WMEMT = 89 * MiB;
constexpr size_t WS_WBRT = 97 * MiB;
constexpr size_t WS_WOUTT = 109 * MiB;
constexpr size_t WS_AQ = 117 * MiB;
constexpr size_t WS_KVA = 133 * MiB;
constexpr size_t WS_SZA = 141 * MiB;
constexpr size_t WS_IQ = 157 * MiB;
constexpr size_t WS_IK = 173 * MiB;
constexpr size_t WS_IW = 174 * MiB;
constexpr size_t WS_BKPE = 175 * MiB;
constexpr size_t WS_BCQ = 177 * MiB;
constexpr size_t WS_BCKV = 185 * MiB;
constexpr size_t WS_SZB = 189 * MiB;
constexpr size_t WS_CQ = 205 * MiB;
constexpr size_t WS_SZC = 221 * MiB;
constexpr size_t WS_G = 237 * MiB;
constexpr size_t WS_CK = 333 * MiB;
constexpr size_t WS_CV = WS_CK + 512 * 1024;
constexpr size_t WS_SEL = 334 * MiB;
constexpr size_t WS_CNT = 342 * MiB;
constexpr size_t WS_COS = 343 * MiB;
constexpr size_t WS_SIN = 344 * MiB;
constexpr size_t WS_UA = 345 * MiB;
constexpr size_t WS_UB = 361 * MiB;
constexpr size_t WS_UC = 377 * MiB;
constexpr size_t WS_MERGED = 393 * MiB;
constexpr size_t WS_HM = 425 * MiB;
constexpr size_t WS_END = 426 * MiB;
constexpr size_t WS_TMP_RAW = 345 * MiB;
constexpr size_t WS_TMP_MERGEDF = 0;
constexpr size_t DO_QB = 0, DO_KB = 24 * MiB, DO_VB = 48 * MiB;

__device__ __forceinline__ float bf2f(u16 u) { return __uint_as_float(((unsigned)u) << 16); }
__device__ __forceinline__ u16 f2bf(float f) {
    unsigned u = __float_as_uint(f);
    u += 0x7FFFu + ((u >> 16) & 1u);
    return (u16)(u >> 16);
}
__device__ __forceinline__ float silu_f(float x) { return x / (1.f + __expf(-x)); }
__device__ __forceinline__ float sigmoid_f(float x) { return 1.f / (1.f + __expf(-x)); }
__device__ __forceinline__ int rope_phys(int j, int second) { return (j >> 4) * 32 + (j & 15) + second * 16; }

__device__ __forceinline__ float block_sum_256(float v, float* red) {
    for (int o = 32; o > 0; o >>= 1) v += __shfl_xor(v, o);
    __syncthreads();
    if ((threadIdx.x & 63) == 0) red[threadIdx.x >> 6] = v;
    __syncthreads();
    return red[0] + red[1] + red[2] + red[3];
}

__global__ void __launch_bounds__(256) nk_rmsnorm_rows(const float* __restrict__ x, const float* __restrict__ g, u16* __restrict__ out, int C) {
    __shared__ float red[4];
    const float* xr = x + (size_t)blockIdx.x * C;
    float ss = 0.f;
    for (int c = threadIdx.x; c < C; c += 256) { float v = xr[c]; ss += v * v; }
    ss = block_sum_256(ss, red);
    float rinv = rsqrtf(ss / (float)C + EPS);
    for (int c = threadIdx.x; c < C; c += 256) out[(size_t)blockIdx.x * C + c] = f2bf(xr[c] * rinv * g[c]);
}

__global__ void __launch_bounds__(256) nk_rope_tables(const int* __restrict__ pos, float* __restrict__ cs, float* __restrict__ sn) {
    int i = blockIdx.x * 256 + threadIdx.x;
    if (i >= SEQ * 32) return;
    int t = i >> 5, j = i & 31;
    float inv_freq = 1.0f / powf(10000.f, (float)(2 * j) / 64.f);
    float ang = (float)pos[t] * inv_freq;
    cs[i] = cosf(ang); sn[i] = sinf(ang);
}

template <typename OutT> __device__ __forceinline__ void store_out(OutT* p, float v);
template <> __device__ __forceinline__ void store_out<float>(float* p, float v) { *p = v; }
template <> __device__ __forceinline__ void store_out<u16>(u16* p, float v) { *p = f2bf(v); }

template <typename OutT, int ACT>
__global__ void __launch_bounds__(256) nk_gemm(const u16* __restrict__ A, int lda, const float* __restrict__ B, int ldb, OutT* __restrict__ C, int ldc,
                        int M, int N, int K, const float* __restrict__ R, int ldr) {
    __shared__ float As[16][65];
    __shared__ float Bs[16][65];
    const int tid = threadIdx.x, tx = tid & 15, ty = tid >> 4;
    const int m0 = blockIdx.y * 64, n0 = blockIdx.x * 64;
    float acc[4][4] = {};
    for (int k0 = 0; k0 < K; k0 += 16) {
        {
            int r = tid >> 2, kk = (tid & 3) * 4;
            const u16* ap = A + (size_t)(m0 + r) * lda + k0 + kk;
            for (int e = 0; e < 4; ++e) As[kk + e][r] = bf2f(ap[e]);
        }
        {
            int kk = tid >> 4, nn = (tid & 15) * 4;
            const float* bp = B + (size_t)(k0 + kk) * ldb + n0 + nn;
            for (int e = 0; e < 4; ++e) Bs[kk][nn + e] = (n0 + nn + e < N) ? bp[e] : 0.f;
        }
        __syncthreads();
#pragma unroll
        for (int k = 0; k < 16; ++k) {
            float a[4], b[4];
#pragma unroll
            for (int i = 0; i < 4; ++i) { a[i] = As[k][ty + 16 * i]; b[i] = Bs[k][tx + 16 * i]; }
#pragma unroll
            for (int i = 0; i < 4; ++i)
#pragma unroll
                for (int j = 0; j < 4; ++j) acc[i][j] = fmaf(a[i], b[j], acc[i][j]);
        }
        __syncthreads();
    }
    for (int i = 0; i < 4; ++i)
        for (int j = 0; j < 4; ++j) {
            int row = m0 + ty + 16 * i, col = n0 + tx + 16 * j;
            if (col < N) {
                float v = acc[i][j];
                if (ACT == 1) v = silu_f(v);
                if (ACT == 2) v = sigmoid_f(v);
                if (ACT == 3) v += R[(size_t)row * ldr + col];
                store_out<OutT>(C + (size_t)row * ldc + col, v);
            }
        }
}

__global__ void __launch_bounds__(256) nk_headnorm(u16* __restrict__ buf, long row_stride, long head_stride, int nheads, int HD,
                            const float* __restrict__ g, float scale, int nrows) {
    int wid = (blockIdx.x * 256 + threadIdx.x) >> 6, lane = threadIdx.x & 63;
    if (wid >= nrows * nheads) return;
    int row = wid / nheads, h = wid % nheads;
    u16* p = buf + (size_t)row * row_stride + (size_t)h * head_stride;
    float ss = 0.f;
    for (int i = lane; i < HD; i += 64) { float v = bf2f(p[i]); ss += v * v; }
    for (int o = 32; o > 0; o >>= 1) ss += __shfl_xor(ss, o);
    float rinv = rsqrtf(ss / (float)HD + EPS) * scale;
    for (int i = lane; i < HD; i += 64) p[i] = f2bf(bf2f(p[i]) * rinv * g[i]);
}

__global__ void __launch_bounds__(256) nk_rownorm_bf16(u16* __restrict__ buf, int C, const float* __restrict__ g, int nrows) {
    int wid = (blockIdx.x * 256 + threadIdx.x) >> 6, lane = threadIdx.x & 63;
    if (wid >= nrows) return;
    u16* p = buf + (size_t)wid * C;
    float ss = 0.f;
    for (int i = lane; i < C; i += 64) { float v = bf2f(p[i]); ss += v * v; }
    for (int o = 32; o > 0; o >>= 1) ss += __shfl_xor(ss, o);
    float rinv = rsqrtf(ss / (float)C + EPS);
    for (int i = lane; i < C; i += 64) p[i] = f2bf(bf2f(p[i]) * rinv * g[i]);
}

__global__ void __launch_bounds__(256) nk_mla_q_finish(const float* __restrict__ qraw, const float* __restrict__ g, const float* __restrict__ cs,
                                const float* __restrict__ sn, u16* __restrict__ QB) {
    int wid = (blockIdx.x * 256 + threadIdx.x) >> 6, lane = threadIdx.x & 63;
    if (wid >= SEQ * 8) return;
    int t = wid >> 3, h = wid & 7;
    const float* p = qraw + (size_t)t * 1536 + h * 192;
    float v0 = p[lane], v1 = p[64 + lane], v2 = p[128 + lane];
    float ss = v0 * v0 + v1 * v1 + v2 * v2;
    for (int o = 32; o > 0; o >>= 1) ss += __shfl_xor(ss, o);
    float rinv = rsqrtf(ss / 192.f + EPS);
    v0 *= rinv * g[lane]; v1 *= rinv * g[64 + lane]; v2 *= rinv * g[128 + lane];
    float other = __shfl_xor(v2, 32);
    int j = lane & 31;
    float c = cs[t * 32 + j], s = sn[t * 32 + j];
    float r = (lane < 32) ? (v2 * c - other * s) : (v2 * c + other * s);
    u16* o = QB + ((size_t)h * SEQ + t) * 192;
    o[lane] = f2bf(v0 * B_SCALE); o[64 + lane] = f2bf(v1 * B_SCALE);
    o[128 + rope_phys(j, lane >> 5)] = f2bf(r * B_SCALE);
}
__global__ void __launch_bounds__(256) nk_mla_kv_finish(const float* __restrict__ kvraw, const float* __restrict__ bkpe, const float* __restrict__ g,
                                 const float* __restrict__ cs, const float* __restrict__ sn, u16* __restrict__ KB, u16* __restrict__ VB) {
    int wid = (blockIdx.x * 256 + threadIdx.x) >> 6, lane = threadIdx.x & 63;
    if (wid >= SEQ * 8) return;
    int t = wid >> 3, h = wid & 7;
    const float* p = kvraw + (size_t)t * 2048 + h * 256;
    float v0 = p[lane], v1 = p[64 + lane], v2 = bkpe[(size_t)t * 64 + lane];
    float ss = v0 * v0 + v1 * v1 + v2 * v2;
    for (int o = 32; o > 0; o >>= 1) ss += __shfl_xor(ss, o);
    float rinv = rsqrtf(ss / 192.f + EPS);
    v0 *= rinv * g[lane]; v1 *= rinv * g[64 + lane]; v2 *= rinv * g[128 + lane];
    float other = __shfl_xor(v2, 32);
    int j = lane & 31;
    float c = cs[t * 32 + j], s = sn[t * 32 + j];
    float r = (lane < 32) ? (v2 * c - other * s) : (v2 * c + other * s);
    u16* o = KB + ((size_t)h * SEQ + t) * 192;
    o[lane] = f2bf(v0); o[64 + lane] = f2bf(v1);
    o[128 + rope_phys(j, lane >> 5)] = f2bf(r);
    u16* vo = VB + ((size_t)h * SEQ + t) * 128;
    vo[lane] = f2bf(p[128 + lane]); vo[64 + lane] = f2bf(p[192 + lane]);
}

template <int DQK, int DV, int KT, bool CAUSAL>
__global__ void __launch_bounds__(256) nk_attn(const u16* __restrict__ Q, long q_rs, long q_hs, const u16* __restrict__ K, long k_rs, long k_hs,
                        const u16* __restrict__ V, long v_rs, long v_hs, int Skv, const u16* __restrict__ SZ, u16* __restrict__ U) {
    extern __shared__ float sm[];
    float* Qs = sm;
    float* Ks = Qs + 32 * (DQK + 1);
    float* Vs = Ks + KT * (DQK + 1);
    float* Ss = Vs + KT * DV;
    float* mrow = Ss + 32 * (KT + 1);
    float* lrow = mrow + 32;
    float* arow = lrow + 32;
    const int tid = threadIdx.x, q0 = blockIdx.x * 32, h = blockIdx.y;
    for (int e = tid; e < 32 * DQK; e += 256) { int r = e / DQK, d = e % DQK; Qs[r * (DQK + 1) + d] = bf2f(Q[(size_t)(q0 + r) * q_rs + (size_t)h * q_hs + d]); }
    if (tid < 32) { mrow[tid] = -1e30f; lrow[tid] = 0.f; }
    constexpr int NO = DV / 8;
    float o[NO];
#pragma unroll
    for (int j = 0; j < NO; ++j) o[j] = 0.f;
    const int qi = tid >> 3, sub = tid & 7;
    const int kend = CAUSAL ? (q0 + 32) : Skv;
    for (int k0 = 0; k0 < kend; k0 += KT) {
        __syncthreads();
        for (int e = tid; e < KT * DQK; e += 256) { int r = e / DQK, d = e % DQK; int key = k0 + r;
            Ks[r * (DQK + 1) + d] = (key < Skv) ? bf2f(K[(size_t)key * k_rs + (size_t)h * k_hs + d]) : 0.f; }
        for (int e = tid; e < KT * DV; e += 256) { int r = e / DV, d = e % DV; int key = k0 + r;
            Vs[r * DV + d] = (key < Skv) ? bf2f(V[(size_t)key * v_rs + (size_t)h * v_hs + d]) : 0.f; }
        __syncthreads();
        {
            constexpr int NP = KT / 8;
            float s[NP];
#pragma unroll
            for (int j = 0; j < NP; ++j) s[j] = 0.f;
            for (int d = 0; d < DQK; ++d) { float qv = Qs[qi * (DQK + 1) + d];
#pragma unroll
                for (int j = 0; j < NP; ++j) s[j] = fmaf(qv, Ks[(sub + 8 * j) * (DQK + 1) + d], s[j]); }
#pragma unroll
            for (int j = 0; j < NP; ++j) { int key = k0 + sub + 8 * j;
                bool ok = key < Skv && (!CAUSAL || key <= q0 + qi);
                Ss[qi * (KT + 1) + sub + 8 * j] = ok ? s[j] : -INFINITY; }
        }
        __syncthreads();
        if (tid < 32) {
            float m = mrow[tid], mx = m;
            for (int k = 0; k < KT; ++k) mx = fmaxf(mx, Ss[tid * (KT + 1) + k]);
            float alpha = __expf(m - mx), sum = 0.f;
            for (int k = 0; k < KT; ++k) { float p = __expf(Ss[tid * (KT + 1) + k] - mx); Ss[tid * (KT + 1) + k] = p; sum += p; }
            mrow[tid] = mx; lrow[tid] = lrow[tid] * alpha + sum; arow[tid] = alpha;
        }
        __syncthreads();
        {
            float alpha = arow[qi];
#pragma unroll
            for (int j = 0; j < NO; ++j) o[j] *= alpha;
            for (int k = 0; k < KT; ++k) { float p = Ss[qi * (KT + 1) + k];
#pragma unroll
                for (int j = 0; j < NO; ++j) o[j] = fmaf(p, Vs[k * DV + sub + 8 * j], o[j]); }
        }
    }
    __syncthreads();
    float linv = 1.f / lrow[qi];
#pragma unroll
    for (int j = 0; j < NO; ++j) { int d = sub + 8 * j; size_t idx = (size_t)(q0 + qi) * 1024 + h * DV + d;
        U[idx] = f2bf(o[j] * linv * bf2f(SZ[idx])); }
}

__device__ __forceinline__ unsigned ord_key(float f) { unsigned u = __float_as_uint(f); return (u & 0x80000000u) ? ~u : (u | 0x80000000u); }
__global__ void __launch_bounds__(256) nk_indexer_topk(const u16* __restrict__ IQ, const u16* __restrict__ IK, const float* __restrict__ IW,
                                int* __restrict__ SEL, int* __restrict__ CNT) {
    __shared__ unsigned keys[SEQ];
    __shared__ float qs[16 * 64];
    __shared__ float ws[16];
    __shared__ int cnt_sh;
    __shared__ int wsum[8];
    const int t = blockIdx.x, tid = threadIdx.x, n = t + 1;
    int* sel = SEL + (size_t)t * TOPK;
    if (n <= TOPK) { for (int i = tid; i < n; i += 256) sel[i] = i; if (tid == 0) CNT[t] = n; return; }
    for (int e = tid; e < 1024; e += 256) qs[e] = bf2f(IQ[(size_t)t * 1024 + e]);
    if (tid < 16) ws[tid] = IW[(size_t)t * 16 + tid];
    __syncthreads();
    for (int s = tid; s < n; s += 256) {
        float kv[64];
        const u16* kp = IK + (size_t)s * 64;
#pragma unroll
        for (int d = 0; d < 64; ++d) kv[d] = bf2f(kp[d]);
        float sc = 0.f;
        for (int h = 0; h < 16; ++h) { float dot = 0.f;
#pragma unroll
            for (int d = 0; d < 64; ++d) dot = fmaf(qs[h * 64 + d], kv[d], dot);
            sc = fmaf(ws[h], fmaxf(dot, 0.f), sc); }
        keys[s] = ord_key(sc);
    }
    __syncthreads();
    unsigned prefix = 0; int need = TOPK;
    for (int bit = 31; bit >= 0; --bit) {
        if (tid == 0) cnt_sh = 0;
        __syncthreads();
        unsigned want = (prefix >> bit) | 1u;
        int c = 0;
        for (int s = tid; s < n; s += 256) c += ((keys[s] >> bit) == want) ? 1 : 0;
        for (int o = 32; o > 0; o >>= 1) c += __shfl_xor(c, o);
        if ((tid & 63) == 0) atomicAdd(&cnt_sh, c);
        __syncthreads();
        int tot = cnt_sh;
        if (tot >= need) prefix |= (1u << bit); else need -= tot;
        __syncthreads();
    }
    int base_sel = 0, base_eq = 0;
    for (int c0 = 0; c0 < n; c0 += 256) {
        int s = c0 + tid; bool in = s < n;
        unsigned kk = in ? keys[s] : 0u;
        bool gt = in && kk > prefix, eq = in && kk == prefix;
        unsigned long long beq = __ballot(eq);
        int w = tid >> 6, lane = tid & 63;
        if (lane == 0) wsum[w] = __popcll(beq);
        __syncthreads();
        int eqpre = base_eq + __popcll(beq & ((1ull << lane) - 1ull));
        for (int i = 0; i < w; ++i) eqpre += wsum[i];
        int eqtot = wsum[0] + wsum[1] + wsum[2] + wsum[3];
        bool selv = gt || (eq && eqpre < need);
        unsigned long long bs = __ballot(selv);
        if (lane == 0) wsum[4 + w] = __popcll(bs);
        __syncthreads();
        int pos = base_sel + __popcll(bs & ((1ull << lane) - 1ull));
        for (int i = 0; i < w; ++i) pos += wsum[4 + i];
        if (selv && pos < TOPK) sel[pos] = s;
        base_sel += wsum[4] + wsum[5] + wsum[6] + wsum[7];
        base_eq += eqtot;
        __syncthreads();
    }
    if (tid == 0) CNT[t] = TOPK;
}

__device__ __forceinline__ int t5_bucket(int dist) {
    int nn = dist > 0 ? dist : 0;
    if (nn < 16) return nn;
    float nf = (float)nn;
    int large = 16 + (int)(logf(nf / 16.f) / 2.0794415416798357f * 16.f);
    return large < 31 ? large : 31;
}
__global__ void __launch_bounds__(256) nk_sparse_attn(const u16* __restrict__ AQ, const u16* __restrict__ KVA, const int* __restrict__ SEL, const int* __restrict__ CNT,
                               const int* __restrict__ pos, const float* __restrict__ relb, const u16* __restrict__ SZA, u16* __restrict__ UA) {
    __shared__ float qs[1024];
    __shared__ int sl[TOPK];
    __shared__ int bk[TOPK];
    __shared__ float pr[TOPK];
    __shared__ float red[4];
    const int t = blockIdx.x, tid = threadIdx.x;
    const int cnt = CNT[t];
    for (int e = tid; e < 1024; e += 256) qs[e] = bf2f(AQ[(size_t)t * 1024 + e]);
    if (tid < cnt) { int s = SEL[(size_t)t * TOPK + tid]; sl[tid] = s; bk[tid] = t5_bucket(pos[t] - pos[s]); }
    __syncthreads();
    for (int h = 0; h < 8; ++h) {
        const int g = h >> 2;
        float logit = -INFINITY;
        if (tid < cnt) {
            const u16* kp = KVA + ((size_t)sl[tid] * 2 + g) * 256;
            float dot = 0.f;
            for (int d = 0; d < 128; ++d) dot = fmaf(qs[h * 128 + d], bf2f(kp[d]), dot);
            logit = dot + relb[bk[tid] * 8 + h];
        }
        float mx = logit;
        for (int o = 32; o > 0; o >>= 1) mx = fmaxf(mx, __shfl_xor(mx, o));
        __syncthreads();
        if ((tid & 63) == 0) red[tid >> 6] = mx;
        __syncthreads();
        mx = fmaxf(fmaxf(red[0], red[1]), fmaxf(red[2], red[3]));
        float p = (tid < cnt) ? __expf(logit - mx) : 0.f;
        pr[tid] = p;
        float sum = block_sum_256(p, red);
        __syncthreads();
        if (tid < 128) {
            float acc = 0.f;
            for (int k = 0; k < cnt; ++k) acc = fmaf(pr[k], bf2f(KVA[((size_t)sl[k] * 2 + g) * 256 + 128 + tid]), acc);
            size_t idx = (size_t)t * 1024 + h * 128 + tid;
            UA[idx] = f2bf(acc / sum * bf2f(SZA[idx]));
        }
        __syncthreads();
    }
}

__global__ void __launch_bounds__(256) nk_merge(const float* __restrict__ Y, const u16* __restrict__ G, int n, float* __restrict__ MF, u16* __restrict__ MERGED) {
    size_t i = (size_t)blockIdx.x * 256 + threadIdx.x;
    if (i >= (size_t)SEQ * DM) return;
    size_t t = i / DM, d = i % DM;
    float v = bf2f(G[t * 6144 + (size_t)n * DM + d]) * Y[i];
    if (n > 0) v += MF[i];
    MF[i] = v;
    if (n == 2) MERGED[i] = f2bf(v);
}

extern "C" void kernel_launch(void* const* d_in, const int* in_sizes, int n_in, void* d_out, int out_size, void* d_ws, size_t ws_size,
                              hipStream_t stream) {
    if (ws_size < WS_END) { fprintf(stderr, "ws too small: %zu < %zu\n", ws_size, WS_END); return; }
    const float* x = (const float*)d_in[0];
    const float* mem = (const float*)d_in[1];
    const int* positions = (const int*)d_in[2];
    const float* rel_bias = (const float*)d_in[3];
    const float* norm_g = (const float*)d_in[4];
    const float* mem_norm_g = (const float*)d_in[5];
    const float* w_in = (const float*)d_in[6];
    const float* a_q_norm_g = (const float*)d_in[7];
    const float* a_k_norm_g = (const float*)d_in[8];
    const float* b_q_lat_norm_g = (const float*)d_in[9];
    const float* b_kv_lat_norm_g = (const float*)d_in[10];
    const float* w_b_uq = (const float*)d_in[11];
    const float* w_b_ukv = (const float*)d_in[12];
    const float* b_q_norm_g = (const float*)d_in[13];
    const float* b_k_norm_g = (const float*)d_in[14];
    const float* w_mem_kv = (const float*)d_in[15];
    const float* c_q_norm_g = (const float*)d_in[16];
    const float* c_k_norm_g = (const float*)d_in[17];
    const float* w_branch = (const float*)d_in[18];
    const float* w_out = (const float*)d_in[19];
    char* ws = (char*)d_ws;
    char* dout = (char*)d_out;
    u16* H = (u16*)(ws + WS_H); u16* HM = (u16*)(ws + WS_HM);
    u16* AQ = (u16*)(ws + WS_AQ); u16* KVA = (u16*)(ws + WS_KVA); u16* SZA = (u16*)(ws + WS_SZA);
    u16* IQ = (u16*)(ws + WS_IQ); u16* IK = (u16*)(ws + WS_IK); float* IW = (float*)(ws + WS_IW); float* BKPE = (float*)(ws + WS_BKPE);
    u16* BCQ = (u16*)(ws + WS_BCQ); u16* BCKV = (u16*)(ws + WS_BCKV); u16* SZB = (u16*)(ws + WS_SZB);
    u16* CQ = (u16*)(ws + WS_CQ); u16* SZC = (u16*)(ws + WS_SZC); u16* G = (u16*)(ws + WS_G);
    u16* CK = (u16*)(ws + WS_CK); u16* CV = (u16*)(ws + WS_CV);
    int* SEL = (int*)(ws + WS_SEL); int* CNT = (int*)(ws + WS_CNT);
    float* COS = (float*)(ws + WS_COS); float* SIN = (float*)(ws + WS_SIN);
    u16* UA = (u16*)(ws + WS_UA); u16* UB = (u16*)(ws + WS_UB); u16* UC = (u16*)(ws + WS_UC);
    u16* MERGED = (u16*)(ws + WS_MERGED);
    u16* QB = (u16*)(dout + DO_QB); u16* KB = (u16*)(dout + DO_KB); u16* VB = (u16*)(dout + DO_VB);
    float* RAW = (float*)(ws + WS_TMP_RAW);
    float* MF = (float*)(ws + WS_TMP_MERGEDF);
    float* Y = (float*)d_out;

    static bool attr_done = false;
    if (!attr_done) {
        attr_done = true;
        hipFuncSetAttribute((const void*)nk_attn<192, 128, 64, true>, hipFuncAttributeMaxDynamicSharedMemorySize, 120 * 1024);
        hipFuncSetAttribute((const void*)nk_attn<256, 256, 32, false>, hipFuncAttributeMaxDynamicSharedMemorySize, 120 * 1024);
    }
    nk_rmsnorm_rows<<<SEQ, 256, 0, stream>>>(x, norm_g, H, DM);
    nk_rmsnorm_rows<<<NMEM, 256, 0, stream>>>(mem, mem_norm_g, HM, DM);
    nk_rope_tables<<<SEQ * 32 / 256, 256, 0, stream>>>(positions, COS, SIN);
#define GEMM(OutT, ACT, A_, lda_, B_, ldb_, C_, ldc_, M_, N_, K_, R_, ldr_) \
    nk_gemm<OutT, ACT><<<dim3(((N_) + 63) / 64, (M_) / 64), 256, 0, stream>>>(A_, lda_, B_, ldb_, C_, ldc_, M_, N_, K_, R_, ldr_)
    GEMM(u16, 0, H, DM, w_in + OFF_AQ, INW, AQ, 1024, SEQ, 1024, DM, nullptr, 0);
    GEMM(u16, 0, H, DM, w_in + OFF_AK, INW, KVA, 512, SEQ, 128, DM, nullptr, 0);
    GEMM(u16, 0, H, DM, w_in + OFF_AK + 128, INW, KVA + 256, 512, SEQ, 128, DM, nullptr, 0);
    GEMM(u16, 0, H, DM, w_in + OFF_AV, INW, KVA + 128, 512, SEQ, 128, DM, nullptr, 0);
    GEMM(u16, 0, H, DM, w_in + OFF_AV + 128, INW, KVA + 384, 512, SEQ, 128, DM, nullptr, 0);
    GEMM(u16, 1, H, DM, w_in + OFF_AZ, INW, SZA, 1024, SEQ, 1024, DM, nullptr, 0);
    GEMM(u16, 0, H, DM, w_in + OFF_IQ, INW, IQ, 1024, SEQ, 1024, DM, nullptr, 0);
    GEMM(u16, 0, H, DM, w_in + OFF_IK, INW, IK, 64, SEQ, 64, DM, nullptr, 0);
    GEMM(float, 0, H, DM, w_in + OFF_IW, INW, IW, 16, SEQ, 16, DM, nullptr, 0);
    GEMM(u16, 0, H, DM, w_in + OFF_BCQ, INW, BCQ, 512, SEQ, 512, DM, nullptr, 0);
    GEMM(u16, 0, H, DM, w_in + OFF_BCKV, INW, BCKV, 256, SEQ, 256, DM, nullptr, 0);
    GEMM(float, 0, H, DM, w_in + OFF_BKPE, INW, BKPE, 64, SEQ, 64, DM, nullptr, 0);
    GEMM(u16, 1, H, DM, w_in + OFF_BZ, INW, SZB, 1024, SEQ, 1024, DM, nullptr, 0);
    GEMM(u16, 0, H, DM, w_in + OFF_CQ, INW, CQ, 1024, SEQ, 1024, DM, nullptr, 0);
    GEMM(u16, 1, H, DM, w_in + OFF_CZ, INW, SZC, 1024, SEQ, 1024, DM, nullptr, 0);
    GEMM(u16, 2, H, DM, w_in + OFF_G, INW, G, 6144, SEQ, 6144, DM, nullptr, 0);
    GEMM(u16, 0, HM, DM, w_mem_kv, 2048, CK, 1024, NMEM, 1024, DM, nullptr, 0);
    GEMM(u16, 0, HM, DM, w_mem_kv + 1024, 2048, CV, 1024, NMEM, 1024, DM, nullptr, 0);
    nk_headnorm<<<SEQ * 8 / 4, 256, 0, stream>>>(AQ, 1024, 128, 8, 128, a_q_norm_g, A_SCALE, SEQ);
    nk_headnorm<<<SEQ * 2 / 4, 256, 0, stream>>>(KVA, 512, 256, 2, 128, a_k_norm_g, 1.f, SEQ);
    nk_headnorm<<<SEQ * 4 / 4, 256, 0, stream>>>(CQ, 1024, 256, 4, 256, c_q_norm_g, C_SCALE, SEQ);
    nk_headnorm<<<NMEM * 4 / 4, 256, 0, stream>>>(CK, 1024, 256, 4, 256, c_k_norm_g, 1.f, NMEM);
    nk_rownorm_bf16<<<SEQ / 4, 256, 0, stream>>>(BCQ, 512, b_q_lat_norm_g, SEQ);
    GEMM(float, 0, BCQ, 512, w_b_uq, 1536, RAW, 1536, SEQ, 1536, 512, nullptr, 0);
    nk_mla_q_finish<<<SEQ * 8 / 4, 256, 0, stream>>>(RAW, b_q_norm_g, COS, SIN, QB);
    nk_rownorm_bf16<<<SEQ / 4, 256, 0, stream>>>(BCKV, 256, b_kv_lat_norm_g, SEQ);
    GEMM(float, 0, BCKV, 256, w_b_ukv, 2048, RAW, 2048, SEQ, 2048, 256, nullptr, 0);
    nk_mla_kv_finish<<<SEQ * 8 / 4, 256, 0, stream>>>(RAW, BKPE, b_k_norm_g, COS, SIN, KB, VB);
    nk_indexer_topk<<<SEQ, 256, 0, stream>>>(IQ, IK, IW, SEL, CNT);
    {
        size_t lds = (size_t)(32 * 257 + 32 * 257 + 32 * 256 + 32 * 33 + 96) * 4;
        nk_attn<256, 256, 32, false><<<dim3(SEQ / 32, 4), 256, lds, stream>>>(CQ, 1024, 256, CK, 1024, 256, CV, 1024, 256, NMEM, SZC, UC);
    }
    nk_sparse_attn<<<SEQ, 256, 0, stream>>>(AQ, KVA, SEL, CNT, positions, rel_bias, SZA, UA);
    {
        size_t lds = (size_t)(32 * 193 + 64 * 193 + 64 * 128 + 32 * 65 + 96) * 4;
        nk_attn<192, 128, 64, true><<<dim3(SEQ / 32, 8), 256, lds, stream>>>(QB, 192, (long)SEQ * 192, KB, 192, (long)SEQ * 192, VB, 128, (long)SEQ * 128, SEQ, SZB, UB);
    }
    const u16* Us[3] = {UA, UB, UC};
    for (int n = 0; n < 3; ++n) {
        GEMM(float, 0, Us[n], 1024, w_branch + (size_t)n * 1024 * DM, DM, Y, DM, SEQ, DM, 1024, nullptr, 0);
        nk_merge<<<SEQ * DM / 256, 256, 0, stream>>>(Y, G, n, MF, MERGED);
    }
    GEMM(float, 3, MERGED, DM, w_out, DM, (float*)d_out, DM, SEQ, DM, DM, x, DM);
#undef GEMM
}
```

```cpp
#include <hip/hip_runtime.h>
#include <hip/hip_bf16.h>
#include <stdint.h>
#include <stdio.h>

typedef unsigned short u16;

constexpr int SEQ = 8192, DM = 2048, INW = 13712, NMEM = 256;
constexpr int OFF_AQ = 0, OFF_AK = 1024, OFF_AV = 1280, OFF_AZ = 1536, OFF_IQ = 2560, OFF_IK = 3584, OFF_IW = 3648,
              OFF_BCQ = 3664, OFF_BCKV = 4176, OFF_BKPE = 4432, OFF_BZ = 4496, OFF_CQ = 5520, OFF_CZ = 6544, OFF_G = 7568;
constexpr float EPS = 1e-6f;
constexpr float A_SCALE = 0.08838834764831845f;
constexpr float B_SCALE = 0.07216878364870322f;
constexpr float C_SCALE = 0.0625f;
constexpr int TOPK = 256;

constexpr size_t MiB = 1024 * 1024;
constexpr size_t WS_H = 0;
constexpr size_t WS_WINT = 32 * MiB;
constexpr size_t WS_WUQT = 86 * MiB;
constexpr size_t WS_WUKVT = 88 * MiB;
constexpr size_t WS_WMEMT = 89 * MiB;
constexpr size_t WS_WBRT = 97 * MiB;
constexpr size_t WS_WOUTT = 109 * MiB;
constexpr size_t WS_AQ = 117 * MiB;
constexpr size_t WS_KVA = 133 * MiB;
constexpr size_t WS_SZA = 141 * MiB;
constexpr size_t WS_IQ = 157 * MiB;
constexpr size_t WS_IK = 173 * MiB;
constexpr size_t WS_IW = 174 * MiB;
constexpr size_t WS_BKPE = 175 * MiB;
constexpr size_t WS_BCQ = 177 * MiB;
constexpr size_t WS_BCKV = 185 * MiB;
constexpr size_t WS_SZB = 189 * MiB;
constexpr size_t WS_CQ = 205 * MiB;
constexpr size_t WS_SZC = 221 * MiB;
constexpr size_t WS_G = 237 * MiB;
constexpr size_t WS_CK = 333 * MiB;
constexpr size_t WS_CV = WS_CK + 512 * 1024;
constexpr size_t WS_SEL = 334 * MiB;
constexpr size_t WS_CNT = 342 * MiB;
constexpr size_t WS_COS = 343 * MiB;
constexpr size_t WS_SIN = 344 * MiB;
constexpr size_t WS_UA = 345 * MiB;
constexpr size_t WS_UB = 361 * MiB;
constexpr size_t WS_UC = 377 * MiB;
constexpr size_t WS_MERGED = 393 * MiB;
constexpr size_t WS_HM = 425 * MiB;
constexpr size_t WS_END = 426 * MiB;
constexpr size_t WS_TMP_RAW = 345 * MiB;
constexpr size_t WS_TMP_MERGEDF = 0;
constexpr size_t DO_QB = 0, DO_KB = 24 * MiB, DO_VB = 48 * MiB;

__device__ __forceinline__ float bf2f(u16 u) { return __uint_as_float(((unsigned)u) << 16); }
__device__ __forceinline__ u16 f2bf(float f) {
    unsigned u = __float_as_uint(f);
    u += 0x7FFFu + ((u >> 16) & 1u);
    return (u16)(u >> 16);
}
__device__ __forceinline__ float silu_f(float x) { return x / (1.f + __expf(-x)); }
__device__ __forceinline__ float sigmoid_f(float x) { return 1.f / (1.f + __expf(-x)); }
__device__ __forceinline__ int rope_phys(int j, int second) { return (j >> 4) * 32 + (j & 15) + second * 16; }

__device__ __forceinline__ float block_sum_256(float v, float* red) {
    for (int o = 32; o > 0; o >>= 1) v += __shfl_xor(v, o);
    __syncthreads();
    if ((threadIdx.x & 63) == 0) red[threadIdx.x >> 6] = v;
    __syncthreads();
    return red[0] + red[1] + red[2] + red[3];
}

__global__ void __launch_bounds__(256) nk_rmsnorm_rows(const float* __restrict__ x, const float* __restrict__ g, u16* __restrict__ out, int C) {
    __shared__ float red[4];
    const float* xr = x + (size_t)blockIdx.x * C;
    float ss = 0.f;
    for (int c = threadIdx.x; c < C; c += 256) { float v = xr[c]; ss += v * v; }
    ss = block_sum_256(ss, red);
    float rinv = rsqrtf(ss / (float)C + EPS);
    for (int c = threadIdx.x; c < C; c += 256) out[(size_t)blockIdx.x * C + c] = f2bf(xr[c] * rinv * g[c]);
}

__global__ void __launch_bounds__(256) nk_rope_tables(const int* __restrict__ pos, float* __restrict__ cs, float* __restrict__ sn) {
    int i = blockIdx.x * 256 + threadIdx.x;
    if (i >= SEQ * 32) return;
    int t = i >> 5, j = i & 31;
    float inv_freq = 1.0f / powf(10000.f, (float)(2 * j) / 64.f);
    float ang = (float)pos[t] * inv_freq;
    cs[i] = cosf(ang); sn[i] = sinf(ang);
}

template <typename OutT> __device__ __forceinline__ void store_out(OutT* p, float v);
template <> __device__ __forceinline__ void store_out<float>(float* p, float v) { *p = v; }
template <> __device__ __forceinline__ void store_out<u16>(u16* p, float v) { *p = f2bf(v); }

template <typename OutT, int ACT>
__global__ void __launch_bounds__(256) nk_gemm(const u16* __restrict__ A, int lda, const float* __restrict__ B, int ldb, OutT* __restrict__ C, int ldc,
                        int M, int N, int K, const float* __restrict__ R, int ldr) {
    __shared__ float As[16][65];
    __shared__ float Bs[16][65];
    const int tid = threadIdx.x, tx = tid & 15, ty = tid >> 4;
    const int m0 = blockIdx.y * 64, n0 = blockIdx.x * 64;
    float acc[4][4] = {};
    for (int k0 = 0; k0 < K; k0 += 16) {
        {
            int r = tid >> 2, kk = (tid & 3) * 4;
            const u16* ap = A + (size_t)(m0 + r) * lda + k0 + kk;
            for (int e = 0; e < 4; ++e) As[kk + e][r] = bf2f(ap[e]);
        }
        {
            int kk = tid >> 4, nn = (tid & 15) * 4;
            const float* bp = B + (size_t)(k0 + kk) * ldb + n0 + nn;
            for (int e = 0; e < 4; ++e) Bs[kk][nn + e] = (n0 + nn + e < N) ? bp[e] : 0.f;
        }
        __syncthreads();
#pragma unroll
        for (int k = 0; k < 16; ++k) {
            float a[4], b[4];
#pragma unroll
            for (int i = 0; i < 4; ++i) { a[i] = As[k][ty + 16 * i]; b[i] = Bs[k][tx + 16 * i]; }
#pragma unroll
            for (int i = 0; i < 4; ++i)
#pragma unroll
                for (int j = 0; j < 4; ++j) acc[i][j] = fmaf(a[i], b[j], acc[i][j]);
        }
        __syncthreads();
    }
    for (int i = 0; i < 4; ++i)
        for (int j = 0; j < 4; ++j) {
            int row = m0 + ty + 16 * i, col = n0 + tx + 16 * j;
            if (col < N) {
                float v = acc[i][j];
                if (ACT == 1) v = silu_f(v);
                if (ACT == 2) v = sigmoid_f(v);
                if (ACT == 3) v += R[(size_t)row * ldr + col];
                store_out<OutT>(C + (size_t)row * ldc + col, v);
            }
        }
}

__global__ void __launch_bounds__(256) nk_headnorm(u16* __restrict__ buf, long row_stride, long head_stride, int nheads, int HD,
                            const float* __restrict__ g, float scale, int nrows) {
    int wid = (blockIdx.x * 256 + threadIdx.x) >> 6, lane = threadIdx.x & 63;
    if (wid >= nrows * nheads) return;
    int row = wid / nheads, h = wid % nheads;
    u16* p = buf + (size_t)row * row_stride + (size_t)h * head_stride;
    float ss = 0.f;
    for (int i = lane; i < HD; i += 64) { float v = bf2f(p[i]); ss += v * v; }
    for (int o = 32; o > 0; o >>= 1) ss += __shfl_xor(ss, o);
    float rinv = rsqrtf(ss / (float)HD + EPS) * scale;
    for (int i = lane; i < HD; i += 64) p[i] = f2bf(bf2f(p[i]) * rinv * g[i]);
}

__global__ void __launch_bounds__(256) nk_rownorm_bf16(u16* __restrict__ buf, int C, const float* __restrict__ g, int nrows) {
    int wid = (blockIdx.x * 256 + threadIdx.x) >> 6, lane = threadIdx.x & 63;
    if (wid >= nrows) return;
    u16* p = buf + (size_t)wid * C;
    float ss = 0.f;
    for (int i = lane; i < C; i += 64) { float v = bf2f(p[i]); ss += v * v; }
    for (int o = 32; o > 0; o >>= 1) ss += __shfl_xor(ss, o);
    float rinv = rsqrtf(ss / (float)C + EPS);
    for (int i = lane; i < C; i += 64) p[i] = f2bf(bf2f(p[i]) * rinv * g[i]);
}

__global__ void __launch_bounds__(256) nk_mla_q_finish(const float* __restrict__ qraw, const float* __restrict__ g, const float* __restrict__ cs,
                                const float* __restrict__ sn, u16* __restrict__ QB) {
    int wid = (blockIdx.x * 256 + threadIdx.x) >> 6, lane = threadIdx.x & 63;
    if (wid >= SEQ * 8) return;
    int t = wid >> 3, h = wid & 7;
    const float* p = qraw + (size_t)t * 1536 + h * 192;
    float v0 = p[lane], v1 = p[64 + lane], v2 = p[128 + lane];
    float ss = v0 * v0 + v1 * v1 + v2 * v2;
    for (int o = 32; o > 0; o >>= 1) ss += __shfl_xor(ss, o);
    float rinv = rsqrtf(ss / 192.f + EPS);
    v0 *= rinv * g[lane]; v1 *= rinv * g[64 + lane]; v2 *= rinv * g[128 + lane];
    float other = __shfl_xor(v2, 32);
    int j = lane & 31;
    float c = cs[t * 32 + j], s = sn[t * 32 + j];
    float r = (lane < 32) ? (v2 * c - other * s) : (v2 * c + other * s);
    u16* o = QB + ((size_t)h * SEQ + t) * 192;
    o[lane] = f2bf(v0 * B_SCALE); o[64 + lane] = f2bf(v1 * B_SCALE);
    o[128 + rope_phys(j, lane >> 5)] = f2bf(r * B_SCALE);
}
__global__ void __launch_bounds__(256) nk_mla_kv_finish(const float* __restrict__ kvraw, const float* __restrict__ bkpe, const float* __restrict__ g,
                                 const float* __restrict__ cs, const float* __restrict__ sn, u16* __restrict__ KB, u16* __restrict__ VB) {
    int wid = (blockIdx.x * 256 + threadIdx.x) >> 6, lane = threadIdx.x & 63;
    if (wid >= SEQ * 8) return;
    int t = wid >> 3, h = wid & 7;
    const float* p = kvraw + (size_t)t * 2048 + h * 256;
    float v0 = p[lane], v1 = p[64 + lane], v2 = bkpe[(size_t)t * 64 + lane];
    float ss = v0 * v0 + v1 * v1 + v2 * v2;
    for (int o = 32; o > 0; o >>= 1) ss += __shfl_xor(ss, o);
    float rinv = rsqrtf(ss / 192.f + EPS);
    v0 *= rinv * g[lane]; v1 *= rinv * g[64 + lane]; v2 *= rinv * g[128 + lane];
    float other = __shfl_xor(v2, 32);
    int j = lane & 31;
    float c = cs[t * 32 + j], s = sn[t * 32 + j];
    float r = (lane < 32) ? (v2 * c - other * s) : (v2 * c + other * s);
    u16* o = KB + ((size_t)h * SEQ + t) * 192;
    o[lane] = f2bf(v0); o[64 + lane] = f2bf(v1);
    o[128 + rope_phys(j, lane >> 5)] = f2bf(r);
    u16* vo = VB + ((size_t)h * SEQ + t) * 128;
    vo[lane] = f2bf(p[128 + lane]); vo[64 + lane] = f2bf(p[192 + lane]);
}

template <int DQK, int DV, int KT, bool CAUSAL>
__global__ void __launch_bounds__(256) nk_attn(const u16* __restrict__ Q, long q_rs, long q_hs, const u16* __restrict__ K, long k_rs, long k_hs,
                        const u16* __restrict__ V, long v_rs, long v_hs, int Skv, const u16* __restrict__ SZ, u16* __restrict__ U) {
    extern __shared__ float sm[];
    float* Qs = sm;
    float* Ks = Qs + 32 * (DQK + 1);
    float* Vs = Ks + KT * (DQK + 1);
    float* Ss = Vs + KT * DV;
    float* mrow = Ss + 32 * (KT + 1);
    float* lrow = mrow + 32;
    float* arow = lrow + 32;
    const int tid = threadIdx.x, q0 = blockIdx.x * 32, h = blockIdx.y;
    for (int e = tid; e < 32 * DQK; e += 256) { int r = e / DQK, d = e % DQK; Qs[r * (DQK + 1) + d] = bf2f(Q[(size_t)(q0 + r) * q_rs + (size_t)h * q_hs + d]); }
    if (tid < 32) { mrow[tid] = -1e30f; lrow[tid] = 0.f; }
    constexpr int NO = DV / 8;
    float o[NO];
#pragma unroll
    for (int j = 0; j < NO; ++j) o[j] = 0.f;
    const int qi = tid >> 3, sub = tid & 7;
    const int kend = CAUSAL ? (q0 + 32) : Skv;
    for (int k0 = 0; k0 < kend; k0 += KT) {
        __syncthreads();
        for (int e = tid; e < KT * DQK; e += 256) { int r = e / DQK, d = e % DQK; int key = k0 + r;
            Ks[r * (DQK + 1) + d] = (key < Skv) ? bf2f(K[(size_t)key * k_rs + (size_t)h * k_hs + d]) : 0.f; }
        for (int e = tid; e < KT * DV; e += 256) { int r = e / DV, d = e % DV; int key = k0 + r;
            Vs[r * DV + d] = (key < Skv) ? bf2f(V[(size_t)key * v_rs + (size_t)h * v_hs + d]) : 0.f; }
        __syncthreads();
        {
            constexpr int NP = KT / 8;
            float s[NP];
#pragma unroll
            for (int j = 0; j < NP; ++j) s[j] = 0.f;
            for (int d = 0; d < DQK; ++d) { float qv = Qs[qi * (DQK + 1) + d];
#pragma unroll
                for (int j = 0; j < NP; ++j) s[j] = fmaf(qv, Ks[(sub + 8 * j) * (DQK + 1) + d], s[j]); }
#pragma unroll
            for (int j = 0; j < NP; ++j) { int key = k0 + sub + 8 * j;
                bool ok = key < Skv && (!CAUSAL || key <= q0 + qi);
                Ss[qi * (KT + 1) + sub + 8 * j] = ok ? s[j] : -INFINITY; }
        }
        __syncthreads();
        if (tid < 32) {
            float m = mrow[tid], mx = m;
            for (int k = 0; k < KT; ++k) mx = fmaxf(mx, Ss[tid * (KT + 1) + k]);
            float alpha = __expf(m - mx), sum = 0.f;
            for (int k = 0; k < KT; ++k) { float p = __expf(Ss[tid * (KT + 1) + k] - mx); Ss[tid * (KT + 1) + k] = p; sum += p; }
            mrow[tid] = mx; lrow[tid] = lrow[tid] * alpha + sum; arow[tid] = alpha;
        }
        __syncthreads();
        {
            float alpha = arow[qi];
#pragma unroll
            for (int j = 0; j < NO; ++j) o[j] *= alpha;
            for (int k = 0; k < KT; ++k) { float p = Ss[qi * (KT + 1) + k];
#pragma unroll
                for (int j = 0; j < NO; ++j) o[j] = fmaf(p, Vs[k * DV + sub + 8 * j], o[j]); }
        }
    }
    __syncthreads();
    float linv = 1.f / lrow[qi];
#pragma unroll
    for (int j = 0; j < NO; ++j) { int d = sub + 8 * j; size_t idx = (size_t)(q0 + qi) * 1024 + h * DV + d;
        U[idx] = f2bf(o[j] * linv * bf2f(SZ[idx])); }
}

__device__ __forceinline__ unsigned ord_key(float f) { unsigned u = __float_as_uint(f); return (u & 0x80000000u) ? ~u : (u | 0x80000000u); }
__global__ void __launch_bounds__(256) nk_indexer_topk(const u16* __restrict__ IQ, const u16* __restrict__ IK, const float* __restrict__ IW,
                                int* __restrict__ SEL, int* __restrict__ CNT) {
    __shared__ unsigned keys[SEQ];
    __shared__ float qs[16 * 64];
    __shared__ float ws[16];
    __shared__ int cnt_sh;
    __shared__ int wsum[8];
    const int t = blockIdx.x, tid = threadIdx.x, n = t + 1;
    int* sel = SEL + (size_t)t * TOPK;
    if (n <= TOPK) { for (int i = tid; i < n; i += 256) sel[i] = i; if (tid == 0) CNT[t] = n; return; }
    for (int e = tid; e < 1024; e += 256) qs[e] = bf2f(IQ[(size_t)t * 1024 + e]);
    if (tid < 16) ws[tid] = IW[(size_t)t * 16 + tid];
    __syncthreads();
    for (int s = tid; s < n; s += 256) {
        float kv[64];
        const u16* kp = IK + (size_t)s * 64;
#pragma unroll
        for (int d = 0; d < 64; ++d) kv[d] = bf2f(kp[d]);
        float sc = 0.f;
        for (int h = 0; h < 16; ++h) { float dot = 0.f;
#pragma unroll
            for (int d = 0; d < 64; ++d) dot = fmaf(qs[h * 64 + d], kv[d], dot);
            sc = fmaf(ws[h], fmaxf(dot, 0.f), sc); }
        keys[s] = ord_key(sc);
    }
    __syncthreads();
    unsigned prefix = 0; int need = TOPK;
    for (int bit = 31; bit >= 0; --bit) {
        if (tid == 0) cnt_sh = 0;
        __syncthreads();
        unsigned want = (prefix >> bit) | 1u;
        int c = 0;
        for (int s = tid; s < n; s += 256) c += ((keys[s] >> bit) == want) ? 1 : 0;
        for (int o = 32; o > 0; o >>= 1) c += __shfl_xor(c, o);
        if ((tid & 63) == 0) atomicAdd(&cnt_sh, c);
        __syncthreads();
        int tot = cnt_sh;
        if (tot >= need) prefix |= (1u << bit); else need -= tot;
        __syncthreads();
    }
    int base_sel = 0, base_eq = 0;
    for (int c0 = 0; c0 < n; c0 += 256) {
        int s = c0 + tid; bool in = s < n;
        unsigned kk = in ? keys[s] : 0u;
        bool gt = in && kk > prefix, eq = in && kk == prefix;
        unsigned long long beq = __ballot(eq);
        int w = tid >> 6, lane = tid & 63;
        if (lane == 0) wsum[w] = __popcll(beq);
        __syncthreads();
        int eqpre = base_eq + __popcll(beq & ((1ull << lane) - 1ull));
        for (int i = 0; i < w; ++i) eqpre += wsum[i];
        int eqtot = wsum[0] + wsum[1] + wsum[2] + wsum[3];
        bool selv = gt || (eq && eqpre < need);
        unsigned long long bs = __ballot(selv);
        if (lane == 0) wsum[4 + w] = __popcll(bs);
        __syncthreads();
        int pos = base_sel + __popcll(bs & ((1ull << lane) - 1ull));
        for (int i = 0; i < w; ++i) pos += wsum[4 + i];
        if (selv && pos < TOPK) sel[pos] = s;
        base_sel += wsum[4] + wsum[5] + wsum[6] + wsum[7];
        base_eq += eqtot;
        __syncthreads();
    }
    if (tid == 0) CNT[t] = TOPK;
}

__device__ __forceinline__ int t5_bucket(int dist) {
    int nn = dist > 0 ? dist : 0;
    if (nn < 16) return nn;
    float nf = (float)nn;
    int large = 16 + (int)(logf(nf / 16.f) / 2.0794415416798357f * 16.f);
    return large < 31 ? large : 31;
}
__global__ void __launch_bounds__(256) nk_sparse_attn(const u16* __restrict__ AQ, const u16* __restrict__ KVA, const int* __restrict__ SEL, const int* __restrict__ CNT,
                               const int* __restrict__ pos, const float* __restrict__ relb, const u16* __restrict__ SZA, u16* __restrict__ UA) {
    __shared__ float qs[1024];
    __shared__ int sl[TOPK];
    __shared__ int bk[TOPK];
    __shared__ float pr[TOPK];
    __shared__ float red[4];
    const int t = blockIdx.x, tid = threadIdx.x;
    const int cnt = CNT[t];
    for (int e = tid; e < 1024; e += 256) qs[e] = bf2f(AQ[(size_t)t * 1024 + e]);
    if (tid < cnt) { int s = SEL[(size_t)t * TOPK + tid]; sl[tid] = s; bk[tid] = t5_bucket(pos[t] - pos[s]); }
    __syncthreads();
    for (int h = 0; h < 8; ++h) {
        const int g = h >> 2;
        float logit = -INFINITY;
        if (tid < cnt) {
            const u16* kp = KVA + ((size_t)sl[tid] * 2 + g) * 256;
            float dot = 0.f;
            for (int d = 0; d < 128; ++d) dot = fmaf(qs[h * 128 + d], bf2f(kp[d]), dot);
            logit = dot + relb[bk[tid] * 8 + h];
        }
        float mx = logit;
        for (int o = 32; o > 0; o >>= 1) mx = fmaxf(mx, __shfl_xor(mx, o));
        __syncthreads();
        if ((tid & 63) == 0) red[tid >> 6] = mx;
        __syncthreads();
        mx = fmaxf(fmaxf(red[0], red[1]), fmaxf(red[2], red[3]));
        float p = (tid < cnt) ? __expf(logit - mx) : 0.f;
        pr[tid] = p;
        float sum = block_sum_256(p, red);
        __syncthreads();
        if (tid < 128) {
            float acc = 0.f;
            for (int k = 0; k < cnt; ++k) acc = fmaf(pr[k], bf2f(KVA[((size_t)sl[k] * 2 + g) * 256 + 128 + tid]), acc);
            size_t idx = (size_t)t * 1024 + h * 128 + tid;
            UA[idx] = f2bf(acc / sum * bf2f(SZA[idx]));
        }
        __syncthreads();
    }
}

__global__ void __launch_bounds__(256) nk_merge(const float* __restrict__ Y, const u16* __restrict__ G, int n, float* __restrict__ MF, u16* __restrict__ MERGED) {
    size_t i = (size_t)blockIdx.x * 256 + threadIdx.x;
    if (i >= (size_t)SEQ * DM) return;
    size_t t = i / DM, d = i % DM;
    float v = bf2f(G[t * 6144 + (size_t)n * DM + d]) * Y[i];
    if (n > 0) v += MF[i];
    MF[i] = v;
    if (n == 2) MERGED[i] = f2bf(v);
}


typedef short bf16x8 __attribute__((ext_vector_type(8)));
typedef float f32x4 __attribute__((ext_vector_type(4)));
typedef float f32x16 __attribute__((ext_vector_type(16)));
typedef unsigned u32x4 __attribute__((ext_vector_type(4)));
typedef unsigned u32x2 __attribute__((ext_vector_type(2)));

constexpr size_t WS_LATQ = WS_CNT + 64 * 1024;
constexpr size_t WS_LATKV = WS_CNT + 128 * 1024;
constexpr size_t WS_PESS = WS_CNT + 192 * 1024;
constexpr int NT_IN = 54;
constexpr int WINT_ROWS = NT_IN * 256;

struct Params {
    const float* x; const float* mem; const int* positions; const float* rel_bias; const float* norm_g; const float* mem_norm_g;
    const float* w_in; const float* a_q_norm_g; const float* a_k_norm_g; const float* b_q_lat_norm_g; const float* b_kv_lat_norm_g;
    const float* w_b_uq; const float* w_b_ukv; const float* b_q_norm_g; const float* b_k_norm_g; const float* w_mem_kv;
    const float* c_q_norm_g; const float* c_k_norm_g; const float* w_branch; const float* w_out;
    char* ws; char* dout;
    int phase_lo, phase_hi;
};

__device__ __forceinline__ int opaque_tid() { int t = threadIdx.x; asm volatile("" : "+v"(t)); return t; }
__device__ __forceinline__ unsigned cvtpk(float lo, float hi) {
    unsigned r; asm volatile("v_cvt_pk_bf16_f32 %0, %1, %2" : "=v"(r) : "v"(lo), "v"(hi)); return r;
}

__device__ __forceinline__ int win_srccol(int n) {
    if (n < 3584) return n;
    if (n < 3840) { int j = n - 3584; if (j < 80) return 3584 + j; if (j < 144) return 4432 + (j - 80); return -1; }
    if (n < 4352) return 3664 + (n - 3840);
    if (n < 4608) return 4176 + (n - 4352);
    return 4496 + (n - 4608);
}
__device__ __forceinline__ int wuq_srccol(int n) {
    int h = n >> 8, j = n & 255;
    if (j < 128) return h * 192 + j;
    if (j < 192) { int p = j - 128, blk = p >> 5, within = p & 31, second = within >> 4, jj = blk * 16 + (within & 15);
        return h * 192 + 128 + second * 32 + jj; }
    return -1;
}
__device__ void phase_prep(const Params& p) {
    extern __shared__ __attribute__((aligned(16))) char smem[];
    int tid = opaque_tid(); int wid = tid >> 6, lane = tid & 63;
    for (int r = blockIdx.x * 8 + wid; r < SEQ + NMEM; r += gridDim.x * 8) {
        const float* src; const float* g; u16* dst;
        if (r < SEQ) { src = p.x + (size_t)r * DM; g = p.norm_g; dst = (u16*)(p.ws + WS_H) + (size_t)r * DM; }
        else { src = p.mem + (size_t)(r - SEQ) * DM; g = p.mem_norm_g; dst = (u16*)(p.ws + WS_HM) + (size_t)(r - SEQ) * DM; }
        f32x4 v[8]; float ss = 0.f;
#pragma unroll
        for (int i = 0; i < 8; ++i) { v[i] = ((const f32x4*)src)[lane + 64 * i]; ss += v[i][0] * v[i][0] + v[i][1] * v[i][1] + v[i][2] * v[i][2] + v[i][3] * v[i][3]; }
        for (int o = 32; o > 0; o >>= 1) ss += __shfl_xor(ss, o);
        const float rinv = rsqrtf(ss / (float)DM + EPS);
#pragma unroll
        for (int i = 0; i < 8; ++i) { f32x4 gg = ((const f32x4*)g)[lane + 64 * i];
            u32x2 w = {cvtpk(v[i][0] * rinv * gg[0], v[i][1] * rinv * gg[1]), cvtpk(v[i][2] * rinv * gg[2], v[i][3] * rinv * gg[3])};
            *(u32x2*)(dst + 4 * (lane + 64 * i)) = w; }
    }
    {
        tid = opaque_tid();
        float* cs = (float*)(p.ws + WS_COS); float* sn = (float*)(p.ws + WS_SIN);
        for (int i = blockIdx.x * 512 + tid; i < SEQ * 32; i += gridDim.x * 512) {
            int t = i >> 5, j = i & 31;
            float inv_freq = 1.0f / powf(10000.f, (float)(2 * j) / 64.f);
            float ang = (float)p.positions[t] * inv_freq;
            cs[i] = cosf(ang); sn[i] = sinf(ang);
        }
    }
    u16* tile = (u16*)smem;
    constexpr int T0 = 32 * 216, T1 = T0 + 8 * 32, T2 = T1 + 4 * 32, T3 = T2 + 32 * 32, T4 = T3 + 3 * 16 * 32, T5 = T4 + 32 * 32;
    for (int T = blockIdx.x; T < T5; T += gridDim.x) {
        const float* W; int ldw, K, kt, nt, mode = 0; const float* gs = nullptr; u16* dst;
        int tt;
        if (T < T0) { tt = T; W = p.w_in; ldw = INW; K = 2048; kt = 32; mode = 1; dst = (u16*)(p.ws + WS_WINT); }
        else if (T < T1) { tt = T - T0; W = p.w_b_uq; ldw = 1536; K = 512; kt = 8; mode = 2; gs = p.b_q_lat_norm_g; dst = (u16*)(p.ws + WS_WUQT); }
        else if (T < T2) { tt = T - T1; W = p.w_b_ukv; ldw = 2048; K = 256; kt = 4; gs = p.b_kv_lat_norm_g; dst = (u16*)(p.ws + WS_WUKVT); }
        else if (T < T3) { tt = T - T2; W = p.w_mem_kv; ldw = 2048; K = 2048; kt = 32; dst = (u16*)(p.ws + WS_WMEMT); }
        else if (T < T4) { tt = T - T3; int n = tt / 512; tt -= n * 512; W = p.w_branch + (size_t)n * 1024 * DM; ldw = DM; K = 1024; kt = 16;
                           dst = (u16*)(p.ws + WS_WBRT) + (size_t)n * DM * 1024; }
        else { tt = T - T4; W = p.w_out; ldw = DM; K = 2048; kt = 32; dst = (u16*)(p.ws + WS_WOUTT); }
        (void)nt;
        const int k0 = (tt % kt) * 64, n0 = (tt / kt) * 64;
        tid = opaque_tid();
        {
            const int r = tid >> 6, c = tid & 63, n = n0 + c;
            int sc = n; if (mode == 1) sc = win_srccol(n); else if (mode == 2) sc = wuq_srccol(n);
#pragma unroll
            for (int ps = 0; ps < 8; ++ps) { const int k = k0 + r + 8 * ps;
                float v = (sc >= 0) ? W[(size_t)k * ldw + sc] : 0.f;
                if (gs) v *= gs[k];
                tile[c * 72 + r + 8 * ps] = f2bf(v); }
        }
        __syncthreads();
        {
            const int c = tid >> 3, k8 = tid & 7;
            u32x4 w = *(const u32x4*)(tile + c * 72 + k8 * 8);
            *(u32x4*)(dst + (size_t)(n0 + c) * K + k0 + k8 * 8) = w;
        }
        __syncthreads();
    }
}

constexpr int G_HT = 128 * 64;
__device__ __forceinline__ int g_lds_byte(int r, int c) { int st = (r >> 4) * 2 + (c >> 5), rr = r & 15, cc = c & 31, ob = rr * 64 + cc * 2; return st * 1024 + (ob ^ (((ob >> 9) & 1) << 5)); }
__device__ __forceinline__ void g_stage_rc(int b, int& R, int& C) { int st = b / 1024, sb = b % 1024, swz = sb ^ (((sb >> 9) & 1) << 5); R = (st >> 1) * 16 + swz / 64; C = (st & 1) * 32 + (swz % 64) / 2; }

__device__ __forceinline__ void gemm_kloop(const u16* __restrict__ A, const u16* __restrict__ Bt, const int K, const int brow, const int bcol,
                                           f32x4 (&acc)[2][2][4][2]) {
    extern __shared__ __attribute__((aligned(16))) char smem[];
    u16* shm = (u16*)smem;
#define SA(b, h) (shm + ((b) * 2 + (h)) * G_HT)
#define SB(b, h) (shm + (4 + (b) * 2 + (h)) * G_HT)
#define STAGE(P, RS, br, kt) do { const int _so = ((br) * K + (kt) * 64) * 2; \
    __builtin_amdgcn_raw_ptr_buffer_load_lds(RS, (__attribute__((address_space(3))) void*)((char*)(P) + tid_ * 16), 16, voff0, _so, 0, 0); \
    __builtin_amdgcn_raw_ptr_buffer_load_lds(RS, (__attribute__((address_space(3))) void*)((char*)(P) + tid_ * 16 + 8192), 16, voff1, _so, 0, 0); } while (0)
#define LDA(dst, b, h) for (int m = 0; m < 4; ++m) for (int k = 0; k < 2; ++k) \
    dst[m][k] = *reinterpret_cast<const bf16x8*>((char*)SA(b, h) + g_lds_byte(wr * 64 + m * 16 + fr, k * 32 + fq * 8))
#define LDB(dst, b, h) for (int n = 0; n < 2; ++n) for (int k = 0; k < 2; ++k) \
    dst[n][k] = *reinterpret_cast<const bf16x8*>((char*)SB(b, h) + g_lds_byte(wc * 32 + n * 16 + fr, k * 32 + fq * 8))
#define MMA(ai, bj, At_, Bt_) do { __builtin_amdgcn_s_setprio(1); \
    for (int m = 0; m < 4; ++m) for (int n = 0; n < 2; ++n) for (int k = 0; k < 2; ++k) \
      acc[ai][bj][m][n] = __builtin_amdgcn_mfma_f32_16x16x32_bf16(At_[m][k], Bt_[n][k], acc[ai][bj][m][n], 0, 0, 0); \
    __builtin_amdgcn_s_setprio(0); } while (0)
#define WAIT_V(n) asm volatile("s_waitcnt vmcnt(" #n ")" ::: "memory")
#define WAIT_L(n) asm volatile("s_waitcnt lgkmcnt(" #n ")" ::: "memory")
#define BAR __builtin_amdgcn_s_barrier()
#define SCHED __builtin_amdgcn_sched_barrier(0)
    const int tid_ = opaque_tid();
    const int wid = tid_ >> 6, lane = tid_ & 63, wr = wid >> 2, wc = wid & 3, fr = lane & 15, fq = lane >> 4;
#pragma unroll
    for (int a = 0; a < 2; ++a)
#pragma unroll
        for (int b = 0; b < 2; ++b)
#pragma unroll
            for (int m = 0; m < 4; ++m)
#pragma unroll
                for (int n = 0; n < 2; ++n) acc[a][b][m][n] = f32x4{0.f, 0.f, 0.f, 0.f};
    bf16x8 At[4][2], B0[2][2], B1[2][2];
    const int nt = K / 64;
    const __amdgpu_buffer_rsrc_t rsA = __builtin_amdgcn_make_buffer_rsrc((void*)A, (short)0, 0x7fffffff, 0x00020000);
    const __amdgpu_buffer_rsrc_t rsB = __builtin_amdgcn_make_buffer_rsrc((void*)Bt, (short)0, 0x7fffffff, 0x00020000);
    int voff0, voff1;
    { int _r, _c; g_stage_rc(tid_ * 16, _r, _c); voff0 = (_r * K + _c) * 2; g_stage_rc(tid_ * 16 + 8192, _r, _c); voff1 = (_r * K + _c) * 2; }
    STAGE(SB(0, 0), rsB, bcol, 0); STAGE(SA(0, 0), rsA, brow, 0);
    STAGE(SB(0, 1), rsB, bcol + 128, 0); STAGE(SA(0, 1), rsA, brow + 128, 0);
    if (wr == 1) BAR;
    WAIT_V(4); BAR;
    STAGE(SB(1, 0), rsB, bcol, 1); STAGE(SA(1, 0), rsA, brow, 1); STAGE(SB(1, 1), rsB, bcol + 128, 1);
    WAIT_V(6); BAR;
    for (int t = 0; t < nt - 2; t += 2) {
        LDB(B0, 0, 0); SCHED; LDA(At, 0, 0); STAGE(SA(1, 1), rsA, brow + 128, t + 1);
        WAIT_L(8); BAR; WAIT_L(0); MMA(0, 0, At, B0); BAR; SCHED;
        LDB(B1, 0, 1); STAGE(SB(0, 0), rsB, bcol, t + 2);
        BAR; WAIT_L(0); MMA(0, 1, At, B1); BAR;
        LDA(At, 0, 1); STAGE(SA(0, 0), rsA, brow, t + 2);
        BAR; WAIT_L(0); MMA(1, 0, At, B0); BAR; SCHED;
        STAGE(SB(0, 1), rsB, bcol + 128, t + 2);
        WAIT_V(6); BAR; MMA(1, 1, At, B1); BAR;
        LDB(B0, 1, 0); SCHED; LDA(At, 1, 0); STAGE(SA(0, 1), rsA, brow + 128, t + 2);
        WAIT_L(8); BAR; WAIT_L(0); MMA(0, 0, At, B0); BAR; SCHED;
        LDB(B1, 1, 1); STAGE(SB(1, 0), rsB, bcol, t + 3);
        BAR; WAIT_L(0); MMA(0, 1, At, B1); BAR;
        LDA(At, 1, 1); STAGE(SA(1, 0), rsA, brow, t + 3);
        BAR; WAIT_L(0); MMA(1, 0, At, B0); BAR; SCHED;
        STAGE(SB(1, 1), rsB, bcol + 128, t + 3);
        WAIT_V(6); BAR; MMA(1, 1, At, B1); BAR;
    }
    { LDB(B0, 0, 0); LDA(At, 0, 0); STAGE(SA(1, 1), rsA, brow + 128, nt - 1);
      BAR; WAIT_L(0); MMA(0, 0, At, B0); BAR;
      LDB(B1, 0, 1); BAR; WAIT_L(0); MMA(0, 1, At, B1); BAR;
      LDA(At, 0, 1); WAIT_V(4); BAR; WAIT_L(0); MMA(1, 0, At, B0); MMA(1, 1, At, B1); BAR; }
    { LDB(B0, 1, 0); LDA(At, 1, 0); WAIT_V(2); BAR; WAIT_L(0); MMA(0, 0, At, B0); BAR;
      LDB(B1, 1, 1); WAIT_V(0); BAR; WAIT_L(0); MMA(0, 1, At, B1); BAR;
      LDA(At, 1, 1); BAR; WAIT_L(0); MMA(1, 0, At, B0); MMA(1, 1, At, B1); BAR; }
    if (wr == 0) BAR;
#undef SA
#undef SB
#undef STAGE
#undef LDA
#undef LDB
#undef MMA
}

constexpr int EPT_LD = 260;
template <int AI>
__device__ __forceinline__ void acc_half_to_lds(const f32x4 (&acc)[2][2][4][2]) {
    extern __shared__ __attribute__((aligned(16))) char smem[];
    float* T = (float*)smem;
    const int tid_ = opaque_tid();
    const int wid = tid_ >> 6, lane = tid_ & 63, wr = wid >> 2, wc = wid & 3, fr = lane & 15, fq = lane >> 4;
    float* base = T + (wr * 64 + fq * 4) * EPT_LD + wc * 32 + fr;
#pragma unroll
    for (int bj = 0; bj < 2; ++bj)
#pragma unroll
        for (int m = 0; m < 4; ++m)
#pragma unroll
            for (int n = 0; n < 2; ++n)
#pragma unroll
                for (int j = 0; j < 4; ++j) base[(m * 16 + j) * EPT_LD + bj * 128 + n * 16] = acc[AI][bj][m][n][j];
}
__device__ __forceinline__ float wave_sum64(float v) { for (int o = 32; o > 0; o >>= 1) v += __shfl_xor(v, o); return v; }
__device__ __forceinline__ float wave_sum32(float v) { for (int o = 16; o > 0; o >>= 1) v += __shfl_xor(v, o); return v; }
__device__ __forceinline__ void store4_bf16(u16* p, float a, float b, float c, float d) { u32x2 w = {cvtpk(a, b), cvtpk(c, d)}; *(u32x2*)p = w; }

enum { EP_RAW = 0, EP_SILU = 1, EP_SIGMOID = 2, EP_NORM128 = 3, EP_NORM256 = 4, EP_RAW_SS = 5, EP_MISC = 6 };

__device__ __forceinline__ void epi_rows_inproj(const int mode, const int grow0, u16* __restrict__ dst, const int ld, const int half_skip,
                                                const float* __restrict__ g, const float scale, float* __restrict__ ssout, const int ss_stride, const Params& p) {
    extern __shared__ __attribute__((aligned(16))) char smem[];
    const float* T = (const float*)smem;
    const int tid_ = opaque_tid();
    const int wid = tid_ >> 6, lane = tid_ & 63;
    const int col = lane * 4;
    f32x4 gg = {1.f, 1.f, 1.f, 1.f};
    if (mode == EP_NORM128) gg = *(const f32x4*)(g + (col & 127));
    else if (mode == EP_NORM256) gg = *(const f32x4*)(g + col);
    for (int rr = 0; rr < 16; ++rr) {
        const int lr = wid * 16 + rr; const size_t row = (size_t)(grow0 + lr);
        f32x4 v = *(const f32x4*)(T + lr * EPT_LD + col);
        if (mode == EP_MISC) {
            u16* IK = (u16*)(p.ws + WS_IK); float* IW = (float*)(p.ws + WS_IW); float* BKPE = (float*)(p.ws + WS_BKPE); float* PESS = (float*)(p.ws + WS_PESS);
            const bool pe = (lane >= 20 && lane < 36);
            float ss = pe ? (v[0] * v[0] + v[1] * v[1] + v[2] * v[2] + v[3] * v[3]) : 0.f;
            ss = wave_sum64(ss);
            if (lane < 16) store4_bf16(IK + row * 64 + col, v[0], v[1], v[2], v[3]);
            else if (lane < 20) *(f32x4*)(IW + row * 16 + (col - 64)) = v;
            else if (lane < 36) *(f32x4*)(BKPE + row * 64 + (col - 80)) = v;
            if (lane == 0) PESS[row] = ss;
            continue;
        }
        if (mode == EP_SILU) { v[0] = silu_f(v[0]); v[1] = silu_f(v[1]); v[2] = silu_f(v[2]); v[3] = silu_f(v[3]); }
        else if (mode == EP_SIGMOID) { v[0] = sigmoid_f(v[0]); v[1] = sigmoid_f(v[1]); v[2] = sigmoid_f(v[2]); v[3] = sigmoid_f(v[3]); }
        else if (mode >= EP_NORM128) {
            float ss = v[0] * v[0] + v[1] * v[1] + v[2] * v[2] + v[3] * v[3];
            if (mode == EP_NORM128) { ss = wave_sum32(ss); const float rinv = rsqrtf(ss * (1.f / 128.f) + EPS) * scale; v[0] *= rinv * gg[0]; v[1] *= rinv * gg[1]; v[2] *= rinv * gg[2]; v[3] *= rinv * gg[3]; }
            else { ss = wave_sum64(ss);
                if (mode == EP_NORM256) { const float rinv = rsqrtf(ss * (1.f / 256.f) + EPS) * scale; v[0] *= rinv * gg[0]; v[1] *= rinv * gg[1]; v[2] *= rinv * gg[2]; v[3] *= rinv * gg[3]; }
                else if (lane == 0) ssout[row * ss_stride] = ss; }
        }
        store4_bf16(dst + row * ld + col + (lane >= 32 ? half_skip : 0), v[0], v[1], v[2], v[3]);
    }
}

__device__ void phase_inproj(const Params& p) {
    const int r = blockIdx.x, xcd = r & 7, slot = r >> 3, mi = slot >> 3, ni = slot & 7;
    f32x4 acc[2][2][4][2];
    for (int w = 0; w < 7; ++w) {
        const int pm = xcd * 4 + mi, pn = w * 8 + ni;
        const bool inproj = pn < NT_IN;
        if (!inproj && !(ni == 6 && pm < 8)) continue;
        {
            const u16* A_ = (const u16*)(p.ws + (inproj ? WS_H : WS_HM)); const u16* B_ = (const u16*)(p.ws + (inproj ? WS_WINT : WS_WMEMT));
            gemm_kloop(A_, B_, DM, inproj ? pm * 256 : 0, inproj ? pn * 256 : pm * 256, acc);
        }
        int mode; size_t dsto; int ld, half_skip = 0, brow; const float* g = nullptr; float scale = 1.f; size_t sso = 0; int ss_stride = 0;
        if (inproj) {
            brow = pm * 256;
            if (pn < 4) { mode = EP_NORM128; dsto = WS_AQ + pn * 512; ld = 1024; g = p.a_q_norm_g; scale = A_SCALE; }
            else if (pn == 4) { mode = EP_NORM128; dsto = WS_KVA; ld = 512; half_skip = 128; g = p.a_k_norm_g; }
            else if (pn == 5) { mode = EP_RAW; dsto = WS_KVA + 256; ld = 512; half_skip = 128; }
            else if (pn < 10) { mode = EP_SILU; dsto = WS_SZA + (pn - 6) * 512; ld = 1024; }
            else if (pn < 14) { mode = EP_RAW; dsto = WS_IQ + (pn - 10) * 512; ld = 1024; }
            else if (pn == 14) { mode = EP_MISC; dsto = 0; ld = 0; }
            else if (pn < 17) { mode = EP_RAW_SS; dsto = WS_BCQ + (pn - 15) * 512; ld = 512; sso = WS_LATQ + (pn - 15) * 4; ss_stride = 2; }
            else if (pn == 17) { mode = EP_RAW_SS; dsto = WS_BCKV; ld = 256; sso = WS_LATKV; ss_stride = 1; }
            else if (pn < 22) { mode = EP_SILU; dsto = WS_SZB + (pn - 18) * 512; ld = 1024; }
            else if (pn < 26) { mode = EP_NORM256; dsto = WS_CQ + (pn - 22) * 512; ld = 1024; g = p.c_q_norm_g; scale = C_SCALE; }
            else if (pn < 30) { mode = EP_SILU; dsto = WS_SZC + (pn - 26) * 512; ld = 1024; }
            else { mode = EP_SIGMOID; dsto = WS_G + (pn - 30) * 512; ld = 6144; }
        } else {
            brow = 0; ld = 1024;
            if (pm < 4) { mode = EP_NORM256; dsto = WS_CK + pm * 512; g = p.c_k_norm_g; }
            else { mode = EP_RAW; dsto = WS_CV + (pm - 4) * 512; }
        }
#pragma unroll 1
        for (int half = 0; half < 2; ++half) {
            __syncthreads();
            if (half == 0) acc_half_to_lds<0>(acc); else acc_half_to_lds<1>(acc);
            __syncthreads();
            epi_rows_inproj(mode, brow + half * 128, (u16*)(p.ws + dsto), ld, half_skip, g, scale, (float*)(p.ws + sso), ss_stride, p);
        }
        __syncthreads();
    }
}

__device__ __forceinline__ void epi_rows_mla_q(const int grow0, const int h, const Params& p) {
    extern __shared__ __attribute__((aligned(16))) char smem[];
    const float* T = (const float*)smem;
    const int tid_ = opaque_tid(); const int wid = tid_ >> 6, lane = tid_ & 63, col = lane * 4;
    const float* LATQ = (const float*)(p.ws + WS_LATQ); const float* COS = (const float*)(p.ws + WS_COS); const float* SIN = (const float*)(p.ws + WS_SIN);
    u16* QB = (u16*)(p.dout + DO_QB) + (size_t)h * SEQ * 192;
    const int pp = (col - 128) & 63, blk = pp >> 5, within = pp & 31, second = within >> 4, jj = blk * 16 + (within & 15);
    f32x4 gg = {0.f, 0.f, 0.f, 0.f};
    if (lane < 32) gg = *(const f32x4*)(p.b_q_norm_g + col);
    else if (lane < 48) gg = *(const f32x4*)(p.b_q_norm_g + 128 + second * 32 + jj);
    for (int rr = 0; rr < 16; ++rr) {
        const int lr = wid * 16 + rr; const size_t t = (size_t)(grow0 + lr);
        f32x4 v = *(const f32x4*)(T + lr * EPT_LD + col);
        const float rlat = rsqrtf((LATQ[t * 2] + LATQ[t * 2 + 1]) * (1.f / 512.f) + EPS);
        v[0] *= rlat; v[1] *= rlat; v[2] *= rlat; v[3] *= rlat;
        float ss = v[0] * v[0] + v[1] * v[1] + v[2] * v[2] + v[3] * v[3];
        ss = wave_sum64(ss);
        const float rinv = rsqrtf(ss * (1.f / 192.f) + EPS);
        v[0] *= rinv * gg[0]; v[1] *= rinv * gg[1]; v[2] *= rinv * gg[2]; v[3] *= rinv * gg[3];
        f32x4 o;
        o[0] = __shfl_xor(v[0], 4); o[1] = __shfl_xor(v[1], 4); o[2] = __shfl_xor(v[2], 4); o[3] = __shfl_xor(v[3], 4);
        if (lane >= 32 && lane < 48) {
            const f32x4 c = *(const f32x4*)(COS + t * 32 + jj), s = *(const f32x4*)(SIN + t * 32 + jj);
#pragma unroll
            for (int e = 0; e < 4; ++e) v[e] = second ? (v[e] * c[e] + o[e] * s[e]) : (v[e] * c[e] - o[e] * s[e]);
        }
        if (lane < 48) store4_bf16(QB + t * 192 + col, v[0] * B_SCALE, v[1] * B_SCALE, v[2] * B_SCALE, v[3] * B_SCALE);
    }
}
__device__ __forceinline__ void epi_rows_mla_kv(const int grow0, const int h, const Params& p) {
    extern __shared__ __attribute__((aligned(16))) char smem[];
    const float* T = (const float*)smem;
    const int tid_ = opaque_tid(); const int wid = tid_ >> 6, lane = tid_ & 63, col = lane * 4;
    const float* LATKV = (const float*)(p.ws + WS_LATKV); const float* PESS = (const float*)(p.ws + WS_PESS); const float* BKPE = (const float*)(p.ws + WS_BKPE);
    const float* COS = (const float*)(p.ws + WS_COS); const float* SIN = (const float*)(p.ws + WS_SIN);
    u16* KB = (u16*)(p.dout + DO_KB) + (size_t)h * SEQ * 192; u16* VB = (u16*)(p.dout + DO_VB) + (size_t)h * SEQ * 128;
    f32x4 gg = {1.f, 1.f, 1.f, 1.f};
    if (lane < 32) gg = *(const f32x4*)(p.b_k_norm_g + col);
    const int jj = (lane & 7) * 4;
    const f32x4 g1 = *(const f32x4*)(p.b_k_norm_g + 128 + jj), g2 = *(const f32x4*)(p.b_k_norm_g + 160 + jj);
    for (int rr = 0; rr < 16; ++rr) {
        const int lr = wid * 16 + rr; const size_t t = (size_t)(grow0 + lr);
        f32x4 v = *(const f32x4*)(T + lr * EPT_LD + col);
        const float rlat = rsqrtf(LATKV[t] * (1.f / 256.f) + EPS);
        v[0] *= rlat; v[1] *= rlat; v[2] *= rlat; v[3] *= rlat;
        float ss = v[0] * v[0] + v[1] * v[1] + v[2] * v[2] + v[3] * v[3];
        ss = wave_sum32(ss);
        const float rinv = rsqrtf((ss + PESS[t]) * (1.f / 192.f) + EPS);
        if (lane < 32) store4_bf16(KB + t * 192 + col, v[0] * rinv * gg[0], v[1] * rinv * gg[1], v[2] * rinv * gg[2], v[3] * rinv * gg[3]);
        else store4_bf16(VB + t * 128 + (col - 128), v[0], v[1], v[2], v[3]);
        if (lane < 8) {
            const f32x4 x1 = *(const f32x4*)(BKPE + t * 64 + jj), x2 = *(const f32x4*)(BKPE + t * 64 + 32 + jj);
            const f32x4 c = *(const f32x4*)(COS + t * 32 + jj), s = *(const f32x4*)(SIN + t * 32 + jj);
            float o1[4], o2[4];
#pragma unroll
            for (int e = 0; e < 4; ++e) { const float a = x1[e] * rinv * g1[e], b = x2[e] * rinv * g2[e]; o1[e] = a * c[e] - b * s[e]; o2[e] = b * c[e] + a * s[e]; }
            store4_bf16(KB + t * 192 + 128 + rope_phys(jj, 0), o1[0], o1[1], o1[2], o1[3]);
            store4_bf16(KB + t * 192 + 128 + rope_phys(jj, 1), o2[0], o2[1], o2[2], o2[3]);
        }
    }
}
__device__ void phase_mla_up(const Params& p) {
    const int r = blockIdx.x, xcd = r & 7, slot = r >> 3, pm = xcd * 4 + (slot >> 3), h = slot & 7;
    f32x4 acc[2][2][4][2];
#pragma unroll 1
    for (int which = 0; which < 2; ++which) {
        if (which == 0) gemm_kloop((const u16*)(p.ws + WS_BCQ), (const u16*)(p.ws + WS_WUQT), 512, pm * 256, h * 256, acc);
        else gemm_kloop((const u16*)(p.ws + WS_BCKV), (const u16*)(p.ws + WS_WUKVT), 256, pm * 256, h * 256, acc);
#pragma unroll 1
        for (int half = 0; half < 2; ++half) {
            __syncthreads();
            if (half == 0) acc_half_to_lds<0>(acc); else acc_half_to_lds<1>(acc);
            __syncthreads();
            if (which == 0) epi_rows_mla_q(pm * 256 + half * 128, h, p); else epi_rows_mla_kv(pm * 256 + half * 128, h, p);
        }
        __syncthreads();
    }
}

__device__ __forceinline__ void epi_rows_merge(const int grow0, const int pd, const int n, const Params& p) {
    extern __shared__ __attribute__((aligned(16))) char smem[];
    const float* T = (const float*)smem;
    const int tid_ = opaque_tid(); const int wid = tid_ >> 6, lane = tid_ & 63, col = lane * 4;
    const u16* G = (const u16*)(p.ws + WS_G); float* M = (float*)p.dout; u16* MERGED = (u16*)(p.ws + WS_MERGED);
    for (int rr = 0; rr < 16; ++rr) {
        const int lr = wid * 16 + rr; const size_t t = (size_t)(grow0 + lr);
        f32x4 v = *(const f32x4*)(T + lr * EPT_LD + col);
        const u32x2 gw = *(const u32x2*)(G + t * 6144 + n * 2048 + pd * 256 + col);
        const float g0 = __uint_as_float(gw[0] << 16), g1 = __uint_as_float(gw[0] & 0xffff0000u), g2 = __uint_as_float(gw[1] << 16), g3 = __uint_as_float(gw[1] & 0xffff0000u);
        v[0] *= g0; v[1] *= g1; v[2] *= g2; v[3] *= g3;
        float* mp = M + t * DM + pd * 256 + col;
        if (n > 0) { const f32x4 mv = *(const f32x4*)mp; v[0] += mv[0]; v[1] += mv[1]; v[2] += mv[2]; v[3] += mv[3]; }
        if (n < 2) *(f32x4*)mp = v;
        else store4_bf16(MERGED + t * DM + pd * 256 + col, v[0], v[1], v[2], v[3]);
    }
}
__device__ void phase_merge(const Params& p) {
    const int r = blockIdx.x, xcd = r & 7, slot = r >> 3, pm = xcd * 4 + (slot >> 3), pd = slot & 7;
    f32x4 acc[2][2][4][2];
#pragma unroll 1
    for (int n = 0; n < 3; ++n) {
        const u16* U = (const u16*)(p.ws + (n == 0 ? WS_UA : (n == 1 ? WS_UB : WS_UC)));
        gemm_kloop(U, (const u16*)(p.ws + WS_WBRT) + (size_t)n * DM * 1024, 1024, pm * 256, pd * 256, acc);
#pragma unroll 1
        for (int half = 0; half < 2; ++half) {
            __syncthreads();
            if (half == 0) acc_half_to_lds<0>(acc); else acc_half_to_lds<1>(acc);
            __syncthreads();
            epi_rows_merge(pm * 256 + half * 128, pd, n, p);
        }
        __syncthreads();
    }
}
__device__ __forceinline__ void epi_rows_out(const int grow0, const int pd, const Params& p) {
    extern __shared__ __attribute__((aligned(16))) char smem[];
    const float* T = (const float*)smem;
    const int tid_ = opaque_tid(); const int wid = tid_ >> 6, lane = tid_ & 63, col = lane * 4;
    float* OUT = (float*)p.dout;
    for (int rr = 0; rr < 16; ++rr) {
        const int lr = wid * 16 + rr; const size_t t = (size_t)(grow0 + lr);
        f32x4 v = *(const f32x4*)(T + lr * EPT_LD + col);
        const f32x4 xv = *(const f32x4*)(p.x + t * DM + pd * 256 + col);
        v[0] += xv[0]; v[1] += xv[1]; v[2] += xv[2]; v[3] += xv[3];
        *(f32x4*)(OUT + t * DM + pd * 256 + col) = v;
    }
}
__device__ void phase_out(const Params& p) {
    const int r = blockIdx.x, xcd = r & 7, slot = r >> 3, pm = xcd * 4 + (slot >> 3), pd = slot & 7;
    f32x4 acc[2][2][4][2];
    gemm_kloop((const u16*)(p.ws + WS_MERGED), (const u16*)(p.ws + WS_WOUTT), DM, pm * 256, pd * 256, acc);
#pragma unroll 1
    for (int half = 0; half < 2; ++half) {
        __syncthreads();
        if (half == 0) acc_half_to_lds<0>(acc); else acc_half_to_lds<1>(acc);
        __syncthreads();
        epi_rows_out(pm * 256 + half * 128, pd, p);
    }
    __syncthreads();
}

typedef short s16x4 __attribute__((ext_vector_type(4)));
constexpr float LOG2E = 1.4426950408889634f;
constexpr int MLA_KT = 12288, MLA_VT = 8192, MLA_GRP = MLA_KT + MLA_VT, MLA_BUF = 2 * MLA_GRP;
__device__ __forceinline__ int crow16(int r, int hi) { return (r & 3) + 8 * (r >> 2) + 4 * hi; }

__device__ void mla_qblock(const Params& p, const int h, const int qb) {
    extern __shared__ __attribute__((aligned(16))) char smem[];
    const int tid_ = opaque_tid();
    const int wid = __builtin_amdgcn_readfirstlane(tid_ >> 6), lane = tid_ & 63, r32 = lane & 31, hi = lane >> 5;
    const int grp = wid >> 2, wq = wid & 3;
    const int R0 = qb * 128, qrow = R0 + wq * 32 + r32;
    const int n_it = 2 * (qb + 1);
    const u16* QB = (const u16*)(p.dout + DO_QB) + ((size_t)h * SEQ + qrow) * 192;
    const __amdgpu_buffer_rsrc_t rs = __builtin_amdgcn_make_buffer_rsrc((void*)p.dout, (short)0, 0x7fffffff, 0x00020000);
    bf16x8 qr[12];
#pragma unroll
    for (int d0 = 0; d0 < 12; ++d0) qr[d0] = *(const bf16x8*)(QB + d0 * 16 + hi * 8);
    int voff[5];
#pragma unroll
    for (int i = 0; i < 5; ++i) {
        const int pc = wq * 5 + i;
        if (pc < 12) { const int o = pc * 1024 + lane * 16, row = o / 384, cpos = (o - row * 384) >> 4, f = (row >> 1) & 7;
            const int chunk = (cpos & ~7) | ((cpos & 7) ^ f); voff[i] = row * 384 + chunk * 16; }
        else { const int o = (pc - 12) * 1024 + lane * 16, sub = o >> 8, ksub = sub >> 2, csub = sub & 3, kq = (o & 255) >> 6, cc = (o & 63) >> 4;
            voff[i] = (ksub * 4 + kq) * 256 + (csub * 4 + cc) * 16; }
    }
    const int kbase = (int)DO_KB + h * SEQ * 384, vbase = (int)DO_VB + h * SEQ * 256;
#define MLA_DMA(it_) do { const int key0_ = (it_) * 64 + grp * 32; char* img_ = smem + ((it_) % 3) * MLA_BUF + grp * MLA_GRP; \
    _Pragma("unroll") for (int i = 0; i < 5; ++i) { const int pc = wq * 5 + i; \
        const int so_ = (pc < 12) ? (kbase + key0_ * 384) : (vbase + key0_ * 256); \
        __builtin_amdgcn_raw_ptr_buffer_load_lds(rs, (__attribute__((address_space(3))) void*)(img_ + pc * 1024 + lane * 16), 16, voff[i], so_, 0, 0); } } while (0)
    int kaddr[4];
    { const int f = (r32 >> 1) & 7;
#pragma unroll
      for (int a = 0; a < 4; ++a) kaddr[a] = r32 * 384 + 16 * ((2 * a + hi) ^ f); }
    const int vlane = hi * 1024 + ((lane & 15) >> 2) * 64 + ((lane >> 4) & 1) * 32 + (lane & 3) * 8;
    f32x16 o[4];
#pragma unroll
    for (int d = 0; d < 4; ++d)
#pragma unroll
        for (int r = 0; r < 16; ++r) o[d][r] = 0.f;
    float m_run = -1e30f, l_run = 0.f;
    asm volatile("s_waitcnt vmcnt(0)" ::: "memory");
    __builtin_amdgcn_s_barrier();
    MLA_DMA(0);
    if (n_it > 1) MLA_DMA(1);
    for (int it = 0; it < n_it; ++it) {
        if (it + 1 < n_it) asm volatile("s_waitcnt vmcnt(5)" ::: "memory"); else asm volatile("s_waitcnt vmcnt(0)" ::: "memory");
        __builtin_amdgcn_s_barrier();
        if (it + 2 < n_it) MLA_DMA(it + 2);
        const int key0 = it * 64 + grp * 32;
        if (key0 <= R0 + wq * 32 + 31) {
            const char* Kt = smem + (it % 3) * MLA_BUF + grp * MLA_GRP;
            const int vt = (int)(uintptr_t)(Kt + MLA_KT) + vlane;
            f32x16 pt;
#pragma unroll
            for (int r = 0; r < 16; ++r) pt[r] = 0.f;
#pragma unroll
            for (int d0 = 0; d0 < 12; ++d0) {
                const bf16x8 kf = *(const bf16x8*)(Kt + kaddr[d0 & 3] + (d0 >> 2) * 128);
                pt = __builtin_amdgcn_mfma_f32_32x32x16_bf16(kf, qr[d0], pt, 0, 0, 0);
            }
            if (key0 + 31 > R0 + wq * 32) {
#pragma unroll
                for (int r = 0; r < 16; ++r) if (key0 + crow16(r, hi) > qrow) pt[r] = -INFINITY;
            }
            float pmax = pt[0];
#pragma unroll
            for (int r = 1; r < 16; ++r) pmax = fmaxf(pmax, pt[r]);
            { auto rr = __builtin_amdgcn_permlane32_swap(__float_as_uint(pmax), __float_as_uint(pmax), false, false);
              pmax = fmaxf(__uint_as_float(rr[0]), __uint_as_float(rr[1])); }
            const float mn = fmaxf(m_run, pmax);
            const float alpha = __builtin_amdgcn_exp2f((m_run - mn) * LOG2E);
            const float mneg = -mn * LOG2E;
            m_run = mn;
            float ps = 0.f;
#pragma unroll
            for (int r = 0; r < 16; ++r) { pt[r] = __builtin_amdgcn_exp2f(fmaf(pt[r], LOG2E, mneg)); ps += pt[r]; }
            { auto rr = __builtin_amdgcn_permlane32_swap(__float_as_uint(ps), __float_as_uint(ps), false, false);
              ps = __uint_as_float(rr[0]) + __uint_as_float(rr[1]); }
            l_run = l_run * alpha + ps;
            if (__any(alpha != 1.f)) {
#pragma unroll
                for (int d = 0; d < 4; ++d)
#pragma unroll
                    for (int r = 0; r < 16; ++r) o[d][r] *= alpha;
            }
            bf16x8 pa[2];
#pragma unroll
            for (int s = 0; s < 2; ++s) { u32x4 w = {cvtpk(pt[8 * s + 0], pt[8 * s + 1]), cvtpk(pt[8 * s + 2], pt[8 * s + 3]), cvtpk(pt[8 * s + 4], pt[8 * s + 5]), cvtpk(pt[8 * s + 6], pt[8 * s + 7])};
                pa[s] = *reinterpret_cast<bf16x8*>(&w); }
#define TRRD(dst, off) asm volatile("ds_read_b64_tr_b16 %0, %1 offset:%2" : "=&v"(dst) : "v"(vt), "i"(off) : "memory")
#define MLA_PV(d0) do { s16x4 a0, a1, b0, b1; TRRD(a0, (d0) * 256); TRRD(a1, (d0) * 256 + 2048); TRRD(b0, (d0) * 256 + 4096); TRRD(b1, (d0) * 256 + 6144); \
            asm volatile("s_waitcnt lgkmcnt(0)" ::: "memory"); __builtin_amdgcn_sched_barrier(0); \
            o[d0] = __builtin_amdgcn_mfma_f32_32x32x16_bf16((bf16x8){a0[0], a0[1], a0[2], a0[3], a1[0], a1[1], a1[2], a1[3]}, pa[0], o[d0], 0, 0, 0); \
            o[d0] = __builtin_amdgcn_mfma_f32_32x32x16_bf16((bf16x8){b0[0], b0[1], b0[2], b0[3], b1[0], b1[1], b1[2], b1[3]}, pa[1], o[d0], 0, 0, 0); } while (0)
            MLA_PV(0); MLA_PV(1); MLA_PV(2); MLA_PV(3);
#undef MLA_PV
#undef TRRD
        }
    }
#undef MLA_DMA
    __builtin_amdgcn_s_barrier();
    float* cmb = (float*)smem + (size_t)wq * 66 * 64;
    if (grp == 1) {
#pragma unroll
        for (int d = 0; d < 4; ++d)
#pragma unroll
            for (int r = 0; r < 16; ++r) cmb[(d * 16 + r) * 64 + lane] = o[d][r];
        cmb[64 * 64 + lane] = m_run; cmb[65 * 64 + lane] = l_run;
    }
    __syncthreads();
    if (grp == 0) {
        const float m1 = cmb[64 * 64 + lane], l1 = cmb[65 * 64 + lane];
        const float mn = fmaxf(m_run, m1);
        const float a0 = __builtin_amdgcn_exp2f((m_run - mn) * LOG2E), a1 = __builtin_amdgcn_exp2f((m1 - mn) * LOG2E);
        const float linv = 1.f / (l_run * a0 + l1 * a1);
        const float s0 = a0 * linv, s1 = a1 * linv;
        const u16* SZ = (const u16*)(p.ws + WS_SZB) + (size_t)qrow * 1024 + h * 128;
        u16* UB = (u16*)(p.ws + WS_UB) + (size_t)qrow * 1024 + h * 128;
#pragma unroll
        for (int d = 0; d < 4; ++d)
#pragma unroll
            for (int a = 0; a < 4; ++a) {
                const int dim = d * 32 + 8 * a + 4 * hi;
                const u32x2 zw = *(const u32x2*)(SZ + dim);
                float v[4];
#pragma unroll
                for (int b = 0; b < 4; ++b) v[b] = o[d][4 * a + b] * s0 + cmb[(d * 16 + 4 * a + b) * 64 + lane] * s1;
                v[0] *= __uint_as_float(zw[0] << 16); v[1] *= __uint_as_float(zw[0] & 0xffff0000u); v[2] *= __uint_as_float(zw[1] << 16); v[3] *= __uint_as_float(zw[1] & 0xffff0000u);
                store4_bf16(UB + dim, v[0], v[1], v[2], v[3]);
            }
    }
    __syncthreads();
}
__device__ void phase_mla_attn(const Params& p) {
    const int h = blockIdx.x & 7, i = blockIdx.x >> 3;
    mla_qblock(p, h, 63 - i);
    mla_qblock(p, h, i);
}

constexpr int IDX_CAP = 1024, IDX_WAVE_LDS = 2 * IDX_CAP * 4 + 2 * IDX_CAP * 2 + 1024;
__device__ __forceinline__ unsigned ordk(unsigned b) { return (b & 0x80000000u) ? ~b : (b | 0x80000000u); }

__device__ __forceinline__ float idx_prune(unsigned* lk, u16* li, unsigned* hist, const int n, const int lane) {
    unsigned prefix = 0; int need = TOPK;
#pragma unroll 1
    for (int d = 3; d >= 0; --d) {
        const int sh = 8 * d;
        *(u32x4*)(hist + lane * 4) = (u32x4){0u, 0u, 0u, 0u};
        for (int e = lane; e < n; e += 64) { const unsigned k = ordk(lk[e]);
            const bool match = (d == 3) || ((k >> (sh + 8)) == (prefix >> (sh + 8)));
            if (match) atomicAdd(&hist[(k >> sh) & 255], 1u); }
        const u32x4 hv = *(const u32x4*)(hist + lane * 4);
        const int s = (int)(hv[0] + hv[1] + hv[2] + hv[3]);
        int S = s;
#pragma unroll
        for (int o = 1; o < 64; o <<= 1) { const int v = __shfl_down(S, o); if (lane + o < 64) S += v; }
        const int above = S - s;
        const bool cross = (above < need) && (S >= need);
        const unsigned long long bm = __ballot(cross);
        const int L = __ffsll((long long)bm) - 1;
        int dsel = 0, nneed = 0, acc = above; bool found = false;
#pragma unroll
        for (int i = 3; i >= 0; --i) { const int hc = (int)hv[i];
            if (!found && acc + hc >= need) { dsel = lane * 4 + i; nneed = need - acc; found = true; }
            acc += hc; }
        dsel = __shfl(dsel, L); nneed = __shfl(nneed, L);
        prefix |= ((unsigned)dsel) << sh; need = nneed;
    }
    int outc = 0, eqc = 0;
    for (int c0 = 0; c0 < n; c0 += 64) {
        const int e = c0 + lane; const bool in = e < n;
        const unsigned kb = in ? lk[e] : 0u; const u16 ix = in ? li[e] : (u16)0; const unsigned k = ordk(kb);
        const bool gt = in && k > prefix, eq = in && k == prefix;
        const unsigned long long beq = __ballot(eq);
        const int eqr = eqc + __popcll(beq & ((1ull << lane) - 1ull));
        const bool keep = gt || (eq && eqr < need);
        const unsigned long long bk = __ballot(keep);
        const int pos = outc + __popcll(bk & ((1ull << lane) - 1ull));
        if (keep) { lk[pos] = kb; li[pos] = ix; }
        outc += __popcll(bk); eqc += __popcll(beq);
    }
    const unsigned tb = (prefix & 0x80000000u) ? (prefix & 0x7fffffffu) : ~prefix;
    return __uint_as_float(tb);
}

__device__ void idx_pair(const Params& p, const int pr, char* wlds, const int lane) {
    const int t0 = 2 * pr, c = lane & 31, hi = lane >> 5, tq = t0 + hi;
    int* SEL = (int*)(p.ws + WS_SEL); int* CNT = (int*)(p.ws + WS_CNT);
    if (t0 + 1 < TOPK) {
        for (int q = 0; q < 2; ++q) { const int t = t0 + q; for (int i = lane; i <= t; i += 64) SEL[(size_t)t * TOPK + i] = i; if (lane == 0) CNT[t] = t + 1; }
        return;
    }
    unsigned* lkA = (unsigned*)wlds; unsigned* lkB = lkA + IDX_CAP; u16* liA = (u16*)(lkB + IDX_CAP); u16* liB = liA + IDX_CAP; unsigned* hist = (unsigned*)(liB + IDX_CAP);
    unsigned* lk = hi ? lkB : lkA; u16* li = hi ? liB : liA;
    const u16* IQ = (const u16*)(p.ws + WS_IQ); const u16* IK = (const u16*)(p.ws + WS_IK); const float* IW = (const float*)(p.ws + WS_IW);
    bf16x8 af[4];
    { const int aq = (c >> 2) & 1, ah = (c & 3) + 4 * (c >> 3);
      const u16* ap = IQ + (size_t)(t0 + aq) * 1024 + ah * 64 + hi * 8;
#pragma unroll
      for (int s = 0; s < 4; ++s) af[s] = *(const bf16x8*)(ap + 16 * s); }
    float w[16];
    { const f32x4* wp = (const f32x4*)(IW + (size_t)tq * 16);
#pragma unroll
      for (int i = 0; i < 4; ++i) { const f32x4 v = wp[i]; w[4 * i] = v[0]; w[4 * i + 1] = v[1]; w[4 * i + 2] = v[2]; w[4 * i + 3] = v[3]; } }
    int cntA = 0, cntB = 0; float tau = -INFINITY;
    const int ntiles = (t0 + 2 + 31) >> 5;
    const u16* kp = IK + (size_t)c * 64 + hi * 8;
    bf16x8 bn[4];
#pragma unroll
    for (int s = 0; s < 4; ++s) bn[s] = *(const bf16x8*)(kp + 16 * s);
    for (int j = 0; j < ntiles; ++j) {
        bf16x8 bc[4];
#pragma unroll
        for (int s = 0; s < 4; ++s) bc[s] = bn[s];
        if (j + 1 < ntiles) {
#pragma unroll
            for (int s = 0; s < 4; ++s) bn[s] = *(const bf16x8*)(kp + (size_t)(j + 1) * 32 * 64 + 16 * s);
        }
        f32x16 d;
#pragma unroll
        for (int r = 0; r < 16; ++r) d[r] = 0.f;
#pragma unroll
        for (int s = 0; s < 4; ++s) d = __builtin_amdgcn_mfma_f32_32x32x16_bf16(af[s], bc[s], d, 0, 0, 0);
        float sc = 0.f;
#pragma unroll
        for (int r = 0; r < 16; ++r) sc = fmaf(w[r], fmaxf(d[r], 0.f), sc);
        const int key = j * 32 + c;
        const bool pass = (key <= tq) && (sc > tau);
        const unsigned long long mask = __ballot(pass);
        if (mask != 0ull) {
            const unsigned mA = (unsigned)mask, mB = (unsigned)(mask >> 32);
            const unsigned mq = hi ? mB : mA;
            const int pos = (hi ? cntB : cntA) + __popc(mq & ((1u << c) - 1u));
            if (pass) { lk[pos] = __float_as_uint(sc); li[pos] = (u16)key; }
            cntA += __popc(mA); cntB += __popc(mB);
            if (cntA > IDX_CAP - 32) { const float ta = idx_prune(lkA, liA, hist, cntA, lane); cntA = TOPK; if (!hi) tau = ta; }
            if (cntB > IDX_CAP - 32) { const float tb = idx_prune(lkB, liB, hist, cntB, lane); cntB = TOPK; if (hi) tau = tb; }
        }
    }
    if (cntA > TOPK) { idx_prune(lkA, liA, hist, cntA, lane); }
    if (cntB > TOPK) { idx_prune(lkB, liB, hist, cntB, lane); }
#pragma unroll
    for (int i = 0; i < 4; ++i) { SEL[(size_t)t0 * TOPK + lane + 64 * i] = (int)liA[lane + 64 * i]; SEL[(size_t)(t0 + 1) * TOPK + lane + 64 * i] = (int)liB[lane + 64 * i]; }
    if (lane == 0) { CNT[t0] = TOPK; CNT[t0 + 1] = TOPK; }
}
__device__ void phase_indexer(const Params& p) {
    extern __shared__ __attribute__((aligned(16))) char smem[];
    const int tid_ = opaque_tid();
    const int wid = __builtin_amdgcn_readfirstlane(tid_ >> 6), lane = tid_ & 63;
    char* wlds = smem + wid * IDX_WAVE_LDS;
    const int gw = blockIdx.x * 8 + wid;
    idx_pair(p, 4095 - gw, wlds, lane);
    idx_pair(p, gw, wlds, lane);
    __syncthreads();
}

__device__ __forceinline__ float softmax_cols16(f32x4 (&S)[16]) {
    float mx = S[0][0];
#pragma unroll
    for (int kb = 0; kb < 16; ++kb)
#pragma unroll
        for (int i = 0; i < 4; ++i) mx = fmaxf(mx, S[kb][i]);
    mx = fmaxf(mx, __shfl_xor(mx, 16)); mx = fmaxf(mx, __shfl_xor(mx, 32));
    const float mneg = -mx * LOG2E;
    float sum = 0.f;
#pragma unroll
    for (int kb = 0; kb < 16; ++kb)
#pragma unroll
        for (int i = 0; i < 4; ++i) { S[kb][i] = __builtin_amdgcn_exp2f(fmaf(S[kb][i], LOG2E, mneg)); sum += S[kb][i]; }
    sum += __shfl_xor(sum, 16); sum += __shfl_xor(sum, 32);
    return sum;
}
__device__ __forceinline__ bf16x8 pack_p(const f32x4& a, const f32x4& b) {
    u32x4 w = {cvtpk(a[0], a[1]), cvtpk(a[2], a[3]), cvtpk(b[0], b[1]), cvtpk(b[2], b[3])};
    return *reinterpret_cast<bf16x8*>(&w);
}
#define TRRD16(dst, base, off) asm volatile("ds_read_b64_tr_b16 %0, %1 offset:%2" : "=&v"(dst) : "v"(base), "i"(off) : "memory")

constexpr int SP_WAVE_LDS = 1024 + 2 * 8192;
constexpr int SP_RELB_OFF = 8 * SP_WAVE_LDS;
__device__ void sp_item(const Params& p, const int t, const int g, char* wl, const float* relb_l, const int lane) {
    u16* sel_l = (u16*)wl; unsigned char* bkt_l = (unsigned char*)(wl + 512); char* vtile = wl + 1024;
    const int i16 = lane & 15, c = lane >> 4;
    const int* SEL = (const int*)(p.ws + WS_SEL); const int cnt = ((const int*)(p.ws + WS_CNT))[t];
    const u16* KVA = (const u16*)(p.ws + WS_KVA);
    const __amdgpu_buffer_rsrc_t rs = __builtin_amdgcn_make_buffer_rsrc((void*)(p.ws + WS_KVA), (short)0, 0x7fffffff, 0x00020000);
    {
        const int pt = p.positions[t];
#pragma unroll
        for (int i = 0; i < 4; ++i) { const int slot = lane + 64 * i; const int s = (slot < cnt) ? SEL[(size_t)t * TOPK + slot] : 0;
            sel_l[slot] = (u16)s; bkt_l[slot] = (unsigned char)t5_bucket(pt - p.positions[s]); }
    }
#define SP_VDMA(u_) do { char* dst_ = vtile + ((u_) & 1) * 8192; \
    _Pragma("unroll") for (int m = 0; m < 8; ++m) { const int kl_ = 8 * (m >> 1) + (i16 >> 1), ch_ = 8 * (m & 1) + 2 * c + (lane & 1); \
        const int tok_ = sel_l[(u_) * 32 + kl_]; \
        __builtin_amdgcn_raw_ptr_buffer_load_lds(rs, (__attribute__((address_space(3))) void*)(dst_ + m * 1024 + lane * 16), 16, tok_ * 1024 + g * 512 + 256 + ch_ * 16, 0, 0, 0); } } while (0)
    SP_VDMA(0); SP_VDMA(1);
    bf16x8 qf[4];
    { const u16* qp = (const u16*)(p.ws + WS_AQ) + (size_t)t * 1024 + (g * 4 + (i16 & 3)) * 128 + 8 * c;
#pragma unroll
      for (int s = 0; s < 4; ++s) { qf[s] = *(const bf16x8*)(qp + 32 * s); if (i16 >= 4) qf[s] = (bf16x8){0, 0, 0, 0, 0, 0, 0, 0}; } }
    f32x4 S[16];
#pragma unroll
    for (int kb = 0; kb < 16; ++kb) {
        const int tok = sel_l[16 * kb + i16];
        const u16* kp = KVA + (size_t)tok * 512 + g * 256 + 8 * c;
        f32x4 a = {0.f, 0.f, 0.f, 0.f};
#pragma unroll
        for (int s = 0; s < 4; ++s) { const bf16x8 kf = *(const bf16x8*)(kp + 32 * s); a = __builtin_amdgcn_mfma_f32_16x16x32_bf16(kf, qf[s], a, 0, 0, 0); }
        S[kb] = a;
    }
#pragma unroll
    for (int kb = 0; kb < 16; ++kb) {
        const unsigned bw = *(const unsigned*)(bkt_l + 16 * kb + 4 * c);
#pragma unroll
        for (int i = 0; i < 4; ++i) { const int slot = 16 * kb + 4 * c + i; const int b = (bw >> (8 * i)) & 255;
            const float bias = relb_l[b * 8 + g * 4 + (i16 & 3)];
            S[kb][i] = (slot < cnt) ? (S[kb][i] + bias) : -INFINITY; }
    }
    const float lsum = softmax_cols16(S);
    f32x4 O[8];
#pragma unroll
    for (int d = 0; d < 8; ++d) O[d] = f32x4{0.f, 0.f, 0.f, 0.f};
    const int vlane = (c >> 1) * 2048 + (c & 1) * 128 + (i16 >> 2) * 32 + (i16 & 3) * 8;
#pragma unroll
    for (int u = 0; u < 8; ++u) {
        if (u < 7) asm volatile("s_waitcnt vmcnt(8)" ::: "memory"); else asm volatile("s_waitcnt vmcnt(0)" ::: "memory");
        const int vb = (int)(uintptr_t)(vtile + (u & 1) * 8192) + vlane;
        const bf16x8 pf = pack_p(S[2 * u], S[2 * u + 1]);
#define SP_PV(d0) do { s16x4 x0, x1; TRRD16(x0, vb, (d0) * 256); TRRD16(x1, vb, (d0) * 256 + 4096); \
        asm volatile("s_waitcnt lgkmcnt(0)" ::: "memory"); __builtin_amdgcn_sched_barrier(0); \
        O[d0] = __builtin_amdgcn_mfma_f32_16x16x32_bf16((bf16x8){x0[0], x0[1], x0[2], x0[3], x1[0], x1[1], x1[2], x1[3]}, pf, O[d0], 0, 0, 0); } while (0)
        SP_PV(0); SP_PV(1); SP_PV(2); SP_PV(3); SP_PV(4); SP_PV(5); SP_PV(6); SP_PV(7);
#undef SP_PV
        if (u + 2 < 8) SP_VDMA(u + 2);
    }
#undef SP_VDMA
    if (i16 < 4) {
        const float linv = 1.f / lsum;
        const size_t ob = (size_t)t * 1024 + (g * 4 + i16) * 128 + 4 * c;
        const u16* SZ = (const u16*)(p.ws + WS_SZA) + ob; u16* UA = (u16*)(p.ws + WS_UA) + ob;
#pragma unroll
        for (int d = 0; d < 8; ++d) { const u32x2 zw = *(const u32x2*)(SZ + d * 16);
            store4_bf16(UA + d * 16, O[d][0] * linv * __uint_as_float(zw[0] << 16), O[d][1] * linv * __uint_as_float(zw[0] & 0xffff0000u),
                        O[d][2] * linv * __uint_as_float(zw[1] << 16), O[d][3] * linv * __uint_as_float(zw[1] & 0xffff0000u)); }
    }
}
__device__ void phase_sparse_attn(const Params& p) {
    extern __shared__ __attribute__((aligned(16))) char smem[];
    const int tid_ = opaque_tid();
    const int wid = __builtin_amdgcn_readfirstlane(tid_ >> 6), lane = tid_ & 63;
    float* relb_l = (float*)(smem + SP_RELB_OFF);
    __syncthreads();
    if (tid_ < 256) relb_l[tid_] = p.rel_bias[tid_];
    __syncthreads();
    char* wl = smem + wid * SP_WAVE_LDS;
    const int g = blockIdx.x & 1, wg = (blockIdx.x >> 1) * 8 + wid;
    for (int t = wg; t < SEQ; t += 1024) sp_item(p, t, g, wl, relb_l, lane);
    asm volatile("s_waitcnt vmcnt(0)" ::: "memory");
    __syncthreads();
}

__device__ void phase_mem_attn(const Params& p) {
    extern __shared__ __attribute__((aligned(16))) char smem[];
    const int tid_ = opaque_tid();
    const int wid = __builtin_amdgcn_readfirstlane(tid_ >> 6), lane = tid_ & 63, i16 = lane & 15, c = lane >> 4;
    const int hh = blockIdx.x & 3, q0 = (blockIdx.x >> 2) * 128 + wid * 16;
    const __amdgpu_buffer_rsrc_t rsK = __builtin_amdgcn_make_buffer_rsrc((void*)(p.ws + WS_CK), (short)0, 0x7fffffff, 0x00020000);
    const __amdgpu_buffer_rsrc_t rsV = __builtin_amdgcn_make_buffer_rsrc((void*)(p.ws + WS_CV), (short)0, 0x7fffffff, 0x00020000);
    __syncthreads();
#pragma unroll 4
    for (int m = 0; m < 16; ++m) { const int o = (wid * 16 + m) * 1024 + lane * 16, key = o >> 9, cpos = (o & 511) >> 4;
        const int chunk = (cpos & 16) | ((cpos & 15) ^ (key & 15));
        __builtin_amdgcn_raw_ptr_buffer_load_lds(rsK, (__attribute__((address_space(3))) void*)(smem + o), 16, key * 2048 + hh * 512 + chunk * 16, 0, 0, 0); }
    bf16x8 qf[8];
    { const u16* qp = (const u16*)(p.ws + WS_CQ) + (size_t)(q0 + i16) * 1024 + hh * 256 + 8 * c;
#pragma unroll
      for (int s = 0; s < 8; ++s) qf[s] = *(const bf16x8*)(qp + 32 * s); }
    asm volatile("s_waitcnt vmcnt(0)" ::: "memory");
    __syncthreads();
    f32x4 S[16];
    {
        int kbase[4];
#pragma unroll
        for (int a = 0; a < 4; ++a) kbase[a] = i16 * 512 + 16 * ((4 * a + c) ^ i16);
#pragma unroll
        for (int kb = 0; kb < 16; ++kb) {
            f32x4 acc = {0.f, 0.f, 0.f, 0.f};
            int kofs = kb * 8192; asm volatile("" : "+v"(kofs));
#pragma unroll
            for (int s = 0; s < 8; ++s) { const bf16x8 kf = *(const bf16x8*)(smem + kofs + kbase[s & 3] + (s >> 2) * 256);
                acc = __builtin_amdgcn_mfma_f32_16x16x32_bf16(kf, qf[s], acc, 0, 0, 0); }
            asm volatile("" : "+v"(acc));
            S[kb] = acc;
        }
    }
    __syncthreads();
#pragma unroll 4
    for (int m = 0; m < 16; ++m) { const int o = (wid * 16 + m) * 1024 + lane * 16, sub = o >> 8, key = (sub >> 4) * 8 + ((o & 255) >> 5), chunk = (sub & 15) * 2 + ((o >> 4) & 1);
        __builtin_amdgcn_raw_ptr_buffer_load_lds(rsV, (__attribute__((address_space(3))) void*)(smem + o), 16, key * 2048 + hh * 512 + chunk * 16, 0, 0, 0); }
    const float lsum = softmax_cols16(S);
    asm volatile("s_waitcnt vmcnt(0)" ::: "memory");
    __syncthreads();
    f32x4 O[16];
#pragma unroll
    for (int d = 0; d < 16; ++d) O[d] = f32x4{0.f, 0.f, 0.f, 0.f};
    const int vlane = (int)(uintptr_t)smem + (c >> 1) * 4096 + (c & 1) * 128 + (i16 >> 2) * 32 + (i16 & 3) * 8;
#pragma unroll
    for (int u = 0; u < 8; ++u) {
        const int vb = vlane + u * 16384;
        const bf16x8 pf = pack_p(S[2 * u], S[2 * u + 1]);
#define MEM_PV(d0) do { s16x4 x0, x1; TRRD16(x0, vb, (d0) * 256); TRRD16(x1, vb, (d0) * 256 + 8192); \
        asm volatile("s_waitcnt lgkmcnt(0)" ::: "memory"); __builtin_amdgcn_sched_barrier(0); \
        O[d0] = __builtin_amdgcn_mfma_f32_16x16x32_bf16((bf16x8){x0[0], x0[1], x0[2], x0[3], x1[0], x1[1], x1[2], x1[3]}, pf, O[d0], 0, 0, 0); } while (0)
        MEM_PV(0); MEM_PV(1); MEM_PV(2); MEM_PV(3); MEM_PV(4); MEM_PV(5); MEM_PV(6); MEM_PV(7);
        MEM_PV(8); MEM_PV(9); MEM_PV(10); MEM_PV(11); MEM_PV(12); MEM_PV(13); MEM_PV(14); MEM_PV(15);
#undef MEM_PV
    }
    {
        const float linv = 1.f / lsum;
        const size_t ob = (size_t)(q0 + i16) * 1024 + hh * 256 + 4 * c;
        const u16* SZ = (const u16*)(p.ws + WS_SZC) + ob; u16* UC = (u16*)(p.ws + WS_UC) + ob;
#pragma unroll
        for (int d = 0; d < 16; ++d) { const u32x2 zw = *(const u32x2*)(SZ + d * 16);
            store4_bf16(UC + d * 16, O[d][0] * linv * __uint_as_float(zw[0] << 16), O[d][1] * linv * __uint_as_float(zw[0] & 0xffff0000u),
                        O[d][2] * linv * __uint_as_float(zw[1] << 16), O[d][3] * linv * __uint_as_float(zw[1] & 0xffff0000u)); }
    }
    __syncthreads();
}

constexpr int MEGA_LDS = SP_RELB_OFF + 1024;
__global__ void __launch_bounds__(512) mega_kernel(Params p) {
    for (int ph = p.phase_lo; ph < p.phase_hi; ++ph) {
        if (ph == 1) phase_prep(p);
        else if (ph == 2) phase_inproj(p);
        else if (ph == 3) { phase_mla_up(p); phase_indexer(p); phase_mem_attn(p); }
        else if (ph == 4) { phase_mla_attn(p); phase_sparse_attn(p); }
        else if (ph == 5) phase_merge(p);
        else if (ph == 6) phase_out(p);
    }
}

extern "C" void kernel_launch(void* const* d_in, const int* in_sizes, int n_in, void* d_out, int out_size, void* d_ws, size_t ws_size,
                              hipStream_t stream) {
    if (ws_size < WS_END) { fprintf(stderr, "ws too small: %zu < %zu\n", ws_size, WS_END); return; }
    const float* x = (const float*)d_in[0];
    const float* mem = (const float*)d_in[1];
    const int* positions = (const int*)d_in[2];
    const float* rel_bias = (const float*)d_in[3];
    const float* norm_g = (const float*)d_in[4];
    const float* mem_norm_g = (const float*)d_in[5];
    const float* w_in = (const float*)d_in[6];
    const float* a_q_norm_g = (const float*)d_in[7];
    const float* a_k_norm_g = (const float*)d_in[8];
    const float* b_q_lat_norm_g = (const float*)d_in[9];
    const float* b_kv_lat_norm_g = (const float*)d_in[10];
    const float* w_b_uq = (const float*)d_in[11];
    const float* w_b_ukv = (const float*)d_in[12];
    const float* b_q_norm_g = (const float*)d_in[13];
    const float* b_k_norm_g = (const float*)d_in[14];
    const float* w_mem_kv = (const float*)d_in[15];
    const float* c_q_norm_g = (const float*)d_in[16];
    const float* c_k_norm_g = (const float*)d_in[17];
    const float* w_branch = (const float*)d_in[18];
    const float* w_out = (const float*)d_in[19];
    char* ws = (char*)d_ws;
    char* dout = (char*)d_out;
    u16* H = (u16*)(ws + WS_H); u16* HM = (u16*)(ws + WS_HM);
    u16* AQ = (u16*)(ws + WS_AQ); u16* KVA = (u16*)(ws + WS_KVA); u16* SZA = (u16*)(ws + WS_SZA);
    u16* IQ = (u16*)(ws + WS_IQ); u16* IK = (u16*)(ws + WS_IK); float* IW = (float*)(ws + WS_IW); float* BKPE = (float*)(ws + WS_BKPE);
    u16* BCQ = (u16*)(ws + WS_BCQ); u16* BCKV = (u16*)(ws + WS_BCKV); u16* SZB = (u16*)(ws + WS_SZB);
    u16* CQ = (u16*)(ws + WS_CQ); u16* SZC = (u16*)(ws + WS_SZC); u16* G = (u16*)(ws + WS_G);
    u16* CK = (u16*)(ws + WS_CK); u16* CV = (u16*)(ws + WS_CV);
    int* SEL = (int*)(ws + WS_SEL); int* CNT = (int*)(ws + WS_CNT);
    float* COS = (float*)(ws + WS_COS); float* SIN = (float*)(ws + WS_SIN);
    u16* UA = (u16*)(ws + WS_UA); u16* UB = (u16*)(ws + WS_UB); u16* UC = (u16*)(ws + WS_UC);
    u16* MERGED = (u16*)(ws + WS_MERGED);
    u16* QB = (u16*)(dout + DO_QB); u16* KB = (u16*)(dout + DO_KB); u16* VB = (u16*)(dout + DO_VB);
    float* RAW = (float*)(ws + WS_TMP_RAW);
    float* MF = (float*)(ws + WS_TMP_MERGEDF);
    float* Y = (float*)d_out;

    static bool attr_done = false;
    if (!attr_done) {
        attr_done = true;
        (void)hipFuncSetAttribute((const void*)nk_attn<192, 128, 64, true>, hipFuncAttributeMaxDynamicSharedMemorySize, 120 * 1024);
        (void)hipFuncSetAttribute((const void*)nk_attn<256, 256, 32, false>, hipFuncAttributeMaxDynamicSharedMemorySize, 120 * 1024);
        (void)hipFuncSetAttribute((const void*)mega_kernel, hipFuncAttributeMaxDynamicSharedMemorySize, MEGA_LDS);
    }
    Params prm{};
    prm.x = x; prm.mem = mem; prm.positions = positions; prm.rel_bias = rel_bias; prm.norm_g = norm_g; prm.mem_norm_g = mem_norm_g;
    prm.w_in = w_in; prm.a_q_norm_g = a_q_norm_g; prm.a_k_norm_g = a_k_norm_g; prm.b_q_lat_norm_g = b_q_lat_norm_g; prm.b_kv_lat_norm_g = b_kv_lat_norm_g;
    prm.w_b_uq = w_b_uq; prm.w_b_ukv = w_b_ukv; prm.b_q_norm_g = b_q_norm_g; prm.b_k_norm_g = b_k_norm_g; prm.w_mem_kv = w_mem_kv;
    prm.c_q_norm_g = c_q_norm_g; prm.c_k_norm_g = c_k_norm_g; prm.w_branch = w_branch; prm.w_out = w_out;
    prm.ws = ws; prm.dout = dout;
#define GEMM(OutT, ACT, A_, lda_, B_, ldb_, C_, ldc_, M_, N_, K_, R_, ldr_) \
    nk_gemm<OutT, ACT><<<dim3(((N_) + 63) / 64, (M_) / 64), 256, 0, stream>>>(A_, lda_, B_, ldb_, C_, ldc_, M_, N_, K_, R_, ldr_)
    prm.phase_lo = 1; prm.phase_hi = 2; mega_kernel<<<256, 512, MEGA_LDS, stream>>>(prm);
    prm.phase_lo = 2; prm.phase_hi = 3; mega_kernel<<<256, 512, MEGA_LDS, stream>>>(prm);
    prm.phase_lo = 3; prm.phase_hi = 4; mega_kernel<<<256, 512, MEGA_LDS, stream>>>(prm);
    prm.phase_lo = 4; prm.phase_hi = 5; mega_kernel<<<256, 512, MEGA_LDS, stream>>>(prm);
    prm.phase_lo = 5; prm.phase_hi = 6; mega_kernel<<<256, 512, MEGA_LDS, stream>>>(prm);
    prm.phase_lo = 6; prm.phase_hi = 7; mega_kernel<<<256, 512, MEGA_LDS, stream>>>(prm);
#undef GEMM
}
```

```cpp
#include <hip/hip_runtime.h>
#include <hip/hip_bf16.h>
#include <hip/hip_cooperative_groups.h>
#include <stdint.h>
#include <stdio.h>

typedef unsigned short u16;

constexpr int SEQ = 8192, DM = 2048, INW = 13712, NMEM = 256;
constexpr int OFF_AQ = 0, OFF_AK = 1024, OFF_AV = 1280, OFF_AZ = 1536, OFF_IQ = 2560, OFF_IK = 3584, OFF_IW = 3648,
              OFF_BCQ = 3664, OFF_BCKV = 4176, OFF_BKPE = 4432, OFF_BZ = 4496, OFF_CQ = 5520, OFF_CZ = 6544, OFF_G = 7568;
constexpr float EPS = 1e-6f;
constexpr float A_SCALE = 0.08838834764831845f;
constexpr float B_SCALE = 0.07216878364870322f;
constexpr float C_SCALE = 0.0625f;
constexpr int TOPK = 256;

constexpr size_t MiB = 1024 * 1024;
constexpr size_t WS_H = 0;
constexpr size_t WS_WINT = 32 * MiB;
constexpr size_t WS_WUQT = 86 * MiB;
constexpr size_t WS_WUKVT = 88 * MiB;
constexpr size_t WS_WMEMT = 89 * MiB;
constexpr size_t WS_WBRT = 97 * MiB;
constexpr size_t WS_WOUTT = 109 * MiB;
constexpr size_t WS_AQ = 117 * MiB;
constexpr size_t WS_KVA = 133 * MiB;
constexpr size_t WS_SZA = 141 * MiB;
constexpr size_t WS_IQ = 157 * MiB;
constexpr size_t WS_IK = 173 * MiB;
constexpr size_t WS_IW = 174 * MiB;
constexpr size_t WS_BKPE = 175 * MiB;
constexpr size_t WS_BCQ = 177 * MiB;
constexpr size_t WS_BCKV = 185 * MiB;
constexpr size_t WS_SZB = 189 * MiB;
constexpr size_t WS_CQ = 205 * MiB;
constexpr size_t WS_SZC = 221 * MiB;
constexpr size_t WS_G = 237 * MiB;
constexpr size_t WS_CK = 333 * MiB;
constexpr size_t WS_CV = WS_CK + 512 * 1024;
constexpr size_t WS_SEL = 334 * MiB;
constexpr size_t WS_CNT = 342 * MiB;
constexpr size_t WS_COS = 343 * MiB;
constexpr size_t WS_SIN = 344 * MiB;
constexpr size_t WS_UA = 345 * MiB;
constexpr size_t WS_UB = 361 * MiB;
constexpr size_t WS_UC = 377 * MiB;
constexpr size_t WS_MERGED = 393 * MiB;
constexpr size_t WS_HM = 425 * MiB;
constexpr size_t WS_END = 426 * MiB;
constexpr size_t WS_TMP_RAW = 345 * MiB;
constexpr size_t WS_TMP_MERGEDF = 0;
constexpr size_t DO_QB = 0, DO_KB = 24 * MiB, DO_VB = 48 * MiB;

__device__ __forceinline__ float bf2f(u16 u) { return __uint_as_float(((unsigned)u) << 16); }
__device__ __forceinline__ u16 f2bf(float f) {
    unsigned u = __float_as_uint(f);
    u += 0x7FFFu + ((u >> 16) & 1u);
    return (u16)(u >> 16);
}
__device__ __forceinline__ float silu_f(float x) { return x / (1.f + __expf(-x)); }
__device__ __forceinline__ float sigmoid_f(float x) { return 1.f / (1.f + __expf(-x)); }
__device__ __forceinline__ int rope_phys(int j, int second) { return (j >> 4) * 32 + (j & 15) + second * 16; }

__device__ __forceinline__ float block_sum_256(float v, float* red) {
    for (int o = 32; o > 0; o >>= 1) v += __shfl_xor(v, o);
    __syncthreads();
    if ((threadIdx.x & 63) == 0) red[threadIdx.x >> 6] = v;
    __syncthreads();
    return red[0] + red[1] + red[2] + red[3];
}

__global__ void __launch_bounds__(256) nk_rmsnorm_rows(const float* __restrict__ x, const float* __restrict__ g, u16* __restrict__ out, int C) {
    __shared__ float red[4];
    const float* xr = x + (size_t)blockIdx.x * C;
    float ss = 0.f;
    for (int c = threadIdx.x; c < C; c += 256) { float v = xr[c]; ss += v * v; }
    ss = block_sum_256(ss, red);
    float rinv = rsqrtf(ss / (float)C + EPS);
    for (int c = threadIdx.x; c < C; c += 256) out[(size_t)blockIdx.x * C + c] = f2bf(xr[c] * rinv * g[c]);
}

__global__ void __launch_bounds__(256) nk_rope_tables(const int* __restrict__ pos, float* __restrict__ cs, float* __restrict__ sn) {
    int i = blockIdx.x * 256 + threadIdx.x;
    if (i >= SEQ * 32) return;
    int t = i >> 5, j = i & 31;
    float inv_freq = 1.0f / powf(10000.f, (float)(2 * j) / 64.f);
    float ang = (float)pos[t] * inv_freq;
    cs[i] = cosf(ang); sn[i] = sinf(ang);
}

template <typename OutT> __device__ __forceinline__ void store_out(OutT* p, float v);
template <> __device__ __forceinline__ void store_out<float>(float* p, float v) { *p = v; }
template <> __device__ __forceinline__ void store_out<u16>(u16* p, float v) { *p = f2bf(v); }

template <typename OutT, int ACT>
__global__ void __launch_bounds__(256) nk_gemm(const u16* __restrict__ A, int lda, const float* __restrict__ B, int ldb, OutT* __restrict__ C, int ldc,
                        int M, int N, int K, const float* __restrict__ R, int ldr) {
    __shared__ float As[16][65];
    __shared__ float Bs[16][65];
    const int tid = threadIdx.x, tx = tid & 15, ty = tid >> 4;
    const int m0 = blockIdx.y * 64, n0 = blockIdx.x * 64;
    float acc[4][4] = {};
    for (int k0 = 0; k0 < K; k0 += 16) {
        {
            int r = tid >> 2, kk = (tid & 3) * 4;
            const u16* ap = A + (size_t)(m0 + r) * lda + k0 + kk;
            for (int e = 0; e < 4; ++e) As[kk + e][r] = bf2f(ap[e]);
        }
        {
            int kk = tid >> 4, nn = (tid & 15) * 4;
            const float* bp = B + (size_t)(k0 + kk) * ldb + n0 + nn;
            for (int e = 0; e < 4; ++e) Bs[kk][nn + e] = (n0 + nn + e < N) ? bp[e] : 0.f;
        }
        __syncthreads();
#pragma unroll
        for (int k = 0; k < 16; ++k) {
            float a[4], b[4];
#pragma unroll
            for (int i = 0; i < 4; ++i) { a[i] = As[k][ty + 16 * i]; b[i] = Bs[k][tx + 16 * i]; }
#pragma unroll
            for (int i = 0; i < 4; ++i)
#pragma unroll
                for (int j = 0; j < 4; ++j) acc[i][j] = fmaf(a[i], b[j], acc[i][j]);
        }
        __syncthreads();
    }
    for (int i = 0; i < 4; ++i)
        for (int j = 0; j < 4; ++j) {
            int row = m0 + ty + 16 * i, col = n0 + tx + 16 * j;
            if (col < N) {
                float v = acc[i][j];
                if (ACT == 1) v = silu_f(v);
                if (ACT == 2) v = sigmoid_f(v);
                if (ACT == 3) v += R[(size_t)row * ldr + col];
                store_out<OutT>(C + (size_t)row * ldc + col, v);
            }
        }
}

__global__ void __launch_bounds__(256) nk_headnorm(u16* __restrict__ buf, long row_stride, long head_stride, int nheads, int HD,
                            const float* __restrict__ g, float scale, int nrows) {
    int wid = (blockIdx.x * 256 + threadIdx.x) >> 6, lane = threadIdx.x & 63;
    if (wid >= nrows * nheads) return;
    int row = wid / nheads, h = wid % nheads;
    u16* p = buf + (size_t)row * row_stride + (size_t)h * head_stride;
    float ss = 0.f;
    for (int i = lane; i < HD; i += 64) { float v = bf2f(p[i]); ss += v * v; }
    for (int o = 32; o > 0; o >>= 1) ss += __shfl_xor(ss, o);
    float rinv = rsqrtf(ss / (float)HD + EPS) * scale;
    for (int i = lane; i < HD; i += 64) p[i] = f2bf(bf2f(p[i]) * rinv * g[i]);
}

__global__ void __launch_bounds__(256) nk_rownorm_bf16(u16* __restrict__ buf, int C, const float* __restrict__ g, int nrows) {
    int wid = (blockIdx.x * 256 + threadIdx.x) >> 6, lane = threadIdx.x & 63;
    if (wid >= nrows) return;
    u16* p = buf + (size_t)wid * C;
    float ss = 0.f;
    for (int i = lane; i < C; i += 64) { float v = bf2f(p[i]); ss += v * v; }
    for (int o = 32; o > 0; o >>= 1) ss += __shfl_xor(ss, o);
    float rinv = rsqrtf(ss / (float)C + EPS);
    for (int i = lane; i < C; i += 64) p[i] = f2bf(bf2f(p[i]) * rinv * g[i]);
}

__global__ void __launch_bounds__(256) nk_mla_q_finish(const float* __restrict__ qraw, const float* __restrict__ g, const float* __restrict__ cs,
                                const float* __restrict__ sn, u16* __restrict__ QB) {
    int wid = (blockIdx.x * 256 + threadIdx.x) >> 6, lane = threadIdx.x & 63;
    if (wid >= SEQ * 8) return;
    int t = wid >> 3, h = wid & 7;
    const float* p = qraw + (size_t)t * 1536 + h * 192;
    float v0 = p[lane], v1 = p[64 + lane], v2 = p[128 + lane];
    float ss = v0 * v0 + v1 * v1 + v2 * v2;
    for (int o = 32; o > 0; o >>= 1) ss += __shfl_xor(ss, o);
    float rinv = rsqrtf(ss / 192.f + EPS);
    v0 *= rinv * g[lane]; v1 *= rinv * g[64 + lane]; v2 *= rinv * g[128 + lane];
    float other = __shfl_xor(v2, 32);
    int j = lane & 31;
    float c = cs[t * 32 + j], s = sn[t * 32 + j];
    float r = (lane < 32) ? (v2 * c - other * s) : (v2 * c + other * s);
    u16* o = QB + ((size_t)h * SEQ + t) * 192;
    o[lane] = f2bf(v0 * B_SCALE); o[64 + lane] = f2bf(v1 * B_SCALE);
    o[128 + rope_phys(j, lane >> 5)] = f2bf(r * B_SCALE);
}
__global__ void __launch_bounds__(256) nk_mla_kv_finish(const float* __restrict__ kvraw, const float* __restrict__ bkpe, const float* __restrict__ g,
                                 const float* __restrict__ cs, const float* __restrict__ sn, u16* __restrict__ KB, u16* __restrict__ VB) {
    int wid = (blockIdx.x * 256 + threadIdx.x) >> 6, lane = threadIdx.x & 63;
    if (wid >= SEQ * 8) return;
    int t = wid >> 3, h = wid & 7;
    const float* p = kvraw + (size_t)t * 2048 + h * 256;
    float v0 = p[lane], v1 = p[64 + lane], v2 = bkpe[(size_t)t * 64 + lane];
    float ss = v0 * v0 + v1 * v1 + v2 * v2;
    for (int o = 32; o > 0; o >>= 1) ss += __shfl_xor(ss, o);
    float rinv = rsqrtf(ss / 192.f + EPS);
    v0 *= rinv * g[lane]; v1 *= rinv * g[64 + lane]; v2 *= rinv * g[128 + lane];
    float other = __shfl_xor(v2, 32);
    int j = lane & 31;
    float c = cs[t * 32 + j], s = sn[t * 32 + j];
    float r = (lane < 32) ? (v2 * c - other * s) : (v2 * c + other * s);
    u16* o = KB + ((size_t)h * SEQ + t) * 192;
    o[lane] = f2bf(v0); o[64 + lane] = f2bf(v1);
    o[128 + rope_phys(j, lane >> 5)] = f2bf(r);
    u16* vo = VB + ((size_t)h * SEQ + t) * 128;
    vo[lane] = f2bf(p[128 + lane]); vo[64 + lane] = f2bf(p[192 + lane]);
}

template <int DQK, int DV, int KT, bool CAUSAL>
__global__ void __launch_bounds__(256) nk_attn(const u16* __restrict__ Q, long q_rs, long q_hs, const u16* __restrict__ K, long k_rs, long k_hs,
                        const u16* __restrict__ V, long v_rs, long v_hs, int Skv, const u16* __restrict__ SZ, u16* __restrict__ U) {
    extern __shared__ float sm[];
    float* Qs = sm;
    float* Ks = Qs + 32 * (DQK + 1);
    float* Vs = Ks + KT * (DQK + 1);
    float* Ss = Vs + KT * DV;
    float* mrow = Ss + 32 * (KT + 1);
    float* lrow = mrow + 32;
    float* arow = lrow + 32;
    const int tid = threadIdx.x, q0 = blockIdx.x * 32, h = blockIdx.y;
    for (int e = tid; e < 32 * DQK; e += 256) { int r = e / DQK, d = e % DQK; Qs[r * (DQK + 1) + d] = bf2f(Q[(size_t)(q0 + r) * q_rs + (size_t)h * q_hs + d]); }
    if (tid < 32) { mrow[tid] = -1e30f; lrow[tid] = 0.f; }
    constexpr int NO = DV / 8;
    float o[NO];
#pragma unroll
    for (int j = 0; j < NO; ++j) o[j] = 0.f;
    const int qi = tid >> 3, sub = tid & 7;
    const int kend = CAUSAL ? (q0 + 32) : Skv;
    for (int k0 = 0; k0 < kend; k0 += KT) {
        __syncthreads();
        for (int e = tid; e < KT * DQK; e += 256) { int r = e / DQK, d = e % DQK; int key = k0 + r;
            Ks[r * (DQK + 1) + d] = (key < Skv) ? bf2f(K[(size_t)key * k_rs + (size_t)h * k_hs + d]) : 0.f; }
        for (int e = tid; e < KT * DV; e += 256) { int r = e / DV, d = e % DV; int key = k0 + r;
            Vs[r * DV + d] = (key < Skv) ? bf2f(V[(size_t)key * v_rs + (size_t)h * v_hs + d]) : 0.f; }
        __syncthreads();
        {
            constexpr int NP = KT / 8;
            float s[NP];
#pragma unroll
            for (int j = 0; j < NP; ++j) s[j] = 0.f;
            for (int d = 0; d < DQK; ++d) { float qv = Qs[qi * (DQK + 1) + d];
#pragma unroll
                for (int j = 0; j < NP; ++j) s[j] = fmaf(qv, Ks[(sub + 8 * j) * (DQK + 1) + d], s[j]); }
#pragma unroll
            for (int j = 0; j < NP; ++j) { int key = k0 + sub + 8 * j;
                bool ok = key < Skv && (!CAUSAL || key <= q0 + qi);
                Ss[qi * (KT + 1) + sub + 8 * j] = ok ? s[j] : -INFINITY; }
        }
        __syncthreads();
        if (tid < 32) {
            float m = mrow[tid], mx = m;
            for (int k = 0; k < KT; ++k) mx = fmaxf(mx, Ss[tid * (KT + 1) + k]);
            float alpha = __expf(m - mx), sum = 0.f;
            for (int k = 0; k < KT; ++k) { float p = __expf(Ss[tid * (KT + 1) + k] - mx); Ss[tid * (KT + 1) + k] = p; sum += p; }
            mrow[tid] = mx; lrow[tid] = lrow[tid] * alpha + sum; arow[tid] = alpha;
        }
        __syncthreads();
        {
            float alpha = arow[qi];
#pragma unroll
            for (int j = 0; j < NO; ++j) o[j] *= alpha;
            for (int k = 0; k < KT; ++k) { float p = Ss[qi * (KT + 1) + k];
#pragma unroll
                for (int j = 0; j < NO; ++j) o[j] = fmaf(p, Vs[k * DV + sub + 8 * j], o[j]); }
        }
    }
    __syncthreads();
    float linv = 1.f / lrow[qi];
#pragma unroll
    for (int j = 0; j < NO; ++j) { int d = sub + 8 * j; size_t idx = (size_t)(q0 + qi) * 1024 + h * DV + d;
        U[idx] = f2bf(o[j] * linv * bf2f(SZ[idx])); }
}

__device__ __forceinline__ unsigned ord_key(float f) { unsigned u = __float_as_uint(f); return (u & 0x80000000u) ? ~u : (u | 0x80000000u); }
__global__ void __launch_bounds__(256) nk_indexer_topk(const u16* __restrict__ IQ, const u16* __restrict__ IK, const float* __restrict__ IW,
                                int* __restrict__ SEL, int* __restrict__ CNT) {
    __shared__ unsigned keys[SEQ];
    __shared__ float qs[16 * 64];
    __shared__ float ws[16];
    __shared__ int cnt_sh;
    __shared__ int wsum[8];
    const int t = blockIdx.x, tid = threadIdx.x, n = t + 1;
    int* sel = SEL + (size_t)t * TOPK;
    if (n <= TOPK) { for (int i = tid; i < n; i += 256) sel[i] = i; if (tid == 0) CNT[t] = n; return; }
    for (int e = tid; e < 1024; e += 256) qs[e] = bf2f(IQ[(size_t)t * 1024 + e]);
    if (tid < 16) ws[tid] = IW[(size_t)t * 16 + tid];
    __syncthreads();
    for (int s = tid; s < n; s += 256) {
        float kv[64];
        const u16* kp = IK + (size_t)s * 64;
#pragma unroll
        for (int d = 0; d < 64; ++d) kv[d] = bf2f(kp[d]);
        float sc = 0.f;
        for (int h = 0; h < 16; ++h) { float dot = 0.f;
#pragma unroll
            for (int d = 0; d < 64; ++d) dot = fmaf(qs[h * 64 + d], kv[d], dot);
            sc = fmaf(ws[h], fmaxf(dot, 0.f), sc); }
        keys[s] = ord_key(sc);
    }
    __syncthreads();
    unsigned prefix = 0; int need = TOPK;
    for (int bit = 31; bit >= 0; --bit) {
        if (tid == 0) cnt_sh = 0;
        __syncthreads();
        unsigned want = (prefix >> bit) | 1u;
        int c = 0;
        for (int s = tid; s < n; s += 256) c += ((keys[s] >> bit) == want) ? 1 : 0;
        for (int o = 32; o > 0; o >>= 1) c += __shfl_xor(c, o);
        if ((tid & 63) == 0) atomicAdd(&cnt_sh, c);
        __syncthreads();
        int tot = cnt_sh;
        if (tot >= need) prefix |= (1u << bit); else need -= tot;
        __syncthreads();
    }
    int base_sel = 0, base_eq = 0;
    for (int c0 = 0; c0 < n; c0 += 256) {
        int s = c0 + tid; bool in = s < n;
        unsigned kk = in ? keys[s] : 0u;
        bool gt = in && kk > prefix, eq = in && kk == prefix;
        unsigned long long beq = __ballot(eq);
        int w = tid >> 6, lane = tid & 63;
        if (lane == 0) wsum[w] = __popcll(beq);
        __syncthreads();
        int eqpre = base_eq + __popcll(beq & ((1ull << lane) - 1ull));
        for (int i = 0; i < w; ++i) eqpre += wsum[i];
        int eqtot = wsum[0] + wsum[1] + wsum[2] + wsum[3];
        bool selv = gt || (eq && eqpre < need);
        unsigned long long bs = __ballot(selv);
        if (lane == 0) wsum[4 + w] = __popcll(bs);
        __syncthreads();
        int pos = base_sel + __popcll(bs & ((1ull << lane) - 1ull));
        for (int i = 0; i < w; ++i) pos += wsum[4 + i];
        if (selv && pos < TOPK) sel[pos] = s;
        base_sel += wsum[4] + wsum[5] + wsum[6] + wsum[7];
        base_eq += eqtot;
        __syncthreads();
    }
    if (tid == 0) CNT[t] = TOPK;
}

__device__ __forceinline__ int t5_bucket(int dist) {
    int nn = dist > 0 ? dist : 0;
    if (nn < 16) return nn;
    float nf = (float)nn;
    int large = 16 + (int)(logf(nf / 16.f) / 2.0794415416798357f * 16.f);
    return large < 31 ? large : 31;
}
__global__ void __launch_bounds__(256) nk_sparse_attn(const u16* __restrict__ AQ, const u16* __restrict__ KVA, const int* __restrict__ SEL, const int* __restrict__ CNT,
                               const int* __restrict__ pos, const float* __restrict__ relb, const u16* __restrict__ SZA, u16* __restrict__ UA) {
    __shared__ float qs[1024];
    __shared__ int sl[TOPK];
    __shared__ int bk[TOPK];
    __shared__ float pr[TOPK];
    __shared__ float red[4];
    const int t = blockIdx.x, tid = threadIdx.x;
    const int cnt = CNT[t];
    for (int e = tid; e < 1024; e += 256) qs[e] = bf2f(AQ[(size_t)t * 1024 + e]);
    if (tid < cnt) { int s = SEL[(size_t)t * TOPK + tid]; sl[tid] = s; bk[tid] = t5_bucket(pos[t] - pos[s]); }
    __syncthreads();
    for (int h = 0; h < 8; ++h) {
        const int g = h >> 2;
        float logit = -INFINITY;
        if (tid < cnt) {
            const u16* kp = KVA + ((size_t)sl[tid] * 2 + g) * 256;
            float dot = 0.f;
            for (int d = 0; d < 128; ++d) dot = fmaf(qs[h * 128 + d], bf2f(kp[d]), dot);
            logit = dot + relb[bk[tid] * 8 + h];
        }
        float mx = logit;
        for (int o = 32; o > 0; o >>= 1) mx = fmaxf(mx, __shfl_xor(mx, o));
        __syncthreads();
        if ((tid & 63) == 0) red[tid >> 6] = mx;
        __syncthreads();
        mx = fmaxf(fmaxf(red[0], red[1]), fmaxf(red[2], red[3]));
        float p = (tid < cnt) ? __expf(logit - mx) : 0.f;
        pr[tid] = p;
        float sum = block_sum_256(p, red);
        __syncthreads();
        if (tid < 128) {
            float acc = 0.f;
            for (int k = 0; k < cnt; ++k) acc = fmaf(pr[k], bf2f(KVA[((size_t)sl[k] * 2 + g) * 256 + 128 + tid]), acc);
            size_t idx = (size_t)t * 1024 + h * 128 + tid;
            UA[idx] = f2bf(acc / sum * bf2f(SZA[idx]));
        }
        __syncthreads();
    }
}

__global__ void __launch_bounds__(256) nk_merge(const float* __restrict__ Y, const u16* __restrict__ G, int n, float* __restrict__ MF, u16* __restrict__ MERGED) {
    size_t i = (size_t)blockIdx.x * 256 + threadIdx.x;
    if (i >= (size_t)SEQ * DM) return;
    size_t t = i / DM, d = i % DM;
    float v = bf2f(G[t * 6144 + (size_t)n * DM + d]) * Y[i];
    if (n > 0) v += MF[i];
    MF[i] = v;
    if (n == 2) MERGED[i] = f2bf(v);
}


typedef short bf16x8 __attribute__((ext_vector_type(8)));
typedef float f32x4 __attribute__((ext_vector_type(4)));
typedef float f32x16 __attribute__((ext_vector_type(16)));
typedef unsigned u32x4 __attribute__((ext_vector_type(4)));
typedef unsigned u32x2 __attribute__((ext_vector_type(2)));

constexpr size_t WS_LATQ = WS_CNT + 64 * 1024;
constexpr size_t WS_LATKV = WS_CNT + 128 * 1024;
constexpr size_t WS_PESS = WS_CNT + 192 * 1024;
constexpr int NT_IN = 54;
constexpr int WINT_ROWS = NT_IN * 256;

struct Params {
    const float* x; const float* mem; const int* positions; const float* rel_bias; const float* norm_g; const float* mem_norm_g;
    const float* w_in; const float* a_q_norm_g; const float* a_k_norm_g; const float* b_q_lat_norm_g; const float* b_kv_lat_norm_g;
    const float* w_b_uq; const float* w_b_ukv; const float* b_q_norm_g; const float* b_k_norm_g; const float* w_mem_kv;
    const float* c_q_norm_g; const float* c_k_norm_g; const float* w_branch; const float* w_out;
    char* ws; char* dout;
    int phase_lo, phase_hi;
};

__device__ __forceinline__ int opaque_tid() { int t = threadIdx.x; asm volatile("" : "+v"(t)); return t; }
__device__ __forceinline__ unsigned cvtpk(float lo, float hi) {
    unsigned r; asm volatile("v_cvt_pk_bf16_f32 %0, %1, %2" : "=v"(r) : "v"(lo), "v"(hi)); return r;
}

__device__ __forceinline__ int win_srccol(int n) {
    if (n < 3584) return n;
    if (n < 3840) { int j = n - 3584; if (j < 80) return 3584 + j; if (j < 144) return 4432 + (j - 80); return -1; }
    if (n < 4352) return 3664 + (n - 3840);
    if (n < 4608) return 4176 + (n - 4352);
    return 4496 + (n - 4608);
}
__device__ __forceinline__ int wuq_srccol(int n) {
    int h = n >> 8, j = n & 255;
    if (j < 128) return h * 192 + j;
    if (j < 192) { int p = j - 128, blk = p >> 5, within = p & 31, second = within >> 4, jj = blk * 16 + (within & 15);
        return h * 192 + 128 + second * 32 + jj; }
    return -1;
}
__device__ void phase_prep(const Params& p) {
    extern __shared__ __attribute__((aligned(16))) char smem[];
    int tid = opaque_tid(); int wid = tid >> 6, lane = tid & 63;
    for (int r = blockIdx.x * 8 + wid; r < SEQ + NMEM; r += gridDim.x * 8) {
        const float* src; const float* g; u16* dst;
        if (r < SEQ) { src = p.x + (size_t)r * DM; g = p.norm_g; dst = (u16*)(p.ws + WS_H) + (size_t)r * DM; }
        else { src = p.mem + (size_t)(r - SEQ) * DM; g = p.mem_norm_g; dst = (u16*)(p.ws + WS_HM) + (size_t)(r - SEQ) * DM; }
        f32x4 v[8]; float ss = 0.f;
#pragma unroll
        for (int i = 0; i < 8; ++i) { v[i] = ((const f32x4*)src)[lane + 64 * i]; ss += v[i][0] * v[i][0] + v[i][1] * v[i][1] + v[i][2] * v[i][2] + v[i][3] * v[i][3]; }
        for (int o = 32; o > 0; o >>= 1) ss += __shfl_xor(ss, o);
        const float rinv = rsqrtf(ss / (float)DM + EPS);
#pragma unroll
        for (int i = 0; i < 8; ++i) { f32x4 gg = ((const f32x4*)g)[lane + 64 * i];
            u32x2 w = {cvtpk(v[i][0] * rinv * gg[0], v[i][1] * rinv * gg[1]), cvtpk(v[i][2] * rinv * gg[2], v[i][3] * rinv * gg[3])};
            *(u32x2*)(dst + 4 * (lane + 64 * i)) = w; }
    }
    {
        tid = opaque_tid();
        float* cs = (float*)(p.ws + WS_COS); float* sn = (float*)(p.ws + WS_SIN);
        for (int i = blockIdx.x * 512 + tid; i < SEQ * 32; i += gridDim.x * 512) {
            int t = i >> 5, j = i & 31;
            float inv_freq = 1.0f / powf(10000.f, (float)(2 * j) / 64.f);
            float ang = (float)p.positions[t] * inv_freq;
            cs[i] = cosf(ang); sn[i] = sinf(ang);
        }
    }
    u16* tile = (u16*)smem;
    constexpr int T0 = 32 * 216, T1 = T0 + 8 * 32, T2 = T1 + 4 * 32, T3 = T2 + 32 * 32, T4 = T3 + 3 * 16 * 32, T5 = T4 + 32 * 32;
    for (int T = blockIdx.x; T < T5; T += gridDim.x) {
        const float* W; int ldw, K, kt, nt, mode = 0; const float* gs = nullptr; u16* dst;
        int tt;
        if (T < T0) { tt = T; W = p.w_in; ldw = INW; K = 2048; kt = 32; mode = 1; dst = (u16*)(p.ws + WS_WINT); }
        else if (T < T1) { tt = T - T0; W = p.w_b_uq; ldw = 1536; K = 512; kt = 8; mode = 2; gs = p.b_q_lat_norm_g; dst = (u16*)(p.ws + WS_WUQT); }
        else if (T < T2) { tt = T - T1; W = p.w_b_ukv; ldw = 2048; K = 256; kt = 4; gs = p.b_kv_lat_norm_g; dst = (u16*)(p.ws + WS_WUKVT); }
        else if (T < T3) { tt = T - T2; W = p.w_mem_kv; ldw = 2048; K = 2048; kt = 32; dst = (u16*)(p.ws + WS_WMEMT); }
        else if (T < T4) { tt = T - T3; int n = tt / 512; tt -= n * 512; W = p.w_branch + (size_t)n * 1024 * DM; ldw = DM; K = 1024; kt = 16;
                           dst = (u16*)(p.ws + WS_WBRT) + (size_t)n * DM * 1024; }
        else { tt = T - T4; W = p.w_out; ldw = DM; K = 2048; kt = 32; dst = (u16*)(p.ws + WS_WOUTT); }
        (void)nt;
        const int k0 = (tt % kt) * 64, n0 = (tt / kt) * 64;
        tid = opaque_tid();
        {
            const int r = tid >> 6, c = tid & 63, n = n0 + c;
            int sc = n; if (mode == 1) sc = win_srccol(n); else if (mode == 2) sc = wuq_srccol(n);
#pragma unroll
            for (int ps = 0; ps < 8; ++ps) { const int k = k0 + r + 8 * ps;
                float v = (sc >= 0) ? W[(size_t)k * ldw + sc] : 0.f;
                if (gs) v *= gs[k];
                tile[c * 72 + r + 8 * ps] = f2bf(v); }
        }
        __syncthreads();
        {
            const int c = tid >> 3, k8 = tid & 7;
            u32x4 w = *(const u32x4*)(tile + c * 72 + k8 * 8);
            *(u32x4*)(dst + (size_t)(n0 + c) * K + k0 + k8 * 8) = w;
        }
        __syncthreads();
    }
}

constexpr int G_HT = 128 * 64;
__device__ __forceinline__ int g_lds_byte(int r, int c) { int st = (r >> 4) * 2 + (c >> 5), rr = r & 15, cc = c & 31, ob = rr * 64 + cc * 2; return st * 1024 + (ob ^ (((ob >> 9) & 1) << 5)); }
__device__ __forceinline__ void g_stage_rc(int b, int& R, int& C) { int st = b / 1024, sb = b % 1024, swz = sb ^ (((sb >> 9) & 1) << 5); R = (st >> 1) * 16 + swz / 64; C = (st & 1) * 32 + (swz % 64) / 2; }

__device__ __forceinline__ void gemm_kloop(const u16* __restrict__ A, const u16* __restrict__ Bt, const int K, const int brow, const int bcol,
                                           f32x4 (&acc)[2][2][4][2]) {
    extern __shared__ __attribute__((aligned(16))) char smem[];
    u16* shm = (u16*)smem;
#define SA(b, h) (shm + ((b) * 2 + (h)) * G_HT)
#define SB(b, h) (shm + (4 + (b) * 2 + (h)) * G_HT)
#define STAGE(P, RS, br, kt) do { const int _so = ((br) * K + (kt) * 64) * 2; \
    __builtin_amdgcn_raw_ptr_buffer_load_lds(RS, (__attribute__((address_space(3))) void*)((char*)(P) + tid_ * 16), 16, voff0, _so, 0, 0); \
    __builtin_amdgcn_raw_ptr_buffer_load_lds(RS, (__attribute__((address_space(3))) void*)((char*)(P) + tid_ * 16 + 8192), 16, voff1, _so, 0, 0); } while (0)
#define LDA(dst, b, h) for (int m = 0; m < 4; ++m) for (int k = 0; k < 2; ++k) \
    dst[m][k] = *reinterpret_cast<const bf16x8*>((char*)SA(b, h) + g_lds_byte(wr * 64 + m * 16 + fr, k * 32 + fq * 8))
#define LDB(dst, b, h) for (int n = 0; n < 2; ++n) for (int k = 0; k < 2; ++k) \
    dst[n][k] = *reinterpret_cast<const bf16x8*>((char*)SB(b, h) + g_lds_byte(wc * 32 + n * 16 + fr, k * 32 + fq * 8))
#define MMA(ai, bj, At_, Bt_) do { __builtin_amdgcn_s_setprio(1); \
    for (int m = 0; m < 4; ++m) for (int n = 0; n < 2; ++n) for (int k = 0; k < 2; ++k) \
      acc[ai][bj][m][n] = __builtin_amdgcn_mfma_f32_16x16x32_bf16(At_[m][k], Bt_[n][k], acc[ai][bj][m][n], 0, 0, 0); \
    __builtin_amdgcn_s_setprio(0); } while (0)
#define WAIT_V(n) asm volatile("s_waitcnt vmcnt(" #n ")" ::: "memory")
#define WAIT_L(n) asm volatile("s_waitcnt lgkmcnt(" #n ")" ::: "memory")
#define BAR __builtin_amdgcn_s_barrier()
#define SCHED __builtin_amdgcn_sched_barrier(0)
    const int tid_ = opaque_tid();
    const int wid = tid_ >> 6, lane = tid_ & 63, wr = wid >> 2, wc = wid & 3, fr = lane & 15, fq = lane >> 4;
#pragma unroll
    for (int a = 0; a < 2; ++a)
#pragma unroll
        for (int b = 0; b < 2; ++b)
#pragma unroll
            for (int m = 0; m < 4; ++m)
#pragma unroll
                for (int n = 0; n < 2; ++n) acc[a][b][m][n] = f32x4{0.f, 0.f, 0.f, 0.f};
    bf16x8 At[4][2], B0[2][2], B1[2][2];
    const int nt = K / 64;
    const __amdgpu_buffer_rsrc_t rsA = __builtin_amdgcn_make_buffer_rsrc((void*)A, (short)0, 0x7fffffff, 0x00020000);
    const __amdgpu_buffer_rsrc_t rsB = __builtin_amdgcn_make_buffer_rsrc((void*)Bt, (short)0, 0x7fffffff, 0x00020000);
    int voff0, voff1;
    { int _r, _c; g_stage_rc(tid_ * 16, _r, _c); voff0 = (_r * K + _c) * 2; g_stage_rc(tid_ * 16 + 8192, _r, _c); voff1 = (_r * K + _c) * 2; }
    STAGE(SB(0, 0), rsB, bcol, 0); STAGE(SA(0, 0), rsA, brow, 0);
    STAGE(SB(0, 1), rsB, bcol + 128, 0); STAGE(SA(0, 1), rsA, brow + 128, 0);
    if (wr == 1) BAR;
    WAIT_V(4); BAR;
    STAGE(SB(1, 0), rsB, bcol, 1); STAGE(SA(1, 0), rsA, brow, 1); STAGE(SB(1, 1), rsB, bcol + 128, 1);
    WAIT_V(6); BAR;
    for (int t = 0; t < nt - 2; t += 2) {
        LDB(B0, 0, 0); SCHED; LDA(At, 0, 0); STAGE(SA(1, 1), rsA, brow + 128, t + 1);
        WAIT_L(8); BAR; WAIT_L(0); MMA(0, 0, At, B0); BAR; SCHED;
        LDB(B1, 0, 1); STAGE(SB(0, 0), rsB, bcol, t + 2);
        BAR; WAIT_L(0); MMA(0, 1, At, B1); BAR;
        LDA(At, 0, 1); STAGE(SA(0, 0), rsA, brow, t + 2);
        BAR; WAIT_L(0); MMA(1, 0, At, B0); BAR; SCHED;
        STAGE(SB(0, 1), rsB, bcol + 128, t + 2);
        WAIT_V(6); BAR; MMA(1, 1, At, B1); BAR;
        LDB(B0, 1, 0); SCHED; LDA(At, 1, 0); STAGE(SA(0, 1), rsA, brow + 128, t + 2);
        WAIT_L(8); BAR; WAIT_L(0); MMA(0, 0, At, B0); BAR; SCHED;
        LDB(B1, 1, 1); STAGE(SB(1, 0), rsB, bcol, t + 3);
        BAR; WAIT_L(0); MMA(0, 1, At, B1); BAR;
        LDA(At, 1, 1); STAGE(SA(1, 0), rsA, brow, t + 3);
        BAR; WAIT_L(0); MMA(1, 0, At, B0); BAR; SCHED;
        STAGE(SB(1, 1), rsB, bcol + 128, t + 3);
        WAIT_V(6); BAR; MMA(1, 1, At, B1); BAR;
    }
    { LDB(B0, 0, 0); LDA(At, 0, 0); STAGE(SA(1, 1), rsA, brow + 128, nt - 1);
      BAR; WAIT_L(0); MMA(0, 0, At, B0); BAR;
      LDB(B1, 0, 1); BAR; WAIT_L(0); MMA(0, 1, At, B1); BAR;
      LDA(At, 0, 1); WAIT_V(4); BAR; WAIT_L(0); MMA(1, 0, At, B0); MMA(1, 1, At, B1); BAR; }
    { LDB(B0, 1, 0); LDA(At, 1, 0); WAIT_V(2); BAR; WAIT_L(0); MMA(0, 0, At, B0); BAR;
      LDB(B1, 1, 1); WAIT_V(0); BAR; WAIT_L(0); MMA(0, 1, At, B1); BAR;
      LDA(At, 1, 1); BAR; WAIT_L(0); MMA(1, 0, At, B0); MMA(1, 1, At, B1); BAR; }
    if (wr == 0) BAR;
#undef SA
#undef SB
#undef STAGE
#undef LDA
#undef LDB
#undef MMA
}

constexpr int EPT_LD = 260;
template <int AI>
__device__ __forceinline__ void acc_half_to_lds(const f32x4 (&acc)[2][2][4][2]) {
    extern __shared__ __attribute__((aligned(16))) char smem[];
    float* T = (float*)smem;
    const int tid_ = opaque_tid();
    const int wid = tid_ >> 6, lane = tid_ & 63, wr = wid >> 2, wc = wid & 3, fr = lane & 15, fq = lane >> 4;
    float* base = T + (wr * 64 + fq * 4) * EPT_LD + wc * 32 + fr;
#pragma unroll
    for (int bj = 0; bj < 2; ++bj)
#pragma unroll
        for (int m = 0; m < 4; ++m)
#pragma unroll
            for (int n = 0; n < 2; ++n)
#pragma unroll
                for (int j = 0; j < 4; ++j) base[(m * 16 + j) * EPT_LD + bj * 128 + n * 16] = acc[AI][bj][m][n][j];
}
__device__ __forceinline__ float wave_sum64(float v) { for (int o = 32; o > 0; o >>= 1) v += __shfl_xor(v, o); return v; }
__device__ __forceinline__ float wave_sum32(float v) { for (int o = 16; o > 0; o >>= 1) v += __shfl_xor(v, o); return v; }
__device__ __forceinline__ void store4_bf16(u16* p, float a, float b, float c, float d) { u32x2 w = {cvtpk(a, b), cvtpk(c, d)}; *(u32x2*)p = w; }

enum { EP_RAW = 0, EP_SILU = 1, EP_SIGMOID = 2, EP_NORM128 = 3, EP_NORM256 = 4, EP_RAW_SS = 5, EP_MISC = 6 };

__device__ __forceinline__ void epi_rows_inproj(const int mode, const int grow0, u16* __restrict__ dst, const int ld, const int half_skip,
                                                const float* __restrict__ g, const float scale, float* __restrict__ ssout, const int ss_stride, const Params& p) {
    extern __shared__ __attribute__((aligned(16))) char smem[];
    const float* T = (const float*)smem;
    const int tid_ = opaque_tid();
    const int wid = tid_ >> 6, lane = tid_ & 63;
    const int col = lane * 4;
    f32x4 gg = {1.f, 1.f, 1.f, 1.f};
    if (mode == EP_NORM128) gg = *(const f32x4*)(g + (col & 127));
    else if (mode == EP_NORM256) gg = *(const f32x4*)(g + col);
    for (int rr = 0; rr < 16; ++rr) {
        const int lr = wid * 16 + rr; const size_t row = (size_t)(grow0 + lr);
        f32x4 v = *(const f32x4*)(T + lr * EPT_LD + col);
        if (mode == EP_MISC) {
            u16* IK = (u16*)(p.ws + WS_IK); float* IW = (float*)(p.ws + WS_IW); float* BKPE = (float*)(p.ws + WS_BKPE); float* PESS = (float*)(p.ws + WS_PESS);
            const bool pe = (lane >= 20 && lane < 36);
            float ss = pe ? (v[0] * v[0] + v[1] * v[1] + v[2] * v[2] + v[3] * v[3]) : 0.f;
            ss = wave_sum64(ss);
            if (lane < 16) store4_bf16(IK + row * 64 + col, v[0], v[1], v[2], v[3]);
            else if (lane < 20) *(f32x4*)(IW + row * 16 + (col - 64)) = v;
            else if (lane < 36) *(f32x4*)(BKPE + row * 64 + (col - 80)) = v;
            if (lane == 0) PESS[row] = ss;
            continue;
        }
        if (mode == EP_SILU) { v[0] = silu_f(v[0]); v[1] = silu_f(v[1]); v[2] = silu_f(v[2]); v[3] = silu_f(v[3]); }
        else if (mode == EP_SIGMOID) { v[0] = sigmoid_f(v[0]); v[1] = sigmoid_f(v[1]); v[2] = sigmoid_f(v[2]); v[3] = sigmoid_f(v[3]); }
        else if (mode >= EP_NORM128) {
            float ss = v[0] * v[0] + v[1] * v[1] + v[2] * v[2] + v[3] * v[3];
            if (mode == EP_NORM128) { ss = wave_sum32(ss); const float rinv = rsqrtf(ss * (1.f / 128.f) + EPS) * scale; v[0] *= rinv * gg[0]; v[1] *= rinv * gg[1]; v[2] *= rinv * gg[2]; v[3] *= rinv * gg[3]; }
            else { ss = wave_sum64(ss);
                if (mode == EP_NORM256) { const float rinv = rsqrtf(ss * (1.f / 256.f) + EPS) * scale; v[0] *= rinv * gg[0]; v[1] *= rinv * gg[1]; v[2] *= rinv * gg[2]; v[3] *= rinv * gg[3]; }
                else if (lane == 0) ssout[row * ss_stride] = ss; }
        }
        store4_bf16(dst + row * ld + col + (lane >= 32 ? half_skip : 0), v[0], v[1], v[2], v[3]);
    }
}

__device__ void phase_inproj(const Params& p) {
    const int r = blockIdx.x, xcd = r & 7, slot = r >> 3, mi = slot >> 3, ni = slot & 7;
    f32x4 acc[2][2][4][2];
    for (int w = 0; w < 7; ++w) {
        const int pm = xcd * 4 + mi, pn = w * 8 + ni;
        const bool inproj = pn < NT_IN;
        if (!inproj && !(ni == 6 && pm < 8)) continue;
        {
            const u16* A_ = (const u16*)(p.ws + (inproj ? WS_H : WS_HM)); const u16* B_ = (const u16*)(p.ws + (inproj ? WS_WINT : WS_WMEMT));
            gemm_kloop(A_, B_, DM, inproj ? pm * 256 : 0, inproj ? pn * 256 : pm * 256, acc);
        }
        int mode; size_t dsto; int ld, half_skip = 0, brow; const float* g = nullptr; float scale = 1.f; size_t sso = 0; int ss_stride = 0;
        if (inproj) {
            brow = pm * 256;
            if (pn < 4) { mode = EP_NORM128; dsto = WS_AQ + pn * 512; ld = 1024; g = p.a_q_norm_g; scale = A_SCALE; }
            else if (pn == 4) { mode = EP_NORM128; dsto = WS_KVA; ld = 512; half_skip = 128; g = p.a_k_norm_g; }
            else if (pn == 5) { mode = EP_RAW; dsto = WS_KVA + 256; ld = 512; half_skip = 128; }
            else if (pn < 10) { mode = EP_SILU; dsto = WS_SZA + (pn - 6) * 512; ld = 1024; }
            else if (pn < 14) { mode = EP_RAW; dsto = WS_IQ + (pn - 10) * 512; ld = 1024; }
            else if (pn == 14) { mode = EP_MISC; dsto = 0; ld = 0; }
            else if (pn < 17) { mode = EP_RAW_SS; dsto = WS_BCQ + (pn - 15) * 512; ld = 512; sso = WS_LATQ + (pn - 15) * 4; ss_stride = 2; }
            else if (pn == 17) { mode = EP_RAW_SS; dsto = WS_BCKV; ld = 256; sso = WS_LATKV; ss_stride = 1; }
            else if (pn < 22) { mode = EP_SILU; dsto = WS_SZB + (pn - 18) * 512; ld = 1024; }
            else if (pn < 26) { mode = EP_NORM256; dsto = WS_CQ + (pn - 22) * 512; ld = 1024; g = p.c_q_norm_g; scale = C_SCALE; }
            else if (pn < 30) { mode = EP_SILU; dsto = WS_SZC + (pn - 26) * 512; ld = 1024; }
            else { mode = EP_SIGMOID; dsto = WS_G + (pn - 30) * 512; ld = 6144; }
        } else {
            brow = 0; ld = 1024;
            if (pm < 4) { mode = EP_NORM256; dsto = WS_CK + pm * 512; g = p.c_k_norm_g; }
            else { mode = EP_RAW; dsto = WS_CV + (pm - 4) * 512; }
        }
#pragma unroll 1
        for (int half = 0; half < 2; ++half) {
            __syncthreads();
            if (half == 0) acc_half_to_lds<0>(acc); else acc_half_to_lds<1>(acc);
            __syncthreads();
            epi_rows_inproj(mode, brow + half * 128, (u16*)(p.ws + dsto), ld, half_skip, g, scale, (float*)(p.ws + sso), ss_stride, p);
        }
        __syncthreads();
    }
}

__device__ __forceinline__ void epi_rows_mla_q(const int grow0, const int h, const Params& p) {
    extern __shared__ __attribute__((aligned(16))) char smem[];
    const float* T = (const float*)smem;
    const int tid_ = opaque_tid(); const int wid = tid_ >> 6, lane = tid_ & 63, col = lane * 4;
    const float* LATQ = (const float*)(p.ws + WS_LATQ); const float* COS = (const float*)(p.ws + WS_COS); const float* SIN = (const float*)(p.ws + WS_SIN);
    u16* QB = (u16*)(p.dout + DO_QB) + (size_t)h * SEQ * 192;
    const int pp = (col - 128) & 63, blk = pp >> 5, within = pp & 31, second = within >> 4, jj = blk * 16 + (within & 15);
    f32x4 gg = {0.f, 0.f, 0.f, 0.f};
    if (lane < 32) gg = *(const f32x4*)(p.b_q_norm_g + col);
    else if (lane < 48) gg = *(const f32x4*)(p.b_q_norm_g + 128 + second * 32 + jj);
    for (int rr = 0; rr < 16; ++rr) {
        const int lr = wid * 16 + rr; const size_t t = (size_t)(grow0 + lr);
        f32x4 v = *(const f32x4*)(T + lr * EPT_LD + col);
        const float rlat = rsqrtf((LATQ[t * 2] + LATQ[t * 2 + 1]) * (1.f / 512.f) + EPS);
        v[0] *= rlat; v[1] *= rlat; v[2] *= rlat; v[3] *= rlat;
        float ss = v[0] * v[0] + v[1] * v[1] + v[2] * v[2] + v[3] * v[3];
        ss = wave_sum64(ss);
        const float rinv = rsqrtf(ss * (1.f / 192.f) + EPS);
        v[0] *= rinv * gg[0]; v[1] *= rinv * gg[1]; v[2] *= rinv * gg[2]; v[3] *= rinv * gg[3];
        f32x4 o;
        o[0] = __shfl_xor(v[0], 4); o[1] = __shfl_xor(v[1], 4); o[2] = __shfl_xor(v[2], 4); o[3] = __shfl_xor(v[3], 4);
        if (lane >= 32 && lane < 48) {
            const f32x4 c = *(const f32x4*)(COS + t * 32 + jj), s = *(const f32x4*)(SIN + t * 32 + jj);
#pragma unroll
            for (int e = 0; e < 4; ++e) v[e] = second ? (v[e] * c[e] + o[e] * s[e]) : (v[e] * c[e] - o[e] * s[e]);
        }
        if (lane < 48) store4_bf16(QB + t * 192 + col, v[0] * B_SCALE, v[1] * B_SCALE, v[2] * B_SCALE, v[3] * B_SCALE);
    }
}
__device__ __forceinline__ void epi_rows_mla_kv(const int grow0, const int h, const Params& p) {
    extern __shared__ __attribute__((aligned(16))) char smem[];
    const float* T = (const float*)smem;
    const int tid_ = opaque_tid(); const int wid = tid_ >> 6, lane = tid_ & 63, col = lane * 4;
    const float* LATKV = (const float*)(p.ws + WS_LATKV); const float* PESS = (const float*)(p.ws + WS_PESS); const float* BKPE = (const float*)(p.ws + WS_BKPE);
    const float* COS = (const float*)(p.ws + WS_COS); const float* SIN = (const float*)(p.ws + WS_SIN);
    u16* KB = (u16*)(p.dout + DO_KB) + (size_t)h * SEQ * 192; u16* VB = (u16*)(p.dout + DO_VB) + (size_t)h * SEQ * 128;
    f32x4 gg = {1.f, 1.f, 1.f, 1.f};
    if (lane < 32) gg = *(const f32x4*)(p.b_k_norm_g + col);
    const int jj = (lane & 7) * 4;
    const f32x4 g1 = *(const f32x4*)(p.b_k_norm_g + 128 + jj), g2 = *(const f32x4*)(p.b_k_norm_g + 160 + jj);
    for (int rr = 0; rr < 16; ++rr) {
        const int lr = wid * 16 + rr; const size_t t = (size_t)(grow0 + lr);
        f32x4 v = *(const f32x4*)(T + lr * EPT_LD + col);
        const float rlat = rsqrtf(LATKV[t] * (1.f / 256.f) + EPS);
        v[0] *= rlat; v[1] *= rlat; v[2] *= rlat; v[3] *= rlat;
        float ss = v[0] * v[0] + v[1] * v[1] + v[2] * v[2] + v[3] * v[3];
        ss = wave_sum32(ss);
        const float rinv = rsqrtf((ss + PESS[t]) * (1.f / 192.f) + EPS);
        if (lane < 32) store4_bf16(KB + t * 192 + col, v[0] * rinv * gg[0], v[1] * rinv * gg[1], v[2] * rinv * gg[2], v[3] * rinv * gg[3]);
        else store4_bf16(VB + t * 128 + (col - 128), v[0], v[1], v[2], v[3]);
        if (lane < 8) {
            const f32x4 x1 = *(const f32x4*)(BKPE + t * 64 + jj), x2 = *(const f32x4*)(BKPE + t * 64 + 32 + jj);
            const f32x4 c = *(const f32x4*)(COS + t * 32 + jj), s = *(const f32x4*)(SIN + t * 32 + jj);
            float o1[4], o2[4];
#pragma unroll
            for (int e = 0; e < 4; ++e) { const float a = x1[e] * rinv * g1[e], b = x2[e] * rinv * g2[e]; o1[e] = a * c[e] - b * s[e]; o2[e] = b * c[e] + a * s[e]; }
            store4_bf16(KB + t * 192 + 128 + rope_phys(jj, 0), o1[0], o1[1], o1[2], o1[3]);
            store4_bf16(KB + t * 192 + 128 + rope_phys(jj, 1), o2[0], o2[1], o2[2], o2[3]);
        }
    }
}
__device__ void phase_mla_up(const Params& p) {
    const int r = blockIdx.x, xcd = r & 7, slot = r >> 3, pm = xcd * 4 + (slot >> 3), h = slot & 7;
    f32x4 acc[2][2][4][2];
#pragma unroll 1
    for (int which = 0; which < 2; ++which) {
        if (which == 0) gemm_kloop((const u16*)(p.ws + WS_BCQ), (const u16*)(p.ws + WS_WUQT), 512, pm * 256, h * 256, acc);
        else gemm_kloop((const u16*)(p.ws + WS_BCKV), (const u16*)(p.ws + WS_WUKVT), 256, pm * 256, h * 256, acc);
#pragma unroll 1
        for (int half = 0; half < 2; ++half) {
            __syncthreads();
            if (half == 0) acc_half_to_lds<0>(acc); else acc_half_to_lds<1>(acc);
            __syncthreads();
            if (which == 0) epi_rows_mla_q(pm * 256 + half * 128, h, p); else epi_rows_mla_kv(pm * 256 + half * 128, h, p);
        }
        __syncthreads();
    }
}

__device__ __forceinline__ void epi_rows_merge(const int grow0, const int pd, const int n, const Params& p) {
    extern __shared__ __attribute__((aligned(16))) char smem[];
    const float* T = (const float*)smem;
    const int tid_ = opaque_tid(); const int wid = tid_ >> 6, lane = tid_ & 63, col = lane * 4;
    const u16* G = (const u16*)(p.ws + WS_G); float* M = (float*)p.dout; u16* MERGED = (u16*)(p.ws + WS_MERGED);
    for (int rr = 0; rr < 16; ++rr) {
        const int lr = wid * 16 + rr; const size_t t = (size_t)(grow0 + lr);
        f32x4 v = *(const f32x4*)(T + lr * EPT_LD + col);
        const u32x2 gw = *(const u32x2*)(G + t * 6144 + n * 2048 + pd * 256 + col);
        const float g0 = __uint_as_float(gw[0] << 16), g1 = __uint_as_float(gw[0] & 0xffff0000u), g2 = __uint_as_float(gw[1] << 16), g3 = __uint_as_float(gw[1] & 0xffff0000u);
        v[0] *= g0; v[1] *= g1; v[2] *= g2; v[3] *= g3;
        float* mp = M + t * DM + pd * 256 + col;
        if (n > 0) { const f32x4 mv = *(const f32x4*)mp; v[0] += mv[0]; v[1] += mv[1]; v[2] += mv[2]; v[3] += mv[3]; }
        if (n < 2) *(f32x4*)mp = v;
        else store4_bf16(MERGED + t * DM + pd * 256 + col, v[0], v[1], v[2], v[3]);
    }
}
__device__ void phase_merge(const Params& p) {
    const int r = blockIdx.x, xcd = r & 7, slot = r >> 3, pm = xcd * 4 + (slot >> 3), pd = slot & 7;
    f32x4 acc[2][2][4][2];
#pragma unroll 1
    for (int n = 0; n < 3; ++n) {
        const u16* U = (const u16*)(p.ws + (n == 0 ? WS_UA : (n == 1 ? WS_UB : WS_UC)));
        gemm_kloop(U, (const u16*)(p.ws + WS_WBRT) + (size_t)n * DM * 1024, 1024, pm * 256, pd * 256, acc);
#pragma unroll 1
        for (int half = 0; half < 2; ++half) {
            __syncthreads();
            if (half == 0) acc_half_to_lds<0>(acc); else acc_half_to_lds<1>(acc);
            __syncthreads();
            epi_rows_merge(pm * 256 + half * 128, pd, n, p);
        }
        __syncthreads();
    }
}
__device__ __forceinline__ void epi_rows_out(const int grow0, const int pd, const Params& p) {
    extern __shared__ __attribute__((aligned(16))) char smem[];
    const float* T = (const float*)smem;
    const int tid_ = opaque_tid(); const int wid = tid_ >> 6, lane = tid_ & 63, col = lane * 4;
    float* OUT = (float*)p.dout;
    for (int rr = 0; rr < 16; ++rr) {
        const int lr = wid * 16 + rr; const size_t t = (size_t)(grow0 + lr);
        f32x4 v = *(const f32x4*)(T + lr * EPT_LD + col);
        const f32x4 xv = *(const f32x4*)(p.x + t * DM + pd * 256 + col);
        v[0] += xv[0]; v[1] += xv[1]; v[2] += xv[2]; v[3] += xv[3];
        *(f32x4*)(OUT + t * DM + pd * 256 + col) = v;
    }
}
__device__ void phase_out(const Params& p) {
    const int r = blockIdx.x, xcd = r & 7, slot = r >> 3, pm = xcd * 4 + (slot >> 3), pd = slot & 7;
    f32x4 acc[2][2][4][2];
    gemm_kloop((const u16*)(p.ws + WS_MERGED), (const u16*)(p.ws + WS_WOUTT), DM, pm * 256, pd * 256, acc);
#pragma unroll 1
    for (int half = 0; half < 2; ++half) {
        __syncthreads();
        if (half == 0) acc_half_to_lds<0>(acc); else acc_half_to_lds<1>(acc);
        __syncthreads();
        epi_rows_out(pm * 256 + half * 128, pd, p);
    }
    __syncthreads();
}

typedef short s16x4 __attribute__((ext_vector_type(4)));
constexpr float LOG2E = 1.4426950408889634f;
constexpr int MLA_KT = 12288, MLA_VT = 8192, MLA_GRP = MLA_KT + MLA_VT, MLA_BUF = 2 * MLA_GRP;
__device__ __forceinline__ int crow16(int r, int hi) { return (r & 3) + 8 * (r >> 2) + 4 * hi; }

__device__ void mla_qblock(const Params& p, const int h, const int qb) {
    extern __shared__ __attribute__((aligned(16))) char smem[];
    const int tid_ = opaque_tid();
    const int wid = __builtin_amdgcn_readfirstlane(tid_ >> 6), lane = tid_ & 63, r32 = lane & 31, hi = lane >> 5;
    const int grp = wid >> 2, wq = wid & 3;
    const int R0 = qb * 128, qrow = R0 + wq * 32 + r32;
    const int n_it = 2 * (qb + 1);
    const u16* QB = (const u16*)(p.dout + DO_QB) + ((size_t)h * SEQ + qrow) * 192;
    const __amdgpu_buffer_rsrc_t rs = __builtin_amdgcn_make_buffer_rsrc((void*)p.dout, (short)0, 0x7fffffff, 0x00020000);
    bf16x8 qr[12];
#pragma unroll
    for (int d0 = 0; d0 < 12; ++d0) qr[d0] = *(const bf16x8*)(QB + d0 * 16 + hi * 8);
    int voff[5];
#pragma unroll
    for (int i = 0; i < 5; ++i) {
        const int pc = wq * 5 + i;
        if (pc < 12) { const int o = pc * 1024 + lane * 16, row = o / 384, cpos = (o - row * 384) >> 4, f = (row >> 1) & 7;
            const int chunk = (cpos & ~7) | ((cpos & 7) ^ f); voff[i] = row * 384 + chunk * 16; }
        else { const int o = (pc - 12) * 1024 + lane * 16, sub = o >> 8, ksub = sub >> 2, csub = sub & 3, kq = (o & 255) >> 6, cc = (o & 63) >> 4;
            voff[i] = (ksub * 4 + kq) * 256 + (csub * 4 + cc) * 16; }
    }
    const int kbase = (int)DO_KB + h * SEQ * 384, vbase = (int)DO_VB + h * SEQ * 256;
#define MLA_DMA(it_) do { const int key0_ = (it_) * 64 + grp * 32; char* img_ = smem + ((it_) % 3) * MLA_BUF + grp * MLA_GRP; \
    _Pragma("unroll") for (int i = 0; i < 5; ++i) { const int pc = wq * 5 + i; \
        const int so_ = (pc < 12) ? (kbase + key0_ * 384) : (vbase + key0_ * 256); \
        __builtin_amdgcn_raw_ptr_buffer_load_lds(rs, (__attribute__((address_space(3))) void*)(img_ + pc * 1024 + lane * 16), 16, voff[i], so_, 0, 0); } } while (0)
    int kaddr[4];
    { const int f = (r32 >> 1) & 7;
#pragma unroll
      for (int a = 0; a < 4; ++a) kaddr[a] = r32 * 384 + 16 * ((2 * a + hi) ^ f); }
    const int vlane = hi * 1024 + ((lane & 15) >> 2) * 64 + ((lane >> 4) & 1) * 32 + (lane & 3) * 8;
    f32x16 o[4];
#pragma unroll
    for (int d = 0; d < 4; ++d)
#pragma unroll
        for (int r = 0; r < 16; ++r) o[d][r] = 0.f;
    float m_run = -1e30f, l_run = 0.f;
    asm volatile("s_waitcnt vmcnt(0)" ::: "memory");
    __builtin_amdgcn_s_barrier();
    MLA_DMA(0);
    if (n_it > 1) MLA_DMA(1);
    for (int it = 0; it < n_it; ++it) {
        if (it + 1 < n_it) asm volatile("s_waitcnt vmcnt(5)" ::: "memory"); else asm volatile("s_waitcnt vmcnt(0)" ::: "memory");
        __builtin_amdgcn_s_barrier();
        if (it + 2 < n_it) MLA_DMA(it + 2);
        const int key0 = it * 64 + grp * 32;
        if (key0 <= R0 + wq * 32 + 31) {
            const char* Kt = smem + (it % 3) * MLA_BUF + grp * MLA_GRP;
            const int vt = (int)(uintptr_t)(Kt + MLA_KT) + vlane;
            f32x16 pt;
#pragma unroll
            for (int r = 0; r < 16; ++r) pt[r] = 0.f;
#pragma unroll
            for (int d0 = 0; d0 < 12; ++d0) {
                const bf16x8 kf = *(const bf16x8*)(Kt + kaddr[d0 & 3] + (d0 >> 2) * 128);
                pt = __builtin_amdgcn_mfma_f32_32x32x16_bf16(kf, qr[d0], pt, 0, 0, 0);
            }
            if (key0 + 31 > R0 + wq * 32) {
#pragma unroll
                for (int r = 0; r < 16; ++r) if (key0 + crow16(r, hi) > qrow) pt[r] = -INFINITY;
            }
            float pmax = pt[0];
#pragma unroll
            for (int r = 1; r < 16; ++r) pmax = fmaxf(pmax, pt[r]);
            { auto rr = __builtin_amdgcn_permlane32_swap(__float_as_uint(pmax), __float_as_uint(pmax), false, false);
              pmax = fmaxf(__uint_as_float(rr[0]), __uint_as_float(rr[1])); }
            const float mn = fmaxf(m_run, pmax);
            const float alpha = __builtin_amdgcn_exp2f((m_run - mn) * LOG2E);
            const float mneg = -mn * LOG2E;
            m_run = mn;
            float ps = 0.f;
#pragma unroll
            for (int r = 0; r < 16; ++r) { pt[r] = __builtin_amdgcn_exp2f(fmaf(pt[r], LOG2E, mneg)); ps += pt[r]; }
            { auto rr = __builtin_amdgcn_permlane32_swap(__float_as_uint(ps), __float_as_uint(ps), false, false);
              ps = __uint_as_float(rr[0]) + __uint_as_float(rr[1]); }
            l_run = l_run * alpha + ps;
            if (__any(alpha != 1.f)) {
#pragma unroll
                for (int d = 0; d < 4; ++d)
#pragma unroll
                    for (int r = 0; r < 16; ++r) o[d][r] *= alpha;
            }
            bf16x8 pa[2];
#pragma unroll
            for (int s = 0; s < 2; ++s) { u32x4 w = {cvtpk(pt[8 * s + 0], pt[8 * s + 1]), cvtpk(pt[8 * s + 2], pt[8 * s + 3]), cvtpk(pt[8 * s + 4], pt[8 * s + 5]), cvtpk(pt[8 * s + 6], pt[8 * s + 7])};
                pa[s] = *reinterpret_cast<bf16x8*>(&w); }
#define TRRD(dst, off) asm volatile("ds_read_b64_tr_b16 %0, %1 offset:%2" : "=&v"(dst) : "v"(vt), "i"(off) : "memory")
#define MLA_PV(d0) do { s16x4 a0, a1, b0, b1; TRRD(a0, (d0) * 256); TRRD(a1, (d0) * 256 + 2048); TRRD(b0, (d0) * 256 + 4096); TRRD(b1, (d0) * 256 + 6144); \
            asm volatile("s_waitcnt lgkmcnt(0)" ::: "memory"); __builtin_amdgcn_sched_barrier(0); \
            o[d0] = __builtin_amdgcn_mfma_f32_32x32x16_bf16((bf16x8){a0[0], a0[1], a0[2], a0[3], a1[0], a1[1], a1[2], a1[3]}, pa[0], o[d0], 0, 0, 0); \
            o[d0] = __builtin_amdgcn_mfma_f32_32x32x16_bf16((bf16x8){b0[0], b0[1], b0[2], b0[3], b1[0], b1[1], b1[2], b1[3]}, pa[1], o[d0], 0, 0, 0); } while (0)
            MLA_PV(0); MLA_PV(1); MLA_PV(2); MLA_PV(3);
#undef MLA_PV
#undef TRRD
        }
    }
#undef MLA_DMA
    __builtin_amdgcn_s_barrier();
    float* cmb = (float*)smem + (size_t)wq * 66 * 64;
    if (grp == 1) {
#pragma unroll
        for (int d = 0; d < 4; ++d)
#pragma unroll
            for (int r = 0; r < 16; ++r) cmb[(d * 16 + r) * 64 + lane] = o[d][r];
        cmb[64 * 64 + lane] = m_run; cmb[65 * 64 + lane] = l_run;
    }
    __syncthreads();
    if (grp == 0) {
        const float m1 = cmb[64 * 64 + lane], l1 = cmb[65 * 64 + lane];
        const float mn = fmaxf(m_run, m1);
        const float a0 = __builtin_amdgcn_exp2f((m_run - mn) * LOG2E), a1 = __builtin_amdgcn_exp2f((m1 - mn) * LOG2E);
        const float linv = 1.f / (l_run * a0 + l1 * a1);
        const float s0 = a0 * linv, s1 = a1 * linv;
        const u16* SZ = (const u16*)(p.ws + WS_SZB) + (size_t)qrow * 1024 + h * 128;
        u16* UB = (u16*)(p.ws + WS_UB) + (size_t)qrow * 1024 + h * 128;
#pragma unroll
        for (int d = 0; d < 4; ++d)
#pragma unroll
            for (int a = 0; a < 4; ++a) {
                const int dim = d * 32 + 8 * a + 4 * hi;
                const u32x2 zw = *(const u32x2*)(SZ + dim);
                float v[4];
#pragma unroll
                for (int b = 0; b < 4; ++b) v[b] = o[d][4 * a + b] * s0 + cmb[(d * 16 + 4 * a + b) * 64 + lane] * s1;
                v[0] *= __uint_as_float(zw[0] << 16); v[1] *= __uint_as_float(zw[0] & 0xffff0000u); v[2] *= __uint_as_float(zw[1] << 16); v[3] *= __uint_as_float(zw[1] & 0xffff0000u);
                store4_bf16(UB + dim, v[0], v[1], v[2], v[3]);
            }
    }
    __syncthreads();
}
__device__ void phase_mla_attn(const Params& p) {
    const int h = blockIdx.x & 7, i = blockIdx.x >> 3;
    mla_qblock(p, h, 63 - i);
    mla_qblock(p, h, i);
}

constexpr int IDX_CAP = 1024, IDX_WAVE_LDS = 2 * IDX_CAP * 4 + 2 * IDX_CAP * 2 + 1024;
__device__ __forceinline__ unsigned ordk(unsigned b) { return (b & 0x80000000u) ? ~b : (b | 0x80000000u); }

__device__ __forceinline__ float idx_prune(unsigned* lk, u16* li, unsigned* hist, const int n, const int lane) {
    unsigned prefix = 0; int need = TOPK;
#pragma unroll 1
    for (int d = 3; d >= 0; --d) {
        const int sh = 8 * d;
        *(u32x4*)(hist + lane * 4) = (u32x4){0u, 0u, 0u, 0u};
        for (int e = lane; e < n; e += 64) { const unsigned k = ordk(lk[e]);
            const bool match = (d == 3) || ((k >> (sh + 8)) == (prefix >> (sh + 8)));
            if (match) atomicAdd(&hist[(k >> sh) & 255], 1u); }
        const u32x4 hv = *(const u32x4*)(hist + lane * 4);
        const int s = (int)(hv[0] + hv[1] + hv[2] + hv[3]);
        int S = s;
#pragma unroll
        for (int o = 1; o < 64; o <<= 1) { const int v = __shfl_down(S, o); if (lane + o < 64) S += v; }
        const int above = S - s;
        const bool cross = (above < need) && (S >= need);
        const unsigned long long bm = __ballot(cross);
        const int L = __ffsll((long long)bm) - 1;
        int dsel = 0, nneed = 0, acc = above; bool found = false;
#pragma unroll
        for (int i = 3; i >= 0; --i) { const int hc = (int)hv[i];
            if (!found && acc + hc >= need) { dsel = lane * 4 + i; nneed = need - acc; found = true; }
            acc += hc; }
        dsel = __shfl(dsel, L); nneed = __shfl(nneed, L);
        prefix |= ((unsigned)dsel) << sh; need = nneed;
    }
    int outc = 0, eqc = 0;
    for (int c0 = 0; c0 < n; c0 += 64) {
        const int e = c0 + lane; const bool in = e < n;
        const unsigned kb = in ? lk[e] : 0u; const u16 ix = in ? li[e] : (u16)0; const unsigned k = ordk(kb);
        const bool gt = in && k > prefix, eq = in && k == prefix;
        const unsigned long long beq = __ballot(eq);
        const int eqr = eqc + __popcll(beq & ((1ull << lane) - 1ull));
        const bool keep = gt || (eq && eqr < need);
        const unsigned long long bk = __ballot(keep);
        const int pos = outc + __popcll(bk & ((1ull << lane) - 1ull));
        if (keep) { lk[pos] = kb; li[pos] = ix; }
        outc += __popcll(bk); eqc += __popcll(beq);
    }
    const unsigned tb = (prefix & 0x80000000u) ? (prefix & 0x7fffffffu) : ~prefix;
    return __uint_as_float(tb);
}

__device__ void idx_pair(const Params& p, const int pr, char* wlds, const int lane) {
    const int t0 = 2 * pr, c = lane & 31, hi = lane >> 5, tq = t0 + hi;
    int* SEL = (int*)(p.ws + WS_SEL); int* CNT = (int*)(p.ws + WS_CNT);
    if (t0 + 1 < TOPK) {
        for (int q = 0; q < 2; ++q) { const int t = t0 + q; for (int i = lane; i <= t; i += 64) SEL[(size_t)t * TOPK + i] = i; if (lane == 0) CNT[t] = t + 1; }
        return;
    }
    unsigned* lkA = (unsigned*)wlds; unsigned* lkB = lkA + IDX_CAP; u16* liA = (u16*)(lkB + IDX_CAP); u16* liB = liA + IDX_CAP; unsigned* hist = (unsigned*)(liB + IDX_CAP);
    unsigned* lk = hi ? lkB : lkA; u16* li = hi ? liB : liA;
    const u16* IQ = (const u16*)(p.ws + WS_IQ); const u16* IK = (const u16*)(p.ws + WS_IK); const float* IW = (const float*)(p.ws + WS_IW);
    bf16x8 af[4];
    { const int aq = (c >> 2) & 1, ah = (c & 3) + 4 * (c >> 3);
      const u16* ap = IQ + (size_t)(t0 + aq) * 1024 + ah * 64 + hi * 8;
#pragma unroll
      for (int s = 0; s < 4; ++s) af[s] = *(const bf16x8*)(ap + 16 * s); }
    float w[16];
    { const f32x4* wp = (const f32x4*)(IW + (size_t)tq * 16);
#pragma unroll
      for (int i = 0; i < 4; ++i) { const f32x4 v = wp[i]; w[4 * i] = v[0]; w[4 * i + 1] = v[1]; w[4 * i + 2] = v[2]; w[4 * i + 3] = v[3]; } }
    int cntA = 0, cntB = 0; float tau = -INFINITY;
    const int ntiles = (t0 + 2 + 31) >> 5;
    const u16* kp = IK + (size_t)c * 64 + hi * 8;
    bf16x8 bn[4];
#pragma unroll
    for (int s = 0; s < 4; ++s) bn[s] = *(const bf16x8*)(kp + 16 * s);
    for (int j = 0; j < ntiles; ++j) {
        bf16x8 bc[4];
#pragma unroll
        for (int s = 0; s < 4; ++s) bc[s] = bn[s];
        if (j + 1 < ntiles) {
#pragma unroll
            for (int s = 0; s < 4; ++s) bn[s] = *(const bf16x8*)(kp + (size_t)(j + 1) * 32 * 64 + 16 * s);
        }
        f32x16 d;
#pragma unroll
        for (int r = 0; r < 16; ++r) d[r] = 0.f;
#pragma unroll
        for (int s = 0; s < 4; ++s) d = __builtin_amdgcn_mfma_f32_32x32x16_bf16(af[s], bc[s], d, 0, 0, 0);
        float sc = 0.f;
#pragma unroll
        for (int r = 0; r < 16; ++r) sc = fmaf(w[r], fmaxf(d[r], 0.f), sc);
        const int key = j * 32 + c;
        const bool pass = (key <= tq) && (sc > tau);
        const unsigned long long mask = __ballot(pass);
        if (mask != 0ull) {
            const unsigned mA = (unsigned)mask, mB = (unsigned)(mask >> 32);
            const unsigned mq = hi ? mB : mA;
            const int pos = (hi ? cntB : cntA) + __popc(mq & ((1u << c) - 1u));
            if (pass) { lk[pos] = __float_as_uint(sc); li[pos] = (u16)key; }
            cntA += __popc(mA); cntB += __popc(mB);
            if (cntA > IDX_CAP - 32) { const float ta = idx_prune(lkA, liA, hist, cntA, lane); cntA = TOPK; if (!hi) tau = ta; }
            if (cntB > IDX_CAP - 32) { const float tb = idx_prune(lkB, liB, hist, cntB, lane); cntB = TOPK; if (hi) tau = tb; }
        }
    }
    if (cntA > TOPK) { idx_prune(lkA, liA, hist, cntA, lane); }
    if (cntB > TOPK) { idx_prune(lkB, liB, hist, cntB, lane); }
#pragma unroll
    for (int i = 0; i < 4; ++i) { SEL[(size_t)t0 * TOPK + lane + 64 * i] = (int)liA[lane + 64 * i]; SEL[(size_t)(t0 + 1) * TOPK + lane + 64 * i] = (int)liB[lane + 64 * i]; }
    if (lane == 0) { CNT[t0] = TOPK; CNT[t0 + 1] = TOPK; }
}
__device__ void phase_indexer(const Params& p) {
    extern __shared__ __attribute__((aligned(16))) char smem[];
    const int tid_ = opaque_tid();
    const int wid = __builtin_amdgcn_readfirstlane(tid_ >> 6), lane = tid_ & 63;
    char* wlds = smem + wid * IDX_WAVE_LDS;
    const int gw = blockIdx.x * 8 + wid;
    idx_pair(p, 4095 - gw, wlds, lane);
    idx_pair(p, gw, wlds, lane);
    __syncthreads();
}

__device__ __forceinline__ float softmax_cols16(f32x4 (&S)[16]) {
    float mx = S[0][0];
#pragma unroll
    for (int kb = 0; kb < 16; ++kb)
#pragma unroll
        for (int i = 0; i < 4; ++i) mx = fmaxf(mx, S[kb][i]);
    mx = fmaxf(mx, __shfl_xor(mx, 16)); mx = fmaxf(mx, __shfl_xor(mx, 32));
    const float mneg = -mx * LOG2E;
    float sum = 0.f;
#pragma unroll
    for (int kb = 0; kb < 16; ++kb)
#pragma unroll
        for (int i = 0; i < 4; ++i) { S[kb][i] = __builtin_amdgcn_exp2f(fmaf(S[kb][i], LOG2E, mneg)); sum += S[kb][i]; }
    sum += __shfl_xor(sum, 16); sum += __shfl_xor(sum, 32);
    return sum;
}
__device__ __forceinline__ bf16x8 pack_p(const f32x4& a, const f32x4& b) {
    u32x4 w = {cvtpk(a[0], a[1]), cvtpk(a[2], a[3]), cvtpk(b[0], b[1]), cvtpk(b[2], b[3])};
    return *reinterpret_cast<bf16x8*>(&w);
}
#define TRRD16(dst, base, off) asm volatile("ds_read_b64_tr_b16 %0, %1 offset:%2" : "=&v"(dst) : "v"(base), "i"(off) : "memory")

constexpr int SP_WAVE_LDS = 1024 + 2 * 8192;
constexpr int SP_RELB_OFF = 8 * SP_WAVE_LDS;
__device__ void sp_item(const Params& p, const int t, const int g, char* wl, const float* relb_l, const int lane) {
    u16* sel_l = (u16*)wl; unsigned char* bkt_l = (unsigned char*)(wl + 512); char* vtile = wl + 1024;
    const int i16 = lane & 15, c = lane >> 4;
    const int* SEL = (const int*)(p.ws + WS_SEL); const int cnt = ((const int*)(p.ws + WS_CNT))[t];
    const u16* KVA = (const u16*)(p.ws + WS_KVA);
    const __amdgpu_buffer_rsrc_t rs = __builtin_amdgcn_make_buffer_rsrc((void*)(p.ws + WS_KVA), (short)0, 0x7fffffff, 0x00020000);
    {
        const int pt = p.positions[t];
#pragma unroll
        for (int i = 0; i < 4; ++i) { const int slot = lane + 64 * i; const int s = (slot < cnt) ? SEL[(size_t)t * TOPK + slot] : 0;
            sel_l[slot] = (u16)s; bkt_l[slot] = (unsigned char)t5_bucket(pt - p.positions[s]); }
    }
#define SP_VDMA(u_) do { char* dst_ = vtile + ((u_) & 1) * 8192; \
    _Pragma("unroll") for (int m = 0; m < 8; ++m) { const int kl_ = 8 * (m >> 1) + (i16 >> 1), ch_ = 8 * (m & 1) + 2 * c + (lane & 1); \
        const int tok_ = sel_l[(u_) * 32 + kl_]; \
        __builtin_amdgcn_raw_ptr_buffer_load_lds(rs, (__attribute__((address_space(3))) void*)(dst_ + m * 1024 + lane * 16), 16, tok_ * 1024 + g * 512 + 256 + ch_ * 16, 0, 0, 0); } } while (0)
    SP_VDMA(0); SP_VDMA(1);
    bf16x8 qf[4];
    { const u16* qp = (const u16*)(p.ws + WS_AQ) + (size_t)t * 1024 + (g * 4 + (i16 & 3)) * 128 + 8 * c;
#pragma unroll
      for (int s = 0; s < 4; ++s) { qf[s] = *(const bf16x8*)(qp + 32 * s); if (i16 >= 4) qf[s] = (bf16x8){0, 0, 0, 0, 0, 0, 0, 0}; } }
    f32x4 S[16];
#pragma unroll
    for (int kb = 0; kb < 16; ++kb) {
        const int tok = sel_l[16 * kb + i16];
        const u16* kp = KVA + (size_t)tok * 512 + g * 256 + 8 * c;
        f32x4 a = {0.f, 0.f, 0.f, 0.f};
#pragma unroll
        for (int s = 0; s < 4; ++s) { const bf16x8 kf = *(const bf16x8*)(kp + 32 * s); a = __builtin_amdgcn_mfma_f32_16x16x32_bf16(kf, qf[s], a, 0, 0, 0); }
        S[kb] = a;
    }
#pragma unroll
    for (int kb = 0; kb < 16; ++kb) {
        const unsigned bw = *(const unsigned*)(bkt_l + 16 * kb + 4 * c);
#pragma unroll
        for (int i = 0; i < 4; ++i) { const int slot = 16 * kb + 4 * c + i; const int b = (bw >> (8 * i)) & 255;
            const float bias = relb_l[b * 8 + g * 4 + (i16 & 3)];
            S[kb][i] = (slot < cnt) ? (S[kb][i] + bias) : -INFINITY; }
    }
    const float lsum = softmax_cols16(S);
    f32x4 O[8];
#pragma unroll
    for (int d = 0; d < 8; ++d) O[d] = f32x4{0.f, 0.f, 0.f, 0.f};
    const int vlane = (c >> 1) * 2048 + (c & 1) * 128 + (i16 >> 2) * 32 + (i16 & 3) * 8;
#pragma unroll
    for (int u = 0; u < 8; ++u) {
        if (u < 7) asm volatile("s_waitcnt vmcnt(8)" ::: "memory"); else asm volatile("s_waitcnt vmcnt(0)" ::: "memory");
        const int vb = (int)(uintptr_t)(vtile + (u & 1) * 8192) + vlane;
        const bf16x8 pf = pack_p(S[2 * u], S[2 * u + 1]);
#define SP_PV(d0) do { s16x4 x0, x1; TRRD16(x0, vb, (d0) * 256); TRRD16(x1, vb, (d0) * 256 + 4096); \
        asm volatile("s_waitcnt lgkmcnt(0)" ::: "memory"); __builtin_amdgcn_sched_barrier(0); \
        O[d0] = __builtin_amdgcn_mfma_f32_16x16x32_bf16((bf16x8){x0[0], x0[1], x0[2], x0[3], x1[0], x1[1], x1[2], x1[3]}, pf, O[d0], 0, 0, 0); } while (0)
        SP_PV(0); SP_PV(1); SP_PV(2); SP_PV(3); SP_PV(4); SP_PV(5); SP_PV(6); SP_PV(7);
#undef SP_PV
        if (u + 2 < 8) SP_VDMA(u + 2);
    }
#undef SP_VDMA
    if (i16 < 4) {
        const float linv = 1.f / lsum;
        const size_t ob = (size_t)t * 1024 + (g * 4 + i16) * 128 + 4 * c;
        const u16* SZ = (const u16*)(p.ws + WS_SZA) + ob; u16* UA = (u16*)(p.ws + WS_UA) + ob;
#pragma unroll
        for (int d = 0; d < 8; ++d) { const u32x2 zw = *(const u32x2*)(SZ + d * 16);
            store4_bf16(UA + d * 16, O[d][0] * linv * __uint_as_float(zw[0] << 16), O[d][1] * linv * __uint_as_float(zw[0] & 0xffff0000u),
                        O[d][2] * linv * __uint_as_float(zw[1] << 16), O[d][3] * linv * __uint_as_float(zw[1] & 0xffff0000u)); }
    }
}
__device__ void phase_sparse_attn(const Params& p) {
    extern __shared__ __attribute__((aligned(16))) char smem[];
    const int tid_ = opaque_tid();
    const int wid = __builtin_amdgcn_readfirstlane(tid_ >> 6), lane = tid_ & 63;
    float* relb_l = (float*)(smem + SP_RELB_OFF);
    __syncthreads();
    if (tid_ < 256) relb_l[tid_] = p.rel_bias[tid_];
    __syncthreads();
    char* wl = smem + wid * SP_WAVE_LDS;
    const int g = blockIdx.x & 1, wg = (blockIdx.x >> 1) * 8 + wid;
    for (int t = wg; t < SEQ; t += 1024) sp_item(p, t, g, wl, relb_l, lane);
    asm volatile("s_waitcnt vmcnt(0)" ::: "memory");
    __syncthreads();
}

__device__ void phase_mem_attn(const Params& p) {
    extern __shared__ __attribute__((aligned(16))) char smem[];
    const int tid_ = opaque_tid();
    const int wid = __builtin_amdgcn_readfirstlane(tid_ >> 6), lane = tid_ & 63, i16 = lane & 15, c = lane >> 4;
    const int hh = blockIdx.x & 3, q0 = (blockIdx.x >> 2) * 128 + wid * 16;
    const __amdgpu_buffer_rsrc_t rsK = __builtin_amdgcn_make_buffer_rsrc((void*)(p.ws + WS_CK), (short)0, 0x7fffffff, 0x00020000);
    const __amdgpu_buffer_rsrc_t rsV = __builtin_amdgcn_make_buffer_rsrc((void*)(p.ws + WS_CV), (short)0, 0x7fffffff, 0x00020000);
    __syncthreads();
#pragma unroll 4
    for (int m = 0; m < 16; ++m) { const int o = (wid * 16 + m) * 1024 + lane * 16, key = o >> 9, cpos = (o & 511) >> 4;
        const int chunk = (cpos & 16) | ((cpos & 15) ^ (key & 15));
        __builtin_amdgcn_raw_ptr_buffer_load_lds(rsK, (__attribute__((address_space(3))) void*)(smem + o), 16, key * 2048 + hh * 512 + chunk * 16, 0, 0, 0); }
    bf16x8 qf[8];
    { const u16* qp = (const u16*)(p.ws + WS_CQ) + (size_t)(q0 + i16) * 1024 + hh * 256 + 8 * c;
#pragma unroll
      for (int s = 0; s < 8; ++s) qf[s] = *(const bf16x8*)(qp + 32 * s); }
    asm volatile("s_waitcnt vmcnt(0)" ::: "memory");
    __syncthreads();
    f32x4 S[16];
    {
        int kbase[4];
#pragma unroll
        for (int a = 0; a < 4; ++a) kbase[a] = i16 * 512 + 16 * ((4 * a + c) ^ i16);
#pragma unroll
        for (int kb = 0; kb < 16; ++kb) {
            f32x4 acc = {0.f, 0.f, 0.f, 0.f};
            int kofs = kb * 8192; asm volatile("" : "+v"(kofs));
#pragma unroll
            for (int s = 0; s < 8; ++s) { const bf16x8 kf = *(const bf16x8*)(smem + kofs + kbase[s & 3] + (s >> 2) * 256);
                acc = __builtin_amdgcn_mfma_f32_16x16x32_bf16(kf, qf[s], acc, 0, 0, 0); }
            asm volatile("" : "+v"(acc));
            S[kb] = acc;
        }
    }
    __syncthreads();
#pragma unroll 4
    for (int m = 0; m < 16; ++m) { const int o = (wid * 16 + m) * 1024 + lane * 16, sub = o >> 8, key = (sub >> 4) * 8 + ((o & 255) >> 5), chunk = (sub & 15) * 2 + ((o >> 4) & 1);
        __builtin_amdgcn_raw_ptr_buffer_load_lds(rsV, (__attribute__((address_space(3))) void*)(smem + o), 16, key * 2048 + hh * 512 + chunk * 16, 0, 0, 0); }
    const float lsum = softmax_cols16(S);
    asm volatile("s_waitcnt vmcnt(0)" ::: "memory");
    __syncthreads();
    f32x4 O[16];
#pragma unroll
    for (int d = 0; d < 16; ++d) O[d] = f32x4{0.f, 0.f, 0.f, 0.f};
    const int vlane = (int)(uintptr_t)smem + (c >> 1) * 4096 + (c & 1) * 128 + (i16 >> 2) * 32 + (i16 & 3) * 8;
#pragma unroll
    for (int u = 0; u < 8; ++u) {
        const int vb = vlane + u * 16384;
        const bf16x8 pf = pack_p(S[2 * u], S[2 * u + 1]);
#define MEM_PV(d0) do { s16x4 x0, x1; TRRD16(x0, vb, (d0) * 256); TRRD16(x1, vb, (d0) * 256 + 8192); \
        asm volatile("s_waitcnt lgkmcnt(0)" ::: "memory"); __builtin_amdgcn_sched_barrier(0); \
        O[d0] = __builtin_amdgcn_mfma_f32_16x16x32_bf16((bf16x8){x0[0], x0[1], x0[2], x0[3], x1[0], x1[1], x1[2], x1[3]}, pf, O[d0], 0, 0, 0); } while (0)
        MEM_PV(0); MEM_PV(1); MEM_PV(2); MEM_PV(3); MEM_PV(4); MEM_PV(5); MEM_PV(6); MEM_PV(7);
        MEM_PV(8); MEM_PV(9); MEM_PV(10); MEM_PV(11); MEM_PV(12); MEM_PV(13); MEM_PV(14); MEM_PV(15);
#undef MEM_PV
    }
    {
        const float linv = 1.f / lsum;
        const size_t ob = (size_t)(q0 + i16) * 1024 + hh * 256 + 4 * c;
        const u16* SZ = (const u16*)(p.ws + WS_SZC) + ob; u16* UC = (u16*)(p.ws + WS_UC) + ob;
#pragma unroll
        for (int d = 0; d < 16; ++d) { const u32x2 zw = *(const u32x2*)(SZ + d * 16);
            store4_bf16(UC + d * 16, O[d][0] * linv * __uint_as_float(zw[0] << 16), O[d][1] * linv * __uint_as_float(zw[0] & 0xffff0000u),
                        O[d][2] * linv * __uint_as_float(zw[1] << 16), O[d][3] * linv * __uint_as_float(zw[1] & 0xffff0000u)); }
    }
    __syncthreads();
}

constexpr int MEGA_LDS = SP_RELB_OFF + 1024;
__global__ void __launch_bounds__(512) mega_kernel(Params p) {
    cooperative_groups::grid_group grid = cooperative_groups::this_grid();
    for (int ph = p.phase_lo; ph < p.phase_hi; ++ph) {
        if (ph == 1) phase_prep(p);
        else if (ph == 2) phase_inproj(p);
        else if (ph == 3) { phase_mla_up(p); phase_indexer(p); phase_mem_attn(p); }
        else if (ph == 4) { phase_mla_attn(p); phase_sparse_attn(p); }
        else if (ph == 5) phase_merge(p);
        else if (ph == 6) phase_out(p);
        if (ph + 1 < p.phase_hi) grid.sync();
    }
}

extern "C" void kernel_launch(void* const* d_in, const int* in_sizes, int n_in, void* d_out, int out_size, void* d_ws, size_t ws_size,
                              hipStream_t stream) {
    if (ws_size < WS_END) { fprintf(stderr, "ws too small: %zu < %zu\n", ws_size, WS_END); return; }
    const float* x = (const float*)d_in[0];
    const float* mem = (const float*)d_in[1];
    const int* positions = (const int*)d_in[2];
    const float* rel_bias = (const float*)d_in[3];
    const float* norm_g = (const float*)d_in[4];
    const float* mem_norm_g = (const float*)d_in[5];
    const float* w_in = (const float*)d_in[6];
    const float* a_q_norm_g = (const float*)d_in[7];
    const float* a_k_norm_g = (const float*)d_in[8];
    const float* b_q_lat_norm_g = (const float*)d_in[9];
    const float* b_kv_lat_norm_g = (const float*)d_in[10];
    const float* w_b_uq = (const float*)d_in[11];
    const float* w_b_ukv = (const float*)d_in[12];
    const float* b_q_norm_g = (const float*)d_in[13];
    const float* b_k_norm_g = (const float*)d_in[14];
    const float* w_mem_kv = (const float*)d_in[15];
    const float* c_q_norm_g = (const float*)d_in[16];
    const float* c_k_norm_g = (const float*)d_in[17];
    const float* w_branch = (const float*)d_in[18];
    const float* w_out = (const float*)d_in[19];
    char* ws = (char*)d_ws;
    char* dout = (char*)d_out;
    u16* H = (u16*)(ws + WS_H); u16* HM = (u16*)(ws + WS_HM);
    u16* AQ = (u16*)(ws + WS_AQ); u16* KVA = (u16*)(ws + WS_KVA); u16* SZA = (u16*)(ws + WS_SZA);
    u16* IQ = (u16*)(ws + WS_IQ); u16* IK = (u16*)(ws + WS_IK); float* IW = (float*)(ws + WS_IW); float* BKPE = (float*)(ws + WS_BKPE);
    u16* BCQ = (u16*)(ws + WS_BCQ); u16* BCKV = (u16*)(ws + WS_BCKV); u16* SZB = (u16*)(ws + WS_SZB);
    u16* CQ = (u16*)(ws + WS_CQ); u16* SZC = (u16*)(ws + WS_SZC); u16* G = (u16*)(ws + WS_G);
    u16* CK = (u16*)(ws + WS_CK); u16* CV = (u16*)(ws + WS_CV);
    int* SEL = (int*)(ws + WS_SEL); int* CNT = (int*)(ws + WS_CNT);
    float* COS = (float*)(ws + WS_COS); float* SIN = (float*)(ws + WS_SIN);
    u16* UA = (u16*)(ws + WS_UA); u16* UB = (u16*)(ws + WS_UB); u16* UC = (u16*)(ws + WS_UC);
    u16* MERGED = (u16*)(ws + WS_MERGED);
    u16* QB = (u16*)(dout + DO_QB); u16* KB = (u16*)(dout + DO_KB); u16* VB = (u16*)(dout + DO_VB);
    float* RAW = (float*)(ws + WS_TMP_RAW);
    float* MF = (float*)(ws + WS_TMP_MERGEDF);
    float* Y = (float*)d_out;

    static bool attr_done = false;
    if (!attr_done) {
        attr_done = true;
        (void)hipFuncSetAttribute((const void*)nk_attn<192, 128, 64, true>, hipFuncAttributeMaxDynamicSharedMemorySize, 120 * 1024);
        (void)hipFuncSetAttribute((const void*)nk_attn<256, 256, 32, false>, hipFuncAttributeMaxDynamicSharedMemorySize, 120 * 1024);
        (void)hipFuncSetAttribute((const void*)mega_kernel, hipFuncAttributeMaxDynamicSharedMemorySize, MEGA_LDS);
    }
    Params prm{};
    prm.x = x; prm.mem = mem; prm.positions = positions; prm.rel_bias = rel_bias; prm.norm_g = norm_g; prm.mem_norm_g = mem_norm_g;
    prm.w_in = w_in; prm.a_q_norm_g = a_q_norm_g; prm.a_k_norm_g = a_k_norm_g; prm.b_q_lat_norm_g = b_q_lat_norm_g; prm.b_kv_lat_norm_g = b_kv_lat_norm_g;
    prm.w_b_uq = w_b_uq; prm.w_b_ukv = w_b_ukv; prm.b_q_norm_g = b_q_norm_g; prm.b_k_norm_g = b_k_norm_g; prm.w_mem_kv = w_mem_kv;
    prm.c_q_norm_g = c_q_norm_g; prm.c_k_norm_g = c_k_norm_g; prm.w_branch = w_branch; prm.w_out = w_out;
    prm.ws = ws; prm.dout = dout;
#define GEMM(OutT, ACT, A_, lda_, B_, ldb_, C_, ldc_, M_, N_, K_, R_, ldr_) \
    nk_gemm<OutT, ACT><<<dim3(((N_) + 63) / 64, (M_) / 64), 256, 0, stream>>>(A_, lda_, B_, ldb_, C_, ldc_, M_, N_, K_, R_, ldr_)
    prm.phase_lo = 1; prm.phase_hi = 7;
    {
        void* args[] = {&prm};
        hipError_t e = hipLaunchCooperativeKernel((const void*)mega_kernel, dim3(256), dim3(512), args, MEGA_LDS, stream);
        if (e != hipSuccess) fprintf(stderr, "cooperative launch failed: %s\n", hipGetErrorString(e));
    }
#undef GEMM
}
```

```cpp
#include <hip/hip_runtime.h>
#include <hip/hip_bf16.h>
#include <hip/hip_cooperative_groups.h>
#include <stdint.h>
#include <stdio.h>

typedef unsigned short u16;

constexpr int SEQ = 8192, DM = 2048, INW = 13712, NMEM = 256;
constexpr int OFF_AQ = 0, OFF_AK = 1024, OFF_AV = 1280, OFF_AZ = 1536, OFF_IQ = 2560, OFF_IK = 3584, OFF_IW = 3648,
              OFF_BCQ = 3664, OFF_BCKV = 4176, OFF_BKPE = 4432, OFF_BZ = 4496, OFF_CQ = 5520, OFF_CZ = 6544, OFF_G = 7568;
constexpr float EPS = 1e-6f;
constexpr float A_SCALE = 0.08838834764831845f;
constexpr float B_SCALE = 0.07216878364870322f;
constexpr float C_SCALE = 0.0625f;
constexpr int TOPK = 256;

constexpr size_t MiB = 1024 * 1024;
constexpr size_t WS_H = 0;
constexpr size_t WS_WINT = 32 * MiB;
constexpr size_t WS_WUQT = 86 * MiB;
constexpr size_t WS_WUKVT = 88 * MiB;
constexpr size_t WS_WMEMT = 89 * MiB;
constexpr size_t WS_WBRT = 97 * MiB;
constexpr size_t WS_WOUTT = 109 * MiB;
constexpr size_t WS_AQ = 117 * MiB;
constexpr size_t WS_KVA = 133 * MiB;
constexpr size_t WS_SZA = 141 * MiB;
constexpr size_t WS_IQ = 157 * MiB;
constexpr size_t WS_IK = 173 * MiB;
constexpr size_t WS_IW = 174 * MiB;
constexpr size_t WS_BKPE = 175 * MiB;
constexpr size_t WS_BCQ = 177 * MiB;
constexpr size_t WS_BCKV = 185 * MiB;
constexpr size_t WS_SZB = 189 * MiB;
constexpr size_t WS_CQ = 205 * MiB;
constexpr size_t WS_SZC = 221 * MiB;
constexpr size_t WS_G = 237 * MiB;
constexpr size_t WS_CK = 333 * MiB;
constexpr size_t WS_CV = WS_CK + 512 * 1024;
constexpr size_t WS_SEL = 334 * MiB;
constexpr size_t WS_CNT = 342 * MiB;
constexpr size_t WS_COS = 343 * MiB;
constexpr size_t WS_SIN = 344 * MiB;
constexpr size_t WS_UA = 345 * MiB;
constexpr size_t WS_UB = 361 * MiB;
constexpr size_t WS_UC = 377 * MiB;
constexpr size_t WS_MERGED = 393 * MiB;
constexpr size_t WS_HM = 425 * MiB;
constexpr size_t WS_END = 426 * MiB;
constexpr size_t WS_TMP_RAW = 345 * MiB;
constexpr size_t WS_TMP_MERGEDF = 0;
constexpr size_t DO_QB = 0, DO_KB = 24 * MiB, DO_VB = 48 * MiB;

__device__ __forceinline__ float bf2f(u16 u) { return __uint_as_float(((unsigned)u) << 16); }
__device__ __forceinline__ u16 f2bf(float f) {
    unsigned u = __float_as_uint(f);
    u += 0x7FFFu + ((u >> 16) & 1u);
    return (u16)(u >> 16);
}
__device__ __forceinline__ float silu_f(float x) { return x / (1.f + __expf(-x)); }
__device__ __forceinline__ float sigmoid_f(float x) { return 1.f / (1.f + __expf(-x)); }
__device__ __forceinline__ int rope_phys(int j, int second) { return (j >> 4) * 32 + (j & 15) + second * 16; }

__device__ __forceinline__ float block_sum_256(float v, float* red) {
    for (int o = 32; o > 0; o >>= 1) v += __shfl_xor(v, o);
    __syncthreads();
    if ((threadIdx.x & 63) == 0) red[threadIdx.x >> 6] = v;
    __syncthreads();
    return red[0] + red[1] + red[2] + red[3];
}

__global__ void __launch_bounds__(256) nk_rmsnorm_rows(const float* __restrict__ x, const float* __restrict__ g, u16* __restrict__ out, int C) {
    __shared__ float red[4];
    const float* xr = x + (size_t)blockIdx.x * C;
    float ss = 0.f;
    for (int c = threadIdx.x; c < C; c += 256) { float v = xr[c]; ss += v * v; }
    ss = block_sum_256(ss, red);
    float rinv = rsqrtf(ss / (float)C + EPS);
    for (int c = threadIdx.x; c < C; c += 256) out[(size_t)blockIdx.x * C + c] = f2bf(xr[c] * rinv * g[c]);
}

__global__ void __launch_bounds__(256) nk_rope_tables(const int* __restrict__ pos, float* __restrict__ cs, float* __restrict__ sn) {
    int i = blockIdx.x * 256 + threadIdx.x;
    if (i >= SEQ * 32) return;
    int t = i >> 5, j = i & 31;
    float inv_freq = 1.0f / powf(10000.f, (float)(2 * j) / 64.f);
    float ang = (float)pos[t] * inv_freq;
    cs[i] = cosf(ang); sn[i] = sinf(ang);
}

template <typename OutT> __device__ __forceinline__ void store_out(OutT* p, float v);
template <> __device__ __forceinline__ void store_out<float>(float* p, float v) { *p = v; }
template <> __device__ __forceinline__ void store_out<u16>(u16* p, float v) { *p = f2bf(v); }

template <typename OutT, int ACT>
__global__ void __launch_bounds__(256) nk_gemm(const u16* __restrict__ A, int lda, const float* __restrict__ B, int ldb, OutT* __restrict__ C, int ldc,
                        int M, int N, int K, const float* __restrict__ R, int ldr) {
    __shared__ float As[16][65];
    __shared__ float Bs[16][65];
    const int tid = threadIdx.x, tx = tid & 15, ty = tid >> 4;
    const int m0 = blockIdx.y * 64, n0 = blockIdx.x * 64;
    float acc[4][4] = {};
    for (int k0 = 0; k0 < K; k0 += 16) {
        {
            int r = tid >> 2, kk = (tid & 3) * 4;
            const u16* ap = A + (size_t)(m0 + r) * lda + k0 + kk;
            for (int e = 0; e < 4; ++e) As[kk + e][r] = bf2f(ap[e]);
        }
        {
            int kk = tid >> 4, nn = (tid & 15) * 4;
            const float* bp = B + (size_t)(k0 + kk) * ldb + n0 + nn;
            for (int e = 0; e < 4; ++e) Bs[kk][nn + e] = (n0 + nn + e < N) ? bp[e] : 0.f;
        }
        __syncthreads();
#pragma unroll
        for (int k = 0; k < 16; ++k) {
            float a[4], b[4];
#pragma unroll
            for (int i = 0; i < 4; ++i) { a[i] = As[k][ty + 16 * i]; b[i] = Bs[k][tx + 16 * i]; }
#pragma unroll
            for (int i = 0; i < 4; ++i)
#pragma unroll
                for (int j = 0; j < 4; ++j) acc[i][j] = fmaf(a[i], b[j], acc[i][j]);
        }
        __syncthreads();
    }
    for (int i = 0; i < 4; ++i)
        for (int j = 0; j < 4; ++j) {
            int row = m0 + ty + 16 * i, col = n0 + tx + 16 * j;
            if (col < N) {
                float v = acc[i][j];
                if (ACT == 1) v = silu_f(v);
                if (ACT == 2) v = sigmoid_f(v);
                if (ACT == 3) v += R[(size_t)row * ldr + col];
                store_out<OutT>(C + (size_t)row * ldc + col, v);
            }
        }
}

__global__ void __launch_bounds__(256) nk_headnorm(u16* __restrict__ buf, long row_stride, long head_stride, int nheads, int HD,
                            const float* __restrict__ g, float scale, int nrows) {
    int wid = (blockIdx.x * 256 + threadIdx.x) >> 6, lane = threadIdx.x & 63;
    if (wid >= nrows * nheads) return;
    int row = wid / nheads, h = wid % nheads;
    u16* p = buf + (size_t)row * row_stride + (size_t)h * head_stride;
    float ss = 0.f;
    for (int i = lane; i < HD; i += 64) { float v = bf2f(p[i]); ss += v * v; }
    for (int o = 32; o > 0; o >>= 1) ss += __shfl_xor(ss, o);
    float rinv = rsqrtf(ss / (float)HD + EPS) * scale;
    for (int i = lane; i < HD; i += 64) p[i] = f2bf(bf2f(p[i]) * rinv * g[i]);
}

__global__ void __launch_bounds__(256) nk_rownorm_bf16(u16* __restrict__ buf, int C, const float* __restrict__ g, int nrows) {
    int wid = (blockIdx.x * 256 + threadIdx.x) >> 6, lane = threadIdx.x & 63;
    if (wid >= nrows) return;
    u16* p = buf + (size_t)wid * C;
    float ss = 0.f;
    for (int i = lane; i < C; i += 64) { float v = bf2f(p[i]); ss += v * v; }
    for (int o = 32; o > 0; o >>= 1) ss += __shfl_xor(ss, o);
    float rinv = rsqrtf(ss / (float)C + EPS);
    for (int i = lane; i < C; i += 64) p[i] = f2bf(bf2f(p[i]) * rinv * g[i]);
}

__global__ void __launch_bounds__(256) nk_mla_q_finish(const float* __restrict__ qraw, const float* __restrict__ g, const float* __restrict__ cs,
                                const float* __restrict__ sn, u16* __restrict__ QB) {
    int wid = (blockIdx.x * 256 + threadIdx.x) >> 6, lane = threadIdx.x & 63;
    if (wid >= SEQ * 8) return;
    int t = wid >> 3, h = wid & 7;
    const float* p = qraw + (size_t)t * 1536 + h * 192;
    float v0 = p[lane], v1 = p[64 + lane], v2 = p[128 + lane];
    float ss = v0 * v0 + v1 * v1 + v2 * v2;
    for (int o = 32; o > 0; o >>= 1) ss += __shfl_xor(ss, o);
    float rinv = rsqrtf(ss / 192.f + EPS);
    v0 *= rinv * g[lane]; v1 *= rinv * g[64 + lane]; v2 *= rinv * g[128 + lane];
    float other = __shfl_xor(v2, 32);
    int j = lane & 31;
    float c = cs[t * 32 + j], s = sn[t * 32 + j];
    float r = (lane < 32) ? (v2 * c - other * s) : (v2 * c + other * s);
    u16* o = QB + ((size_t)h * SEQ + t) * 192;
    o[lane] = f2bf(v0 * B_SCALE); o[64 + lane] = f2bf(v1 * B_SCALE);
    o[128 + rope_phys(j, lane >> 5)] = f2bf(r * B_SCALE);
}
__global__ void __launch_bounds__(256) nk_mla_kv_finish(const float* __restrict__ kvraw, const float* __restrict__ bkpe, const float* __restrict__ g,
                                 const float* __restrict__ cs, const float* __restrict__ sn, u16* __restrict__ KB, u16* __restrict__ VB) {
    int wid = (blockIdx.x * 256 + threadIdx.x) >> 6, lane = threadIdx.x & 63;
    if (wid >= SEQ * 8) return;
    int t = wid >> 3, h = wid & 7;
    const float* p = kvraw + (size_t)t * 2048 + h * 256;
    float v0 = p[lane], v1 = p[64 + lane], v2 = bkpe[(size_t)t * 64 + lane];
    float ss = v0 * v0 + v1 * v1 + v2 * v2;
    for (int o = 32; o > 0; o >>= 1) ss += __shfl_xor(ss, o);
    float rinv = rsqrtf(ss / 192.f + EPS);
    v0 *= rinv * g[lane]; v1 *= rinv * g[64 + lane]; v2 *= rinv * g[128 + lane];
    float other = __shfl_xor(v2, 32);
    int j = lane & 31;
    float c = cs[t * 32 + j], s = sn[t * 32 + j];
    float r = (lane < 32) ? (v2 * c - other * s) : (v2 * c + other * s);
    u16* o = KB + ((size_t)h * SEQ + t) * 192;
    o[lane] = f2bf(v0); o[64 + lane] = f2bf(v1);
    o[128 + rope_phys(j, lane >> 5)] = f2bf(r);
    u16* vo = VB + ((size_t)h * SEQ + t) * 128;
    vo[lane] = f2bf(p[128 + lane]); vo[64 + lane] = f2bf(p[192 + lane]);
}

template <int DQK, int DV, int KT, bool CAUSAL>
__global__ void __launch_bounds__(256) nk_attn(const u16* __restrict__ Q, long q_rs, long q_hs, const u16* __restrict__ K, long k_rs, long k_hs,
                        const u16* __restrict__ V, long v_rs, long v_hs, int Skv, const u16* __restrict__ SZ, u16* __restrict__ U) {
    extern __shared__ float sm[];
    float* Qs = sm;
    float* Ks = Qs + 32 * (DQK + 1);
    float* Vs = Ks + KT * (DQK + 1);
    float* Ss = Vs + KT * DV;
    float* mrow = Ss + 32 * (KT + 1);
    float* lrow = mrow + 32;
    float* arow = lrow + 32;
    const int tid = threadIdx.x, q0 = blockIdx.x * 32, h = blockIdx.y;
    for (int e = tid; e < 32 * DQK; e += 256) { int r = e / DQK, d = e % DQK; Qs[r * (DQK + 1) + d] = bf2f(Q[(size_t)(q0 + r) * q_rs + (size_t)h * q_hs + d]); }
    if (tid < 32) { mrow[tid] = -1e30f; lrow[tid] = 0.f; }
    constexpr int NO = DV / 8;
    float o[NO];
#pragma unroll
    for (int j = 0; j < NO; ++j) o[j] = 0.f;
    const int qi = tid >> 3, sub = tid & 7;
    const int kend = CAUSAL ? (q0 + 32) : Skv;
    for (int k0 = 0; k0 < kend; k0 += KT) {
        __syncthreads();
        for (int e = tid; e < KT * DQK; e += 256) { int r = e / DQK, d = e % DQK; int key = k0 + r;
            Ks[r * (DQK + 1) + d] = (key < Skv) ? bf2f(K[(size_t)key * k_rs + (size_t)h * k_hs + d]) : 0.f; }
        for (int e = tid; e < KT * DV; e += 256) { int r = e / DV, d = e % DV; int key = k0 + r;
            Vs[r * DV + d] = (key < Skv) ? bf2f(V[(size_t)key * v_rs + (size_t)h * v_hs + d]) : 0.f; }
        __syncthreads();
        {
            constexpr int NP = KT / 8;
            float s[NP];
#pragma unroll
            for (int j = 0; j < NP; ++j) s[j] = 0.f;
            for (int d = 0; d < DQK; ++d) { float qv = Qs[qi * (DQK + 1) + d];
#pragma unroll
                for (int j = 0; j < NP; ++j) s[j] = fmaf(qv, Ks[(sub + 8 * j) * (DQK + 1) + d], s[j]); }
#pragma unroll
            for (int j = 0; j < NP; ++j) { int key = k0 + sub + 8 * j;
                bool ok = key < Skv && (!CAUSAL || key <= q0 + qi);
                Ss[qi * (KT + 1) + sub + 8 * j] = ok ? s[j] : -INFINITY; }
        }
        __syncthreads();
        if (tid < 32) {
            float m = mrow[tid], mx = m;
            for (int k = 0; k < KT; ++k) mx = fmaxf(mx, Ss[tid * (KT + 1) + k]);
            float alpha = __expf(m - mx), sum = 0.f;
            for (int k = 0; k < KT; ++k) { float p = __expf(Ss[tid * (KT + 1) + k] - mx); Ss[tid * (KT + 1) + k] = p; sum += p; }
            mrow[tid] = mx; lrow[tid] = lrow[tid] * alpha + sum; arow[tid] = alpha;
        }
        __syncthreads();
        {
            float alpha = arow[qi];
#pragma unroll
            for (int j = 0; j < NO; ++j) o[j] *= alpha;
            for (int k = 0; k < KT; ++k) { float p = Ss[qi * (KT + 1) + k];
#pragma unroll
                for (int j = 0; j < NO; ++j) o[j] = fmaf(p, Vs[k * DV + sub + 8 * j], o[j]); }
        }
    }
    __syncthreads();
    float linv = 1.f / lrow[qi];
#pragma unroll
    for (int j = 0; j < NO; ++j) { int d = sub + 8 * j; size_t idx = (size_t)(q0 + qi) * 1024 + h * DV + d;
        U[idx] = f2bf(o[j] * linv * bf2f(SZ[idx])); }
}

__device__ __forceinline__ unsigned ord_key(float f) { unsigned u = __float_as_uint(f); return (u & 0x80000000u) ? ~u : (u | 0x80000000u); }
__global__ void __launch_bounds__(256) nk_indexer_topk(const u16* __restrict__ IQ, const u16* __restrict__ IK, const float* __restrict__ IW,
                                int* __restrict__ SEL, int* __restrict__ CNT) {
    __shared__ unsigned keys[SEQ];
    __shared__ float qs[16 * 64];
    __shared__ float ws[16];
    __shared__ int cnt_sh;
    __shared__ int wsum[8];
    const int t = blockIdx.x, tid = threadIdx.x, n = t + 1;
    int* sel = SEL + (size_t)t * TOPK;
    if (n <= TOPK) { for (int i = tid; i < n; i += 256) sel[i] = i; if (tid == 0) CNT[t] = n; return; }
    for (int e = tid; e < 1024; e += 256) qs[e] = bf2f(IQ[(size_t)t * 1024 + e]);
    if (tid < 16) ws[tid] = IW[(size_t)t * 16 + tid];
    __syncthreads();
    for (int s = tid; s < n; s += 256) {
        float kv[64];
        const u16* kp = IK + (size_t)s * 64;
#pragma unroll
        for (int d = 0; d < 64; ++d) kv[d] = bf2f(kp[d]);
        float sc = 0.f;
        for (int h = 0; h < 16; ++h) { float dot = 0.f;
#pragma unroll
            for (int d = 0; d < 64; ++d) dot = fmaf(qs[h * 64 + d], kv[d], dot);
            sc = fmaf(ws[h], fmaxf(dot, 0.f), sc); }
        keys[s] = ord_key(sc);
    }
    __syncthreads();
    unsigned prefix = 0; int need = TOPK;
    for (int bit = 31; bit >= 0; --bit) {
        if (tid == 0) cnt_sh = 0;
        __syncthreads();
        unsigned want = (prefix >> bit) | 1u;
        int c = 0;
        for (int s = tid; s < n; s += 256) c += ((keys[s] >> bit) == want) ? 1 : 0;
        for (int o = 32; o > 0; o >>= 1) c += __shfl_xor(c, o);
        if ((tid & 63) == 0) atomicAdd(&cnt_sh, c);
        __syncthreads();
        int tot = cnt_sh;
        if (tot >= need) prefix |= (1u << bit); else need -= tot;
        __syncthreads();
    }
    int base_sel = 0, base_eq = 0;
    for (int c0 = 0; c0 < n; c0 += 256) {
        int s = c0 + tid; bool in = s < n;
        unsigned kk = in ? keys[s] : 0u;
        bool gt = in && kk > prefix, eq = in && kk == prefix;
        unsigned long long beq = __ballot(eq);
        int w = tid >> 6, lane = tid & 63;
        if (lane == 0) wsum[w] = __popcll(beq);
        __syncthreads();
        int eqpre = base_eq + __popcll(beq & ((1ull << lane) - 1ull));
        for (int i = 0; i < w; ++i) eqpre += wsum[i];
        int eqtot = wsum[0] + wsum[1] + wsum[2] + wsum[3];
        bool selv = gt || (eq && eqpre < need);
        unsigned long long bs = __ballot(selv);
        if (lane == 0) wsum[4 + w] = __popcll(bs);
        __syncthreads();
        int pos = base_sel + __popcll(bs & ((1ull << lane) - 1ull));
        for (int i = 0; i < w; ++i) pos += wsum[4 + i];
        if (selv && pos < TOPK) sel[pos] = s;
        base_sel += wsum[4] + wsum[5] + wsum[6] + wsum[7];
        base_eq += eqtot;
        __syncthreads();
    }
    if (tid == 0) CNT[t] = TOPK;
}

__device__ __forceinline__ int t5_bucket(int dist) {
    int nn = dist > 0 ? dist : 0;
    if (nn < 16) return nn;
    float nf = (float)nn;
    int large = 16 + (int)(logf(nf / 16.f) / 2.0794415416798357f * 16.f);
    return large < 31 ? large : 31;
}
__global__ void __launch_bounds__(256) nk_sparse_attn(const u16* __restrict__ AQ, const u16* __restrict__ KVA, const int* __restrict__ SEL, const int* __restrict__ CNT,
                               const int* __restrict__ pos, const float* __restrict__ relb, const u16* __restrict__ SZA, u16* __restrict__ UA) {
    __shared__ float qs[1024];
    __shared__ int sl[TOPK];
    __shared__ int bk[TOPK];
    __shared__ float pr[TOPK];
    __shared__ float red[4];
    const int t = blockIdx.x, tid = threadIdx.x;
    const int cnt = CNT[t];
    for (int e = tid; e < 1024; e += 256) qs[e] = bf2f(AQ[(size_t)t * 1024 + e]);
    if (tid < cnt) { int s = SEL[(size_t)t * TOPK + tid]; sl[tid] = s; bk[tid] = t5_bucket(pos[t] - pos[s]); }
    __syncthreads();
    for (int h = 0; h < 8; ++h) {
        const int g = h >> 2;
        float logit = -INFINITY;
        if (tid < cnt) {
            const u16* kp = KVA + ((size_t)sl[tid] * 2 + g) * 256;
            float dot = 0.f;
            for (int d = 0; d < 128; ++d) dot = fmaf(qs[h * 128 + d], bf2f(kp[d]), dot);
            logit = dot + relb[bk[tid] * 8 + h];
        }
        float mx = logit;
        for (int o = 32; o > 0; o >>= 1) mx = fmaxf(mx, __shfl_xor(mx, o));
        __syncthreads();
        if ((tid & 63) == 0) red[tid >> 6] = mx;
        __syncthreads();
        mx = fmaxf(fmaxf(red[0], red[1]), fmaxf(red[2], red[3]));
        float p = (tid < cnt) ? __expf(logit - mx) : 0.f;
        pr[tid] = p;
        float sum = block_sum_256(p, red);
        __syncthreads();
        if (tid < 128) {
            float acc = 0.f;
            for (int k = 0; k < cnt; ++k) acc = fmaf(pr[k], bf2f(KVA[((size_t)sl[k] * 2 + g) * 256 + 128 + tid]), acc);
            size_t idx = (size_t)t * 1024 + h * 128 + tid;
            UA[idx] = f2bf(acc / sum * bf2f(SZA[idx]));
        }
        __syncthreads();
    }
}

__global__ void __launch_bounds__(256) nk_merge(const float* __restrict__ Y, const u16* __restrict__ G, int n, float* __restrict__ MF, u16* __restrict__ MERGED) {
    size_t i = (size_t)blockIdx.x * 256 + threadIdx.x;
    if (i >= (size_t)SEQ * DM) return;
    size_t t = i / DM, d = i % DM;
    float v = bf2f(G[t * 6144 + (size_t)n * DM + d]) * Y[i];
    if (n > 0) v += MF[i];
    MF[i] = v;
    if (n == 2) MERGED[i] = f2bf(v);
}


typedef short bf16x8 __attribute__((ext_vector_type(8)));
typedef float f32x4 __attribute__((ext_vector_type(4)));
typedef float f32x16 __attribute__((ext_vector_type(16)));
typedef unsigned u32x4 __attribute__((ext_vector_type(4)));
typedef unsigned u32x2 __attribute__((ext_vector_type(2)));

constexpr size_t WS_LATQ = WS_CNT + 64 * 1024;
constexpr size_t WS_LATKV = WS_CNT + 128 * 1024;
constexpr size_t WS_PESS = WS_CNT + 192 * 1024;
constexpr size_t WS_BKT = WS_CNT + 224 * 1024;
constexpr int NT_IN = 54;
constexpr int WINT_ROWS = NT_IN * 256;

struct Params {
    const float* x; const float* mem; const int* positions; const float* rel_bias; const float* norm_g; const float* mem_norm_g;
    const float* w_in; const float* a_q_norm_g; const float* a_k_norm_g; const float* b_q_lat_norm_g; const float* b_kv_lat_norm_g;
    const float* w_b_uq; const float* w_b_ukv; const float* b_q_norm_g; const float* b_k_norm_g; const float* w_mem_kv;
    const float* c_q_norm_g; const float* c_k_norm_g; const float* w_branch; const float* w_out;
    char* ws; char* dout;
    int phase_lo, phase_hi;
};

__device__ __forceinline__ int opaque_tid() { int t = threadIdx.x; asm volatile("" : "+v"(t)); return t; }
__device__ __forceinline__ unsigned cvtpk(float lo, float hi) {
    unsigned r; asm volatile("v_cvt_pk_bf16_f32 %0, %1, %2" : "=v"(r) : "v"(lo), "v"(hi)); return r;
}

__device__ __forceinline__ int win_srccol(int n) {
    if (n < 3584) return n;
    if (n < 3840) { int j = n - 3584; if (j < 80) return 3584 + j; if (j < 144) return 4432 + (j - 80); return -1; }
    if (n < 4352) return 3664 + (n - 3840);
    if (n < 4608) return 4176 + (n - 4352);
    return 4496 + (n - 4608);
}
__device__ __forceinline__ int wuq_srccol(int n) {
    int h = n >> 8, j = n & 255;
    if (j < 128) return h * 192 + j;
    if (j < 192) { int p = j - 128, blk = p >> 5, within = p & 31, second = within >> 4, jj = blk * 16 + (within & 15);
        return h * 192 + 128 + second * 32 + jj; }
    return -1;
}
__device__ void phase_prep(const Params& p) {
    extern __shared__ __attribute__((aligned(16))) char smem[];
    int tid = opaque_tid(); int wid = tid >> 6, lane = tid & 63;
    for (int r = blockIdx.x * 8 + wid; r < SEQ + NMEM; r += gridDim.x * 8) {
        const float* src; const float* g; u16* dst;
        if (r < SEQ) { src = p.x + (size_t)r * DM; g = p.norm_g; dst = (u16*)(p.ws + WS_H) + (size_t)r * DM; }
        else { src = p.mem + (size_t)(r - SEQ) * DM; g = p.mem_norm_g; dst = (u16*)(p.ws + WS_HM) + (size_t)(r - SEQ) * DM; }
        f32x4 v[8]; float ss = 0.f;
#pragma unroll
        for (int i = 0; i < 8; ++i) { v[i] = ((const f32x4*)src)[lane + 64 * i]; ss += v[i][0] * v[i][0] + v[i][1] * v[i][1] + v[i][2] * v[i][2] + v[i][3] * v[i][3]; }
        for (int o = 32; o > 0; o >>= 1) ss += __shfl_xor(ss, o);
        const float rinv = rsqrtf(ss / (float)DM + EPS);
#pragma unroll
        for (int i = 0; i < 8; ++i) { f32x4 gg = ((const f32x4*)g)[lane + 64 * i];
            u32x2 w = {cvtpk(v[i][0] * rinv * gg[0], v[i][1] * rinv * gg[1]), cvtpk(v[i][2] * rinv * gg[2], v[i][3] * rinv * gg[3])};
            *(u32x2*)(dst + 4 * (lane + 64 * i)) = w; }
    }
    {
        tid = opaque_tid();
        if (blockIdx.x == 0 && tid < 128) ((unsigned char*)(p.ws + WS_BKT))[tid] = (unsigned char)t5_bucket(tid);
        float* cs = (float*)(p.ws + WS_COS); float* sn = (float*)(p.ws + WS_SIN);
        for (int i = blockIdx.x * 512 + tid; i < SEQ * 32; i += gridDim.x * 512) {
            int t = i >> 5, j = i & 31;
            float inv_freq = 1.0f / powf(10000.f, (float)(2 * j) / 64.f);
            float ang = (float)p.positions[t] * inv_freq;
            cs[i] = cosf(ang); sn[i] = sinf(ang);
        }
    }
    constexpr int T0 = 32 * 216, T1 = T0 + 8 * 32, T2 = T1 + 4 * 32, T3 = T2 + 32 * 32, T4 = T3 + 3 * 16 * 32, T5 = T4 + 32 * 32;
    tid = opaque_tid(); wid = __builtin_amdgcn_readfirstlane(tid >> 6); lane = tid & 63;
    for (int T = blockIdx.x * 8 + wid; T < T5; T += gridDim.x * 8) {
        const float* W; int ldw, K, kt, mode = 0; const float* gs = nullptr; u16* dst;
        int tt;
        if (T < T0) { tt = T; W = p.w_in; ldw = INW; K = 2048; kt = 32; mode = 1; dst = (u16*)(p.ws + WS_WINT); }
        else if (T < T1) { tt = T - T0; W = p.w_b_uq; ldw = 1536; K = 512; kt = 8; mode = 2; gs = p.b_q_lat_norm_g; dst = (u16*)(p.ws + WS_WUQT); }
        else if (T < T2) { tt = T - T1; W = p.w_b_ukv; ldw = 2048; K = 256; kt = 4; gs = p.b_kv_lat_norm_g; dst = (u16*)(p.ws + WS_WUKVT); }
        else if (T < T3) { tt = T - T2; W = p.w_mem_kv; ldw = 2048; K = 2048; kt = 32; dst = (u16*)(p.ws + WS_WMEMT); }
        else if (T < T4) { tt = T - T3; int n = tt / 512; tt -= n * 512; W = p.w_branch + (size_t)n * 1024 * DM; ldw = DM; K = 1024; kt = 16;
                           dst = (u16*)(p.ws + WS_WBRT) + (size_t)n * DM * 1024; }
        else { tt = T - T4; W = p.w_out; ldw = DM; K = 2048; kt = 32; dst = (u16*)(p.ws + WS_WOUTT); }
        const int k0 = (tt % kt) * 64, n0 = (tt / kt) * 64, n = n0 + lane;
        int sc = n; if (mode == 1) sc = win_srccol(n); else if (mode == 2) sc = wuq_srccol(n);
        const float* src_p = W + (size_t)k0 * ldw + (sc >= 0 ? sc : 0);
        float v[64];
#pragma unroll
        for (int k = 0; k < 64; ++k) v[k] = src_p[(size_t)k * ldw];
        if (sc < 0) {
#pragma unroll
            for (int k = 0; k < 64; ++k) v[k] = 0.f;
        }
        if (gs) {
#pragma unroll
            for (int k = 0; k < 64; ++k) v[k] *= gs[k0 + k];
        }
        u16* dp = dst + (size_t)n * K + k0;
#pragma unroll
        for (int k8 = 0; k8 < 8; ++k8) { u32x4 w4 = {cvtpk(v[8 * k8 + 0], v[8 * k8 + 1]), cvtpk(v[8 * k8 + 2], v[8 * k8 + 3]), cvtpk(v[8 * k8 + 4], v[8 * k8 + 5]), cvtpk(v[8 * k8 + 6], v[8 * k8 + 7])};
            *(u32x4*)(dp + 8 * k8) = w4; }
    }
}

constexpr int G_HT = 128 * 64;
__device__ __forceinline__ int g_lds_byte(int r, int c) { int st = (r >> 4) * 2 + (c >> 5), rr = r & 15, cc = c & 31, ob = rr * 64 + cc * 2; return st * 1024 + (ob ^ (((ob >> 9) & 1) << 5)); }
__device__ __forceinline__ void g_stage_rc(int b, int& R, int& C) { int st = b / 1024, sb = b % 1024, swz = sb ^ (((sb >> 9) & 1) << 5); R = (st >> 1) * 16 + swz / 64; C = (st & 1) * 32 + (swz % 64) / 2; }

__device__ __forceinline__ void gemm_kloop(const u16* __restrict__ A, const u16* __restrict__ Bt, const int K, const int brow, const int bcol,
                                           f32x4 (&acc)[2][2][4][2]) {
    extern __shared__ __attribute__((aligned(16))) char smem[];
    u16* shm = (u16*)smem;
#define SA(b, h) (shm + ((b) * 2 + (h)) * G_HT)
#define SB(b, h) (shm + (4 + (b) * 2 + (h)) * G_HT)
#define STAGE(P, RS, br, kt) do { const int _so = ((br) * K + (kt) * 64) * 2; \
    __builtin_amdgcn_raw_ptr_buffer_load_lds(RS, (__attribute__((address_space(3))) void*)((char*)(P) + tid_ * 16), 16, voff0, _so, 0, 0); \
    __builtin_amdgcn_raw_ptr_buffer_load_lds(RS, (__attribute__((address_space(3))) void*)((char*)(P) + tid_ * 16 + 8192), 16, voff1, _so, 0, 0); } while (0)
#define LDA(dst, b, h) for (int m = 0; m < 4; ++m) for (int k = 0; k < 2; ++k) \
    dst[m][k] = *reinterpret_cast<const bf16x8*>((char*)SA(b, h) + g_lds_byte(wr * 64 + m * 16 + fr, k * 32 + fq * 8))
#define LDB(dst, b, h) for (int n = 0; n < 2; ++n) for (int k = 0; k < 2; ++k) \
    dst[n][k] = *reinterpret_cast<const bf16x8*>((char*)SB(b, h) + g_lds_byte(wc * 32 + n * 16 + fr, k * 32 + fq * 8))
#define MMA(ai, bj, At_, Bt_) do { __builtin_amdgcn_s_setprio(1); \
    for (int m = 0; m < 4; ++m) for (int n = 0; n < 2; ++n) for (int k = 0; k < 2; ++k) \
      acc[ai][bj][m][n] = __builtin_amdgcn_mfma_f32_16x16x32_bf16(At_[m][k], Bt_[n][k], acc[ai][bj][m][n], 0, 0, 0); \
    __builtin_amdgcn_s_setprio(0); } while (0)
#define WAIT_V(n) asm volatile("s_waitcnt vmcnt(" #n ")" ::: "memory")
#define WAIT_L(n) asm volatile("s_waitcnt lgkmcnt(" #n ")" ::: "memory")
#define BAR __builtin_amdgcn_s_barrier()
#define SCHED __builtin_amdgcn_sched_barrier(0)
    const int tid_ = opaque_tid();
    const int wid = tid_ >> 6, lane = tid_ & 63, wr = wid >> 2, wc = wid & 3, fr = lane & 15, fq = lane >> 4;
#pragma unroll
    for (int a = 0; a < 2; ++a)
#pragma unroll
        for (int b = 0; b < 2; ++b)
#pragma unroll
            for (int m = 0; m < 4; ++m)
#pragma unroll
                for (int n = 0; n < 2; ++n) acc[a][b][m][n] = f32x4{0.f, 0.f, 0.f, 0.f};
    bf16x8 At[4][2], B0[2][2], B1[2][2];
    const int nt = K / 64;
    const __amdgpu_buffer_rsrc_t rsA = __builtin_amdgcn_make_buffer_rsrc((void*)A, (short)0, 0x7fffffff, 0x00020000);
    const __amdgpu_buffer_rsrc_t rsB = __builtin_amdgcn_make_buffer_rsrc((void*)Bt, (short)0, 0x7fffffff, 0x00020000);
    int voff0, voff1;
    { int _r, _c; g_stage_rc(tid_ * 16, _r, _c); voff0 = (_r * K + _c) * 2; g_stage_rc(tid_ * 16 + 8192, _r, _c); voff1 = (_r * K + _c) * 2; }
    STAGE(SB(0, 0), rsB, bcol, 0); STAGE(SA(0, 0), rsA, brow, 0);
    STAGE(SB(0, 1), rsB, bcol + 128, 0); STAGE(SA(0, 1), rsA, brow + 128, 0);
    if (wr == 1) BAR;
    WAIT_V(4); BAR;
    STAGE(SB(1, 0), rsB, bcol, 1); STAGE(SA(1, 0), rsA, brow, 1); STAGE(SB(1, 1), rsB, bcol + 128, 1);
    WAIT_V(6); BAR;
    for (int t = 0; t < nt - 2; t += 2) {
        LDB(B0, 0, 0); SCHED; LDA(At, 0, 0); STAGE(SA(1, 1), rsA, brow + 128, t + 1);
        WAIT_L(8); BAR; WAIT_L(0); MMA(0, 0, At, B0); BAR; SCHED;
        LDB(B1, 0, 1); STAGE(SB(0, 0), rsB, bcol, t + 2);
        BAR; WAIT_L(0); MMA(0, 1, At, B1); BAR;
        LDA(At, 0, 1); STAGE(SA(0, 0), rsA, brow, t + 2);
        BAR; WAIT_L(0); MMA(1, 0, At, B0); BAR; SCHED;
        STAGE(SB(0, 1), rsB, bcol + 128, t + 2);
        WAIT_V(6); BAR; MMA(1, 1, At, B1); BAR;
        LDB(B0, 1, 0); SCHED; LDA(At, 1, 0); STAGE(SA(0, 1), rsA, brow + 128, t + 2);
        WAIT_L(8); BAR; WAIT_L(0); MMA(0, 0, At, B0); BAR; SCHED;
        LDB(B1, 1, 1); STAGE(SB(1, 0), rsB, bcol, t + 3);
        BAR; WAIT_L(0); MMA(0, 1, At, B1); BAR;
        LDA(At, 1, 1); STAGE(SA(1, 0), rsA, brow, t + 3);
        BAR; WAIT_L(0); MMA(1, 0, At, B0); BAR; SCHED;
        STAGE(SB(1, 1), rsB, bcol + 128, t + 3);
        WAIT_V(6); BAR; MMA(1, 1, At, B1); BAR;
    }
    { LDB(B0, 0, 0); LDA(At, 0, 0); STAGE(SA(1, 1), rsA, brow + 128, nt - 1);
      BAR; WAIT_L(0); MMA(0, 0, At, B0); BAR;
      LDB(B1, 0, 1); BAR; WAIT_L(0); MMA(0, 1, At, B1); BAR;
      LDA(At, 0, 1); WAIT_V(4); BAR; WAIT_L(0); MMA(1, 0, At, B0); MMA(1, 1, At, B1); BAR; }
    { LDB(B0, 1, 0); LDA(At, 1, 0); WAIT_V(2); BAR; WAIT_L(0); MMA(0, 0, At, B0); BAR;
      LDB(B1, 1, 1); WAIT_V(0); BAR; WAIT_L(0); MMA(0, 1, At, B1); BAR;
      LDA(At, 1, 1); BAR; WAIT_L(0); MMA(1, 0, At, B0); MMA(1, 1, At, B1); BAR; }
    if (wr == 0) BAR;
#undef SA
#undef SB
#undef STAGE
#undef LDA
#undef LDB
#undef MMA
}

constexpr int EPT_LD = 260;
template <int AI>
__device__ __forceinline__ void acc_half_to_lds(const f32x4 (&acc)[2][2][4][2]) {
    extern __shared__ __attribute__((aligned(16))) char smem[];
    float* T = (float*)smem;
    const int tid_ = opaque_tid();
    const int wid = tid_ >> 6, lane = tid_ & 63, wr = wid >> 2, wc = wid & 3, fr = lane & 15, fq = lane >> 4;
    float* base = T + (wr * 64 + fq * 4) * EPT_LD + wc * 32 + fr;
#pragma unroll
    for (int bj = 0; bj < 2; ++bj)
#pragma unroll
        for (int m = 0; m < 4; ++m)
#pragma unroll
            for (int n = 0; n < 2; ++n)
#pragma unroll
                for (int j = 0; j < 4; ++j) base[(m * 16 + j) * EPT_LD + bj * 128 + n * 16] = acc[AI][bj][m][n][j];
}
__device__ __forceinline__ float wave_sum64(float v) { for (int o = 32; o > 0; o >>= 1) v += __shfl_xor(v, o); return v; }
__device__ __forceinline__ float wave_sum32(float v) { for (int o = 16; o > 0; o >>= 1) v += __shfl_xor(v, o); return v; }
__device__ __forceinline__ void store4_bf16(u16* p, float a, float b, float c, float d) { u32x2 w = {cvtpk(a, b), cvtpk(c, d)}; *(u32x2*)p = w; }

enum { EP_RAW = 0, EP_SILU = 1, EP_SIGMOID = 2, EP_NORM128 = 3, EP_NORM256 = 4, EP_RAW_SS = 5, EP_MISC = 6 };

__device__ __forceinline__ void epi_rows_inproj(const int mode, const int grow0, u16* __restrict__ dst, const int ld, const int half_skip,
                                                const float* __restrict__ g, const float scale, float* __restrict__ ssout, const int ss_stride, const Params& p) {
    extern __shared__ __attribute__((aligned(16))) char smem[];
    const float* T = (const float*)smem;
    const int tid_ = opaque_tid();
    const int wid = tid_ >> 6, lane = tid_ & 63;
    const int col = lane * 4;
    f32x4 gg = {1.f, 1.f, 1.f, 1.f};
    if (mode == EP_NORM128) gg = *(const f32x4*)(g + (col & 127));
    else if (mode == EP_NORM256) gg = *(const f32x4*)(g + col);
    for (int rr = 0; rr < 16; ++rr) {
        const int lr = wid * 16 + rr; const size_t row = (size_t)(grow0 + lr);
        f32x4 v = *(const f32x4*)(T + lr * EPT_LD + col);
        if (mode == EP_MISC) {
            u16* IK = (u16*)(p.ws + WS_IK); float* IW = (float*)(p.ws + WS_IW); float* BKPE = (float*)(p.ws + WS_BKPE); float* PESS = (float*)(p.ws + WS_PESS);
            const bool pe = (lane >= 20 && lane < 36);
            float ss = pe ? (v[0] * v[0] + v[1] * v[1] + v[2] * v[2] + v[3] * v[3]) : 0.f;
            ss = wave_sum64(ss);
            if (lane < 16) store4_bf16(IK + row * 64 + col, v[0], v[1], v[2], v[3]);
            else if (lane < 20) *(f32x4*)(IW + row * 16 + (col - 64)) = v;
            else if (lane < 36) *(f32x4*)(BKPE + row * 64 + (col - 80)) = v;
            if (lane == 0) PESS[row] = ss;
            continue;
        }
        if (mode == EP_SILU) { v[0] = silu_f(v[0]); v[1] = silu_f(v[1]); v[2] = silu_f(v[2]); v[3] = silu_f(v[3]); }
        else if (mode == EP_SIGMOID) { v[0] = sigmoid_f(v[0]); v[1] = sigmoid_f(v[1]); v[2] = sigmoid_f(v[2]); v[3] = sigmoid_f(v[3]); }
        else if (mode >= EP_NORM128) {
            float ss = v[0] * v[0] + v[1] * v[1] + v[2] * v[2] + v[3] * v[3];
            if (mode == EP_NORM128) { ss = wave_sum32(ss); const float rinv = rsqrtf(ss * (1.f / 128.f) + EPS) * scale; v[0] *= rinv * gg[0]; v[1] *= rinv * gg[1]; v[2] *= rinv * gg[2]; v[3] *= rinv * gg[3]; }
            else { ss = wave_sum64(ss);
                if (mode == EP_NORM256) { const float rinv = rsqrtf(ss * (1.f / 256.f) + EPS) * scale; v[0] *= rinv * gg[0]; v[1] *= rinv * gg[1]; v[2] *= rinv * gg[2]; v[3] *= rinv * gg[3]; }
                else if (lane == 0) ssout[row * ss_stride] = ss; }
        }
        store4_bf16(dst + row * ld + col + (lane >= 32 ? half_skip : 0), v[0], v[1], v[2], v[3]);
    }
}

__device__ void phase_inproj(const Params& p) {
    const int r = blockIdx.x, xcd = r & 7, slot = r >> 3, mi = slot >> 3, ni = slot & 7;
    f32x4 acc[2][2][4][2];
    for (int w = 0; w < 7; ++w) {
        const int pm = xcd * 4 + mi, pn = w * 8 + ni;
        const bool inproj = pn < NT_IN;
        if (!inproj && !(ni == 6 && pm < 8)) continue;
        {
            const u16* A_ = (const u16*)(p.ws + (inproj ? WS_H : WS_HM)); const u16* B_ = (const u16*)(p.ws + (inproj ? WS_WINT : WS_WMEMT));
            gemm_kloop(A_, B_, DM, inproj ? pm * 256 : 0, inproj ? pn * 256 : pm * 256, acc);
        }
        int mode; size_t dsto; int ld, half_skip = 0, brow; const float* g = nullptr; float scale = 1.f; size_t sso = 0; int ss_stride = 0;
        if (inproj) {
            brow = pm * 256;
            if (pn < 4) { mode = EP_NORM128; dsto = WS_AQ + pn * 512; ld = 1024; g = p.a_q_norm_g; scale = A_SCALE; }
            else if (pn == 4) { mode = EP_NORM128; dsto = WS_KVA; ld = 512; half_skip = 128; g = p.a_k_norm_g; }
            else if (pn == 5) { mode = EP_RAW; dsto = WS_KVA + 256; ld = 512; half_skip = 128; }
            else if (pn < 10) { mode = EP_SILU; dsto = WS_SZA + (pn - 6) * 512; ld = 1024; }
            else if (pn < 14) { mode = EP_RAW; dsto = WS_IQ + (pn - 10) * 512; ld = 1024; }
            else if (pn == 14) { mode = EP_MISC; dsto = 0; ld = 0; }
            else if (pn < 17) { mode = EP_RAW_SS; dsto = WS_BCQ + (pn - 15) * 512; ld = 512; sso = WS_LATQ + (pn - 15) * 4; ss_stride = 2; }
            else if (pn == 17) { mode = EP_RAW_SS; dsto = WS_BCKV; ld = 256; sso = WS_LATKV; ss_stride = 1; }
            else if (pn < 22) { mode = EP_SILU; dsto = WS_SZB + (pn - 18) * 512; ld = 1024; }
            else if (pn < 26) { mode = EP_NORM256; dsto = WS_CQ + (pn - 22) * 512; ld = 1024; g = p.c_q_norm_g; scale = C_SCALE; }
            else if (pn < 30) { mode = EP_SILU; dsto = WS_SZC + (pn - 26) * 512; ld = 1024; }
            else { mode = EP_SIGMOID; dsto = WS_G + (pn - 30) * 512; ld = 6144; }
        } else {
            brow = 0; ld = 1024;
            if (pm < 4) { mode = EP_NORM256; dsto = WS_CK + pm * 512; g = p.c_k_norm_g; }
            else { mode = EP_RAW; dsto = WS_CV + (pm - 4) * 512; }
        }
#pragma unroll 1
        for (int half = 0; half < 2; ++half) {
            __syncthreads();
            if (half == 0) acc_half_to_lds<0>(acc); else acc_half_to_lds<1>(acc);
            __syncthreads();
            epi_rows_inproj(mode, brow + half * 128, (u16*)(p.ws + dsto), ld, half_skip, g, scale, (float*)(p.ws + sso), ss_stride, p);
        }
        __syncthreads();
    }
}

__device__ __forceinline__ void epi_rows_mla_q(const int grow0, const int h, const Params& p) {
    extern __shared__ __attribute__((aligned(16))) char smem[];
    const float* T = (const float*)smem;
    const int tid_ = opaque_tid(); const int wid = tid_ >> 6, lane = tid_ & 63, col = lane * 4;
    const float* LATQ = (const float*)(p.ws + WS_LATQ); const float* COS = (const float*)(p.ws + WS_COS); const float* SIN = (const float*)(p.ws + WS_SIN);
    u16* QB = (u16*)(p.dout + DO_QB) + (size_t)h * SEQ * 192;
    const int pp = (col - 128) & 63, blk = pp >> 5, within = pp & 31, second = within >> 4, jj = blk * 16 + (within & 15);
    f32x4 gg = {0.f, 0.f, 0.f, 0.f};
    if (lane < 32) gg = *(const f32x4*)(p.b_q_norm_g + col);
    else if (lane < 48) gg = *(const f32x4*)(p.b_q_norm_g + 128 + second * 32 + jj);
    for (int rr = 0; rr < 16; ++rr) {
        const int lr = wid * 16 + rr; const size_t t = (size_t)(grow0 + lr);
        f32x4 v = *(const f32x4*)(T + lr * EPT_LD + col);
        const float rlat = rsqrtf((LATQ[t * 2] + LATQ[t * 2 + 1]) * (1.f / 512.f) + EPS);
        v[0] *= rlat; v[1] *= rlat; v[2] *= rlat; v[3] *= rlat;
        float ss = v[0] * v[0] + v[1] * v[1] + v[2] * v[2] + v[3] * v[3];
        ss = wave_sum64(ss);
        const float rinv = rsqrtf(ss * (1.f / 192.f) + EPS);
        v[0] *= rinv * gg[0]; v[1] *= rinv * gg[1]; v[2] *= rinv * gg[2]; v[3] *= rinv * gg[3];
        f32x4 o;
        o[0] = __shfl_xor(v[0], 4); o[1] = __shfl_xor(v[1], 4); o[2] = __shfl_xor(v[2], 4); o[3] = __shfl_xor(v[3], 4);
        if (lane >= 32 && lane < 48) {
            const f32x4 c = *(const f32x4*)(COS + t * 32 + jj), s = *(const f32x4*)(SIN + t * 32 + jj);
#pragma unroll
            for (int e = 0; e < 4; ++e) v[e] = second ? (v[e] * c[e] + o[e] * s[e]) : (v[e] * c[e] - o[e] * s[e]);
        }
        if (lane < 48) store4_bf16(QB + t * 192 + col, v[0] * B_SCALE, v[1] * B_SCALE, v[2] * B_SCALE, v[3] * B_SCALE);
    }
}
__device__ __forceinline__ void epi_rows_mla_kv(const int grow0, const int h, const Params& p) {
    extern __shared__ __attribute__((aligned(16))) char smem[];
    const float* T = (const float*)smem;
    const int tid_ = opaque_tid(); const int wid = tid_ >> 6, lane = tid_ & 63, col = lane * 4;
    const float* LATKV = (const float*)(p.ws + WS_LATKV); const float* PESS = (const float*)(p.ws + WS_PESS); const float* BKPE = (const float*)(p.ws + WS_BKPE);
    const float* COS = (const float*)(p.ws + WS_COS); const float* SIN = (const float*)(p.ws + WS_SIN);
    u16* KB = (u16*)(p.dout + DO_KB) + (size_t)h * SEQ * 192; u16* VB = (u16*)(p.dout + DO_VB) + (size_t)h * SEQ * 128;
    f32x4 gg = {1.f, 1.f, 1.f, 1.f};
    if (lane < 32) gg = *(const f32x4*)(p.b_k_norm_g + col);
    const int jj = (lane & 7) * 4;
    const f32x4 g1 = *(const f32x4*)(p.b_k_norm_g + 128 + jj), g2 = *(const f32x4*)(p.b_k_norm_g + 160 + jj);
    for (int rr = 0; rr < 16; ++rr) {
        const int lr = wid * 16 + rr; const size_t t = (size_t)(grow0 + lr);
        f32x4 v = *(const f32x4*)(T + lr * EPT_LD + col);
        const float rlat = rsqrtf(LATKV[t] * (1.f / 256.f) + EPS);
        v[0] *= rlat; v[1] *= rlat; v[2] *= rlat; v[3] *= rlat;
        float ss = v[0] * v[0] + v[1] * v[1] + v[2] * v[2] + v[3] * v[3];
        ss = wave_sum32(ss);
        const float rinv = rsqrtf((ss + PESS[t]) * (1.f / 192.f) + EPS);
        if (lane < 32) store4_bf16(KB + t * 192 + col, v[0] * rinv * gg[0], v[1] * rinv * gg[1], v[2] * rinv * gg[2], v[3] * rinv * gg[3]);
        else store4_bf16(VB + t * 128 + (col - 128), v[0], v[1], v[2], v[3]);
        if (lane < 8) {
            const f32x4 x1 = *(const f32x4*)(BKPE + t * 64 + jj), x2 = *(const f32x4*)(BKPE + t * 64 + 32 + jj);
            const f32x4 c = *(const f32x4*)(COS + t * 32 + jj), s = *(const f32x4*)(SIN + t * 32 + jj);
            float o1[4], o2[4];
#pragma unroll
            for (int e = 0; e < 4; ++e) { const float a = x1[e] * rinv * g1[e], b = x2[e] * rinv * g2[e]; o1[e] = a * c[e] - b * s[e]; o2[e] = b * c[e] + a * s[e]; }
            store4_bf16(KB + t * 192 + 128 + rope_phys(jj, 0), o1[0], o1[1], o1[2], o1[3]);
            store4_bf16(KB + t * 192 + 128 + rope_phys(jj, 1), o2[0], o2[1], o2[2], o2[3]);
        }
    }
}
__device__ void phase_mla_up(const Params& p) {
    const int r = blockIdx.x, xcd = r & 7, slot = r >> 3, pm = xcd * 4 + (slot >> 3), h = slot & 7;
    f32x4 acc[2][2][4][2];
#pragma unroll 1
    for (int which = 0; which < 2; ++which) {
        if (which == 0) gemm_kloop((const u16*)(p.ws + WS_BCQ), (const u16*)(p.ws + WS_WUQT), 512, pm * 256, h * 256, acc);
        else gemm_kloop((const u16*)(p.ws + WS_BCKV), (const u16*)(p.ws + WS_WUKVT), 256, pm * 256, h * 256, acc);
#pragma unroll 1
        for (int half = 0; half < 2; ++half) {
            __syncthreads();
            if (half == 0) acc_half_to_lds<0>(acc); else acc_half_to_lds<1>(acc);
            __syncthreads();
            if (which == 0) epi_rows_mla_q(pm * 256 + half * 128, h, p); else epi_rows_mla_kv(pm * 256 + half * 128, h, p);
        }
        __syncthreads();
    }
}

__device__ __forceinline__ void epi_rows_merge(const int grow0, const int pd, const int n, const Params& p) {
    extern __shared__ __attribute__((aligned(16))) char smem[];
    const float* T = (const float*)smem;
    const int tid_ = opaque_tid(); const int wid = tid_ >> 6, lane = tid_ & 63, col = lane * 4;
    const u16* G = (const u16*)(p.ws + WS_G); float* M = (float*)p.dout; u16* MERGED = (u16*)(p.ws + WS_MERGED);
    for (int rr = 0; rr < 16; ++rr) {
        const int lr = wid * 16 + rr; const size_t t = (size_t)(grow0 + lr);
        f32x4 v = *(const f32x4*)(T + lr * EPT_LD + col);
        const u32x2 gw = *(const u32x2*)(G + t * 6144 + n * 2048 + pd * 256 + col);
        const float g0 = __uint_as_float(gw[0] << 16), g1 = __uint_as_float(gw[0] & 0xffff0000u), g2 = __uint_as_float(gw[1] << 16), g3 = __uint_as_float(gw[1] & 0xffff0000u);
        v[0] *= g0; v[1] *= g1; v[2] *= g2; v[3] *= g3;
        float* mp = M + t * DM + pd * 256 + col;
        if (n > 0) { const f32x4 mv = *(const f32x4*)mp; v[0] += mv[0]; v[1] += mv[1]; v[2] += mv[2]; v[3] += mv[3]; }
        if (n < 2) *(f32x4*)mp = v;
        else store4_bf16(MERGED + t * DM + pd * 256 + col, v[0], v[1], v[2], v[3]);
    }
}
__device__ void phase_merge(const Params& p) {
    const int r = blockIdx.x, xcd = r & 7, slot = r >> 3, pm = xcd * 4 + (slot >> 3), pd = slot & 7;
    f32x4 acc[2][2][4][2];
#pragma unroll 1
    for (int n = 0; n < 3; ++n) {
        const u16* U = (const u16*)(p.ws + (n == 0 ? WS_UA : (n == 1 ? WS_UB : WS_UC)));
        gemm_kloop(U, (const u16*)(p.ws + WS_WBRT) + (size_t)n * DM * 1024, 1024, pm * 256, pd * 256, acc);
#pragma unroll 1
        for (int half = 0; half < 2; ++half) {
            __syncthreads();
            if (half == 0) acc_half_to_lds<0>(acc); else acc_half_to_lds<1>(acc);
            __syncthreads();
            epi_rows_merge(pm * 256 + half * 128, pd, n, p);
        }
        __syncthreads();
    }
}
__device__ __forceinline__ void epi_rows_out(const int grow0, const int pd, const Params& p) {
    extern __shared__ __attribute__((aligned(16))) char smem[];
    const float* T = (const float*)smem;
    const int tid_ = opaque_tid(); const int wid = tid_ >> 6, lane = tid_ & 63, col = lane * 4;
    float* OUT = (float*)p.dout;
    for (int rr = 0; rr < 16; ++rr) {
        const int lr = wid * 16 + rr; const size_t t = (size_t)(grow0 + lr);
        f32x4 v = *(const f32x4*)(T + lr * EPT_LD + col);
        const f32x4 xv = *(const f32x4*)(p.x + t * DM + pd * 256 + col);
        v[0] += xv[0]; v[1] += xv[1]; v[2] += xv[2]; v[3] += xv[3];
        *(f32x4*)(OUT + t * DM + pd * 256 + col) = v;
    }
}
__device__ void phase_out(const Params& p) {
    const int r = blockIdx.x, xcd = r & 7, slot = r >> 3, pm = xcd * 4 + (slot >> 3), pd = slot & 7;
    f32x4 acc[2][2][4][2];
    gemm_kloop((const u16*)(p.ws + WS_MERGED), (const u16*)(p.ws + WS_WOUTT), DM, pm * 256, pd * 256, acc);
#pragma unroll 1
    for (int half = 0; half < 2; ++half) {
        __syncthreads();
        if (half == 0) acc_half_to_lds<0>(acc); else acc_half_to_lds<1>(acc);
        __syncthreads();
        epi_rows_out(pm * 256 + half * 128, pd, p);
    }
    __syncthreads();
}

typedef short s16x4 __attribute__((ext_vector_type(4)));
constexpr float LOG2E = 1.4426950408889634f;
constexpr int MLA_KT = 12288, MLA_VT = 8192, MLA_GRP = MLA_KT + MLA_VT, MLA_BUF = 2 * MLA_GRP;
__device__ __forceinline__ int crow16(int r, int hi) { return (r & 3) + 8 * (r >> 2) + 4 * hi; }

__device__ void mla_qblock(const Params& p, const int h, const int qb) {
    extern __shared__ __attribute__((aligned(16))) char smem[];
    const int tid_ = opaque_tid();
    const int wid = __builtin_amdgcn_readfirstlane(tid_ >> 6), lane = tid_ & 63, r32 = lane & 31, hi = lane >> 5;
    const int grp = wid >> 2, wq = wid & 3;
    const int R0 = qb * 128, qrow = R0 + wq * 32 + r32;
    const int n_it = 2 * (qb + 1);
    const u16* QB = (const u16*)(p.dout + DO_QB) + ((size_t)h * SEQ + qrow) * 192;
    const __amdgpu_buffer_rsrc_t rs = __builtin_amdgcn_make_buffer_rsrc((void*)p.dout, (short)0, 0x7fffffff, 0x00020000);
    bf16x8 qr[12];
#pragma unroll
    for (int d0 = 0; d0 < 12; ++d0) qr[d0] = *(const bf16x8*)(QB + d0 * 16 + hi * 8);
    int voff[5];
#pragma unroll
    for (int i = 0; i < 5; ++i) {
        const int pc = wq * 5 + i;
        if (pc < 12) { const int o = pc * 1024 + lane * 16, row = o / 384, cpos = (o - row * 384) >> 4, f = (row >> 1) & 7;
            const int chunk = (cpos & ~7) | ((cpos & 7) ^ f); voff[i] = row * 384 + chunk * 16; }
        else { const int o = (pc - 12) * 1024 + lane * 16, sub = o >> 8, ksub = sub >> 2, csub = sub & 3, kq = (o & 255) >> 6, cc = (o & 63) >> 4;
            voff[i] = (ksub * 4 + kq) * 256 + (csub * 4 + cc) * 16; }
    }
    const int kbase = (int)DO_KB + h * SEQ * 384, vbase = (int)DO_VB + h * SEQ * 256;
#define MLA_DMA(it_) do { const int key0_ = (it_) * 64 + grp * 32; char* img_ = smem + ((it_) % 3) * MLA_BUF + grp * MLA_GRP; \
    _Pragma("unroll") for (int i = 0; i < 5; ++i) { const int pc = wq * 5 + i; \
        const int so_ = (pc < 12) ? (kbase + key0_ * 384) : (vbase + key0_ * 256); \
        __builtin_amdgcn_raw_ptr_buffer_load_lds(rs, (__attribute__((address_space(3))) void*)(img_ + pc * 1024 + lane * 16), 16, voff[i], so_, 0, 0); } } while (0)
    int kaddr[4];
    { const int f = (r32 >> 1) & 7;
#pragma unroll
      for (int a = 0; a < 4; ++a) kaddr[a] = r32 * 384 + 16 * ((2 * a + hi) ^ f); }
    const int vlane = hi * 1024 + ((lane & 15) >> 2) * 64 + ((lane >> 4) & 1) * 32 + (lane & 3) * 8;
    f32x16 o[4];
#pragma unroll
    for (int d = 0; d < 4; ++d)
#pragma unroll
        for (int r = 0; r < 16; ++r) o[d][r] = 0.f;
    float m_run = -1e30f, l_run = 0.f;
    asm volatile("s_waitcnt vmcnt(0)" : "+v"(qr[0]), "+v"(qr[1]), "+v"(qr[2]), "+v"(qr[3]), "+v"(qr[4]), "+v"(qr[5]) :: "memory");
    asm volatile("" : "+v"(qr[6]), "+v"(qr[7]), "+v"(qr[8]), "+v"(qr[9]), "+v"(qr[10]), "+v"(qr[11]));
    __builtin_amdgcn_s_barrier();
    MLA_DMA(0);
    if (n_it > 1) MLA_DMA(1);
    for (int it = 0; it < n_it; ++it) {
        if (it + 1 < n_it) asm volatile("s_waitcnt vmcnt(5)" ::: "memory"); else asm volatile("s_waitcnt vmcnt(0)" ::: "memory");
        __builtin_amdgcn_s_barrier();
        if (it + 2 < n_it) MLA_DMA(it + 2);
        const int key0 = it * 64 + grp * 32;
        if (key0 <= R0 + wq * 32 + 31) {
            const char* Kt = smem + (it % 3) * MLA_BUF + grp * MLA_GRP;
            const int vt = (int)(uintptr_t)(Kt + MLA_KT) + vlane;
            f32x16 pt;
#pragma unroll
            for (int r = 0; r < 16; ++r) pt[r] = 0.f;
#pragma unroll
            for (int d0 = 0; d0 < 12; ++d0) {
                const bf16x8 kf = *(const bf16x8*)(Kt + kaddr[d0 & 3] + (d0 >> 2) * 128);
                pt = __builtin_amdgcn_mfma_f32_32x32x16_bf16(kf, qr[d0], pt, 0, 0, 0);
            }
            if (key0 + 31 > R0 + wq * 32) {
#pragma unroll
                for (int r = 0; r < 16; ++r) if (key0 + crow16(r, hi) > qrow) pt[r] = -INFINITY;
            }
            float pmax = pt[0];
#pragma unroll
            for (int r = 1; r < 16; ++r) pmax = fmaxf(pmax, pt[r]);
            { auto rr = __builtin_amdgcn_permlane32_swap(__float_as_uint(pmax), __float_as_uint(pmax), false, false);
              pmax = fmaxf(__uint_as_float(rr[0]), __uint_as_float(rr[1])); }
            const float mn = fmaxf(m_run, pmax);
            const float alpha = __builtin_amdgcn_exp2f((m_run - mn) * LOG2E);
            const float mneg = -mn * LOG2E;
            m_run = mn;
            float ps = 0.f;
#pragma unroll
            for (int r = 0; r < 16; ++r) { pt[r] = __builtin_amdgcn_exp2f(fmaf(pt[r], LOG2E, mneg)); ps += pt[r]; }
            { auto rr = __builtin_amdgcn_permlane32_swap(__float_as_uint(ps), __float_as_uint(ps), false, false);
              ps = __uint_as_float(rr[0]) + __uint_as_float(rr[1]); }
            l_run = l_run * alpha + ps;
            if (__any(alpha != 1.f)) {
#pragma unroll
                for (int d = 0; d < 4; ++d)
#pragma unroll
                    for (int r = 0; r < 16; ++r) o[d][r] *= alpha;
            }
            bf16x8 pa[2];
#pragma unroll
            for (int s = 0; s < 2; ++s) { u32x4 w = {cvtpk(pt[8 * s + 0], pt[8 * s + 1]), cvtpk(pt[8 * s + 2], pt[8 * s + 3]), cvtpk(pt[8 * s + 4], pt[8 * s + 5]), cvtpk(pt[8 * s + 6], pt[8 * s + 7])};
                pa[s] = *reinterpret_cast<bf16x8*>(&w); }
#define TRRD(dst, off) asm volatile("ds_read_b64_tr_b16 %0, %1 offset:%2" : "=&v"(dst) : "v"(vt), "i"(off) : "memory")
#define MLA_PV(d0) do { s16x4 a0, a1, b0, b1; TRRD(a0, (d0) * 256); TRRD(a1, (d0) * 256 + 2048); TRRD(b0, (d0) * 256 + 4096); TRRD(b1, (d0) * 256 + 6144); \
            asm volatile("s_waitcnt lgkmcnt(0)" ::: "memory"); __builtin_amdgcn_sched_barrier(0); \
            o[d0] = __builtin_amdgcn_mfma_f32_32x32x16_bf16((bf16x8){a0[0], a0[1], a0[2], a0[3], a1[0], a1[1], a1[2], a1[3]}, pa[0], o[d0], 0, 0, 0); \
            o[d0] = __builtin_amdgcn_mfma_f32_32x32x16_bf16((bf16x8){b0[0], b0[1], b0[2], b0[3], b1[0], b1[1], b1[2], b1[3]}, pa[1], o[d0], 0, 0, 0); } while (0)
            MLA_PV(0); MLA_PV(1); MLA_PV(2); MLA_PV(3);
#undef MLA_PV
#undef TRRD
        }
    }
#undef MLA_DMA
    __builtin_amdgcn_s_barrier();
    float* cmb = (float*)smem + (size_t)wq * 66 * 64;
    if (grp == 1) {
#pragma unroll
        for (int d = 0; d < 4; ++d)
#pragma unroll
            for (int r = 0; r < 16; ++r) cmb[(d * 16 + r) * 64 + lane] = o[d][r];
        cmb[64 * 64 + lane] = m_run; cmb[65 * 64 + lane] = l_run;
    }
    __syncthreads();
    if (grp == 0) {
        const float m1 = cmb[64 * 64 + lane], l1 = cmb[65 * 64 + lane];
        const float mn = fmaxf(m_run, m1);
        const float a0 = __builtin_amdgcn_exp2f((m_run - mn) * LOG2E), a1 = __builtin_amdgcn_exp2f((m1 - mn) * LOG2E);
        const float linv = 1.f / (l_run * a0 + l1 * a1);
        const float s0 = a0 * linv, s1 = a1 * linv;
        const u16* SZ = (const u16*)(p.ws + WS_SZB) + (size_t)qrow * 1024 + h * 128;
        u16* UB = (u16*)(p.ws + WS_UB) + (size_t)qrow * 1024 + h * 128;
        u32x2 zws[16];
#pragma unroll
        for (int d = 0; d < 4; ++d)
#pragma unroll
            for (int a = 0; a < 4; ++a) zws[d * 4 + a] = *(const u32x2*)(SZ + d * 32 + 8 * a + 4 * hi);
#pragma unroll
        for (int d = 0; d < 4; ++d)
#pragma unroll
            for (int a = 0; a < 4; ++a) {
                const int dim = d * 32 + 8 * a + 4 * hi;
                const u32x2 zw = zws[d * 4 + a];
                float v[4];
#pragma unroll
                for (int b = 0; b < 4; ++b) v[b] = o[d][4 * a + b] * s0 + cmb[(d * 16 + 4 * a + b) * 64 + lane] * s1;
                v[0] *= __uint_as_float(zw[0] << 16); v[1] *= __uint_as_float(zw[0] & 0xffff0000u); v[2] *= __uint_as_float(zw[1] << 16); v[3] *= __uint_as_float(zw[1] & 0xffff0000u);
                store4_bf16(UB + dim, v[0], v[1], v[2], v[3]);
            }
    }
    __syncthreads();
}
__device__ void phase_mla_attn(const Params& p) {
    const int h = blockIdx.x & 7, i = blockIdx.x >> 3;
    mla_qblock(p, h, 63 - i);
    mla_qblock(p, h, i);
}

constexpr int IDX_CAP = 1024, IDX_WAVE_LDS = 2 * IDX_CAP * 4 + 2 * IDX_CAP * 2 + 1024;
__device__ __forceinline__ unsigned ordk(unsigned b) { return (b & 0x80000000u) ? ~b : (b | 0x80000000u); }

__device__ __forceinline__ float idx_prune(unsigned* lk, u16* li, unsigned* hist, const int n, const int lane) {
    unsigned kmin = 0xffffffffu, kmax = 0u;
    for (int e = lane; e < n; e += 64) { const unsigned k = ordk(lk[e]); kmin = k < kmin ? k : kmin; kmax = k > kmax ? k : kmax; }
#pragma unroll
    for (int o = 32; o > 0; o >>= 1) { const unsigned a = __shfl_xor(kmin, o), b = __shfl_xor(kmax, o); kmin = a < kmin ? a : kmin; kmax = b > kmax ? b : kmax; }
    const unsigned range = kmax - kmin;
    int hib = range ? (32 - __builtin_clz(range)) : 0;
    unsigned pre = 0; int need = TOPK; bool first = true;
    while (hib > 0) {
        const int wbits = hib < 8 ? hib : 8, sh = hib - wbits;
        const unsigned dmask = (1u << wbits) - 1u;
        *(u32x4*)(hist + lane * 4) = (u32x4){0u, 0u, 0u, 0u};
        for (int e = lane; e < n; e += 64) { const unsigned rel = ordk(lk[e]) - kmin;
            const bool match = first || ((hib < 32 ? (rel >> hib) : 0u) == (hib < 32 ? (pre >> hib) : 0u));
            if (match) atomicAdd(&hist[(rel >> sh) & dmask], 1u); }
        const u32x4 hv = *(const u32x4*)(hist + lane * 4);
        const int s = (int)(hv[0] + hv[1] + hv[2] + hv[3]);
        int S = s;
#pragma unroll
        for (int o = 1; o < 64; o <<= 1) { const int v = __shfl_down(S, o); if (lane + o < 64) S += v; }
        const int above = S - s;
        const bool cross = (above < need) && (S >= need);
        const unsigned long long bm = __ballot(cross);
        const int L = __ffsll((long long)bm) - 1;
        int dsel = 0, nneed = 0, acc = above; bool found = false;
#pragma unroll
        for (int i = 3; i >= 0; --i) { const int hc = (int)hv[i];
            if (!found && acc + hc >= need) { dsel = lane * 4 + i; nneed = need - acc; found = true; }
            acc += hc; }
        dsel = __shfl(dsel, L); nneed = __shfl(nneed, L);
        pre |= ((unsigned)dsel) << sh; need = nneed; hib = sh; first = false;
    }
    const unsigned prefix = kmin + pre;
    int outc = 0, eqc = 0;
    for (int c0 = 0; c0 < n; c0 += 64) {
        const int e = c0 + lane; const bool in = e < n;
        const unsigned kb = in ? lk[e] : 0u; const u16 ix = in ? li[e] : (u16)0; const unsigned k = ordk(kb);
        const bool gt = in && k > prefix, eq = in && k == prefix;
        const unsigned long long beq = __ballot(eq);
        const int eqr = eqc + __popcll(beq & ((1ull << lane) - 1ull));
        const bool keep = gt || (eq && eqr < need);
        const unsigned long long bk = __ballot(keep);
        const int pos = outc + __popcll(bk & ((1ull << lane) - 1ull));
        if (keep) { lk[pos] = kb; li[pos] = ix; }
        outc += __popcll(bk); eqc += __popcll(beq);
    }
    const unsigned tb = (prefix & 0x80000000u) ? (prefix & 0x7fffffffu) : ~prefix;
    return __uint_as_float(tb);
}

constexpr int IDX_RING_OFF = 8 * IDX_WAVE_LDS;
__device__ __forceinline__ void idx_round(const Params& p, const int pr, const int pr_max, char* wlds, const int wid, const int lane) {
    extern __shared__ __attribute__((aligned(16))) char smem[];
    const int t0 = 2 * pr, c = lane & 31, hi = lane >> 5, tq = t0 + hi;
    int* SEL = (int*)(p.ws + WS_SEL); int* CNT = (int*)(p.ws + WS_CNT);
    const bool direct = (t0 + 1 < TOPK);
    if (direct) {
        for (int q = 0; q < 2; ++q) { const int t = t0 + q; for (int i = lane; i <= t; i += 64) SEL[(size_t)t * TOPK + i] = i; if (lane == 0) CNT[t] = t + 1; }
    }
    const int maxkeys = 2 * pr_max + 2;
    if (maxkeys <= TOPK) return;
    const int nch = (maxkeys + 127) >> 7;
    unsigned* lkA = (unsigned*)wlds; unsigned* lkB = lkA + IDX_CAP; u16* liA = (u16*)(lkB + IDX_CAP); u16* liB = liA + IDX_CAP; unsigned* hist = (unsigned*)(liB + IDX_CAP);
    unsigned* lk = hi ? lkB : lkA; u16* li = hi ? liB : liA;
    const u16* IQ = (const u16*)(p.ws + WS_IQ); const float* IW = (const float*)(p.ws + WS_IW);
    const __amdgpu_buffer_rsrc_t rs = __builtin_amdgcn_make_buffer_rsrc((void*)(p.ws + WS_IK), (short)0, 0x7fffffff, 0x00020000);
    bf16x8 af[4]; float w[16];
    if (!direct) {
        const int aq = (c >> 2) & 1, ah = (c & 3) + 4 * (c >> 3);
        const u16* ap = IQ + (size_t)(t0 + aq) * 1024 + ah * 64 + hi * 8;
#pragma unroll
        for (int s = 0; s < 4; ++s) af[s] = *(const bf16x8*)(ap + 16 * s);
        const f32x4* wp = (const f32x4*)(IW + (size_t)tq * 16);
#pragma unroll
        for (int i = 0; i < 4; ++i) { const f32x4 v = wp[i]; w[4 * i] = v[0]; w[4 * i + 1] = v[1]; w[4 * i + 2] = v[2]; w[4 * i + 3] = v[3]; }
    } else {
#pragma unroll
        for (int s = 0; s < 4; ++s) af[s] = (bf16x8){0, 0, 0, 0, 0, 0, 0, 0};
#pragma unroll
        for (int i = 0; i < 16; ++i) w[i] = 0.f;
    }
    asm volatile("s_waitcnt vmcnt(0)" : "+v"(af[0]), "+v"(af[1]), "+v"(af[2]), "+v"(af[3]) :: "memory");
    asm volatile("" : "+v"(w[0]), "+v"(w[1]), "+v"(w[2]), "+v"(w[3]), "+v"(w[4]), "+v"(w[5]), "+v"(w[6]), "+v"(w[7]));
    asm volatile("" : "+v"(w[8]), "+v"(w[9]), "+v"(w[10]), "+v"(w[11]), "+v"(w[12]), "+v"(w[13]), "+v"(w[14]), "+v"(w[15]));
    int voff[2];
#pragma unroll
    for (int i = 0; i < 2; ++i) { const int kl = (2 * wid + i) * 8 + (lane >> 3), cpos = lane & 7; voff[i] = kl * 128 + ((cpos ^ ((kl >> 1) & 7)) << 4); }
#define IDX_DMA(ch_) do { char* dst_ = smem + IDX_RING_OFF + ((ch_) & 1) * 16384; \
    _Pragma("unroll") for (int i = 0; i < 2; ++i) \
        __builtin_amdgcn_raw_ptr_buffer_load_lds(rs, (__attribute__((address_space(3))) void*)(dst_ + (2 * wid + i) * 1024 + lane * 16), 16, voff[i], (ch_) * 16384, 0, 0); } while (0)
    int kadr[4];
    { const int f = (c >> 1) & 7;
#pragma unroll
      for (int s = 0; s < 4; ++s) kadr[s] = c * 128 + (((2 * s + hi) ^ f) << 4); }
    int cntA = 0, cntB = 0; float tau = -INFINITY;
    asm volatile("s_waitcnt vmcnt(0)" ::: "memory");
    __builtin_amdgcn_s_barrier();
    if (wid == 0 && lane < 2) ((unsigned*)(smem + IDX_RING_OFF + 32768))[lane] = 0u;
    IDX_DMA(0);
    for (int ch = 0; ch < nch; ++ch) {
        if (ch + 1 < nch) { IDX_DMA(ch + 1); asm volatile("s_waitcnt vmcnt(2)" ::: "memory"); }
        else asm volatile("s_waitcnt vmcnt(0)" ::: "memory");
        __builtin_amdgcn_s_barrier();
        if (!direct) {
            const char* buf = smem + IDX_RING_OFF + (ch & 1) * 16384;
#pragma unroll 1
            for (int tile = 0; tile < 4; ++tile) {
                const int key0 = ch * 128 + tile * 32;
                if (key0 > t0 + 1) break;
                f32x16 d;
#pragma unroll
                for (int r = 0; r < 16; ++r) d[r] = 0.f;
#pragma unroll
                for (int s = 0; s < 4; ++s) { const bf16x8 bf = *(const bf16x8*)(buf + tile * 4096 + kadr[s]); d = __builtin_amdgcn_mfma_f32_32x32x16_bf16(af[s], bf, d, 0, 0, 0); }
                float sc = 0.f;
#pragma unroll
                for (int r = 0; r < 16; ++r) sc = fmaf(w[r], fmaxf(d[r], 0.f), sc);
                const int key = key0 + c;
                const bool pass = (key <= tq) && (sc > tau);
                const unsigned long long mask = __ballot(pass);
                if (mask != 0ull) {
                    const unsigned mA = (unsigned)mask, mB = (unsigned)(mask >> 32);
                    const unsigned mq = hi ? mB : mA;
                    const int pos = (hi ? cntB : cntA) + __popc(mq & ((1u << c) - 1u));
                    if (pass) { lk[pos] = __float_as_uint(sc); li[pos] = (u16)key; }
                    cntA += __popc(mA); cntB += __popc(mB);
                }
            }
        }
        unsigned* flag = (unsigned*)(smem + IDX_RING_OFF + 32768);
        if ((cntA > IDX_CAP - 128 || cntB > IDX_CAP - 128) && lane == 0) flag[ch & 1] = 1u;
        asm volatile("s_waitcnt lgkmcnt(0)" ::: "memory");
        __builtin_amdgcn_s_barrier();
        const unsigned fl = flag[ch & 1];
        if (wid == 0 && lane == 0) flag[(ch + 1) & 1] = 0u;
        if (fl != 0u && !direct) {
            if (cntA > TOPK) { const float ta = idx_prune(lkA, liA, hist, cntA, lane); cntA = TOPK; if (!hi) tau = ta; }
            if (cntB > TOPK) { const float tb = idx_prune(lkB, liB, hist, cntB, lane); cntB = TOPK; if (hi) tau = tb; }
        }
    }
#undef IDX_DMA
    if (!direct) {
        if (cntA > TOPK) { idx_prune(lkA, liA, hist, cntA, lane); }
        if (cntB > TOPK) { idx_prune(lkB, liB, hist, cntB, lane); }
#pragma unroll
        for (int i = 0; i < 4; ++i) { SEL[(size_t)t0 * TOPK + lane + 64 * i] = (int)liA[lane + 64 * i]; SEL[(size_t)(t0 + 1) * TOPK + lane + 64 * i] = (int)liB[lane + 64 * i]; }
        if (lane == 0) { int tk = TOPK; asm volatile("" : "+v"(tk)); CNT[t0] = tk; CNT[t0 + 1] = tk; }
    }
}
__device__ void phase_indexer(const Params& p) {
    extern __shared__ __attribute__((aligned(16))) char smem[];
    const int tid_ = opaque_tid();
    const int wid = __builtin_amdgcn_readfirstlane(tid_ >> 6), lane = tid_ & 63;
    char* wlds = smem + wid * IDX_WAVE_LDS;
    const int gw = blockIdx.x * 8 + wid;
    __syncthreads();
#pragma unroll 1
    for (int rnd = 0; rnd < 2; ++rnd) {
        const int pr = rnd ? gw : 4095 - gw, prmax = rnd ? (int)blockIdx.x * 8 + 7 : 4095 - (int)blockIdx.x * 8;
        idx_round(p, pr, prmax, wlds, wid, lane);
    }
    __syncthreads();
}

__device__ __forceinline__ float softmax_cols16(f32x4 (&S)[16]) {
    float mx = S[0][0];
#pragma unroll
    for (int kb = 0; kb < 16; ++kb)
#pragma unroll
        for (int i = 0; i < 4; ++i) mx = fmaxf(mx, S[kb][i]);
    mx = fmaxf(mx, __shfl_xor(mx, 16)); mx = fmaxf(mx, __shfl_xor(mx, 32));
    const float mneg = -mx * LOG2E;
    float sum = 0.f;
#pragma unroll
    for (int kb = 0; kb < 16; ++kb)
#pragma unroll
        for (int i = 0; i < 4; ++i) { S[kb][i] = __builtin_amdgcn_exp2f(fmaf(S[kb][i], LOG2E, mneg)); sum += S[kb][i]; }
    sum += __shfl_xor(sum, 16); sum += __shfl_xor(sum, 32);
    return sum;
}
__device__ __forceinline__ bf16x8 pack_p(const f32x4& a, const f32x4& b) {
    u32x4 w = {cvtpk(a[0], a[1]), cvtpk(a[2], a[3]), cvtpk(b[0], b[1]), cvtpk(b[2], b[3])};
    return *reinterpret_cast<bf16x8*>(&w);
}
#define TRRD16(dst, base, off) asm volatile("ds_read_b64_tr_b16 %0, %1 offset:%2" : "=&v"(dst) : "v"(base), "i"(off) : "memory")

constexpr int SP_WAVE_LDS = 1024 + 2 * 8192;
constexpr int SP_RELB_OFF = 8 * SP_WAVE_LDS;
__device__ __forceinline__ void sp_item(const Params& p, const int t, const int g, char* wl, const float* relb_l, const int lane) {
    const unsigned char* bktab = (const unsigned char*)(relb_l + 256);
    u16* sel_l = (u16*)wl; unsigned char* bkt_l = (unsigned char*)(wl + 512); char* vtile = wl + 1024;
    const int i16 = lane & 15, c = lane >> 4;
    const int* SEL = (const int*)(p.ws + WS_SEL); const int cnt = ((const int*)(p.ws + WS_CNT))[t];
    const u16* KVA = (const u16*)(p.ws + WS_KVA);
    const __amdgpu_buffer_rsrc_t rs = __builtin_amdgcn_make_buffer_rsrc((void*)(p.ws + WS_KVA), (short)0, 0x7fffffff, 0x00020000);
    {
        const int pt = p.positions[t];
#pragma unroll
        for (int i = 0; i < 4; ++i) { const int slot = lane + 64 * i; const int s = (slot < cnt) ? SEL[(size_t)t * TOPK + slot] : 0;
            sel_l[slot] = (u16)s; int dist = pt - p.positions[s]; dist = dist > 0 ? dist : 0; bkt_l[slot] = (dist < 128) ? bktab[dist] : (unsigned char)31; }
    }
#define SP_VDMA(u_) do { char* dst_ = vtile + ((u_) & 1) * 8192; \
    _Pragma("unroll") for (int m = 0; m < 8; ++m) { const int kl_ = 8 * (m >> 1) + (i16 >> 1), ch_ = 8 * (m & 1) + 2 * c + (lane & 1); \
        const int tok_ = sel_l[(u_) * 32 + kl_]; \
        __builtin_amdgcn_raw_ptr_buffer_load_lds(rs, (__attribute__((address_space(3))) void*)(dst_ + m * 1024 + lane * 16), 16, tok_ * 1024 + g * 512 + 256 + ch_ * 16, 0, 0, 0); } } while (0)
    SP_VDMA(0); SP_VDMA(1);
    bf16x8 qf[4];
    { const u16* qp = (const u16*)(p.ws + WS_AQ) + (size_t)t * 1024 + (g * 4 + (i16 & 3)) * 128 + 8 * c;
#pragma unroll
      for (int s = 0; s < 4; ++s) { qf[s] = *(const bf16x8*)(qp + 32 * s); if (i16 >= 4) qf[s] = (bf16x8){0, 0, 0, 0, 0, 0, 0, 0}; } }
    f32x4 S[16];
#pragma unroll
    for (int kb = 0; kb < 16; ++kb) {
        const int tok = sel_l[16 * kb + i16];
        const u16* kp = KVA + (size_t)tok * 512 + g * 256 + 8 * c;
        f32x4 a = {0.f, 0.f, 0.f, 0.f};
#pragma unroll
        for (int s = 0; s < 4; ++s) { const bf16x8 kf = *(const bf16x8*)(kp + 32 * s); a = __builtin_amdgcn_mfma_f32_16x16x32_bf16(kf, qf[s], a, 0, 0, 0); }
        S[kb] = a;
    }
#pragma unroll
    for (int kb = 0; kb < 16; ++kb) {
        const unsigned bw = *(const unsigned*)(bkt_l + 16 * kb + 4 * c);
#pragma unroll
        for (int i = 0; i < 4; ++i) { const int slot = 16 * kb + 4 * c + i; const int b = (bw >> (8 * i)) & 255;
            const float bias = relb_l[b * 8 + g * 4 + (i16 & 3)];
            S[kb][i] = (slot < cnt) ? (S[kb][i] + bias) : -INFINITY; }
    }
    const float lsum = softmax_cols16(S);
    f32x4 O[8];
#pragma unroll
    for (int d = 0; d < 8; ++d) O[d] = f32x4{0.f, 0.f, 0.f, 0.f};
    const int vlane = (c >> 1) * 2048 + (c & 1) * 128 + (i16 >> 2) * 32 + (i16 & 3) * 8;
#pragma unroll
    for (int u = 0; u < 8; ++u) {
        if (u < 7) asm volatile("s_waitcnt vmcnt(8)" ::: "memory"); else asm volatile("s_waitcnt vmcnt(0)" ::: "memory");
        const int vb = (int)(uintptr_t)(vtile + (u & 1) * 8192) + vlane;
        const bf16x8 pf = pack_p(S[2 * u], S[2 * u + 1]);
#define SP_PV(d0) do { s16x4 x0, x1; TRRD16(x0, vb, (d0) * 256); TRRD16(x1, vb, (d0) * 256 + 4096); \
        asm volatile("s_waitcnt lgkmcnt(0)" ::: "memory"); __builtin_amdgcn_sched_barrier(0); \
        O[d0] = __builtin_amdgcn_mfma_f32_16x16x32_bf16((bf16x8){x0[0], x0[1], x0[2], x0[3], x1[0], x1[1], x1[2], x1[3]}, pf, O[d0], 0, 0, 0); } while (0)
        SP_PV(0); SP_PV(1); SP_PV(2); SP_PV(3); SP_PV(4); SP_PV(5); SP_PV(6); SP_PV(7);
#undef SP_PV
        if (u + 2 < 8) SP_VDMA(u + 2);
    }
#undef SP_VDMA
    if (i16 < 4) {
        const float linv = 1.f / lsum;
        const size_t ob = (size_t)t * 1024 + (g * 4 + i16) * 128 + 4 * c;
        const u16* SZ = (const u16*)(p.ws + WS_SZA) + ob; u16* UA = (u16*)(p.ws + WS_UA) + ob;
        u32x2 zws[8];
#pragma unroll
        for (int d = 0; d < 8; ++d) zws[d] = *(const u32x2*)(SZ + d * 16);
#pragma unroll
        for (int d = 0; d < 8; ++d) { const u32x2 zw = zws[d];
            store4_bf16(UA + d * 16, O[d][0] * linv * __uint_as_float(zw[0] << 16), O[d][1] * linv * __uint_as_float(zw[0] & 0xffff0000u),
                        O[d][2] * linv * __uint_as_float(zw[1] << 16), O[d][3] * linv * __uint_as_float(zw[1] & 0xffff0000u)); }
    }
}
__device__ void phase_sparse_attn(const Params& p) {
    extern __shared__ __attribute__((aligned(16))) char smem[];
    const int tid_ = opaque_tid();
    const int wid = __builtin_amdgcn_readfirstlane(tid_ >> 6), lane = tid_ & 63;
    float* relb_l = (float*)(smem + SP_RELB_OFF);
    __syncthreads();
    if (tid_ < 256) relb_l[tid_] = p.rel_bias[tid_];
    if (tid_ < 32) ((unsigned*)(smem + SP_RELB_OFF + 1024))[tid_] = ((const unsigned*)(p.ws + WS_BKT))[tid_];
    __syncthreads();
    char* wl = smem + wid * SP_WAVE_LDS;
    const int g = blockIdx.x & 1, wg = (blockIdx.x >> 1) * 8 + wid;
    for (int t = wg; t < SEQ; t += 1024) sp_item(p, t, g, wl, relb_l, lane);
    asm volatile("s_waitcnt vmcnt(0)" ::: "memory");
    __syncthreads();
}

__device__ void phase_mem_attn(const Params& p) {
    extern __shared__ __attribute__((aligned(16))) char smem[];
    const int tid_ = opaque_tid();
    const int wid = __builtin_amdgcn_readfirstlane(tid_ >> 6), lane = tid_ & 63, i16 = lane & 15, c = lane >> 4;
    const int hh = blockIdx.x & 3, q0 = (blockIdx.x >> 2) * 128 + wid * 16;
    const __amdgpu_buffer_rsrc_t rsK = __builtin_amdgcn_make_buffer_rsrc((void*)(p.ws + WS_CK), (short)0, 0x7fffffff, 0x00020000);
    const __amdgpu_buffer_rsrc_t rsV = __builtin_amdgcn_make_buffer_rsrc((void*)(p.ws + WS_CV), (short)0, 0x7fffffff, 0x00020000);
    __syncthreads();
#pragma unroll 4
    for (int m = 0; m < 16; ++m) { const int o = (wid * 16 + m) * 1024 + lane * 16, key = o >> 9, cpos = (o & 511) >> 4;
        const int chunk = (cpos & 16) | ((cpos & 15) ^ (key & 15));
        __builtin_amdgcn_raw_ptr_buffer_load_lds(rsK, (__attribute__((address_space(3))) void*)(smem + o), 16, key * 2048 + hh * 512 + chunk * 16, 0, 0, 0); }
    bf16x8 qf[8];
    { const u16* qp = (const u16*)(p.ws + WS_CQ) + (size_t)(q0 + i16) * 1024 + hh * 256 + 8 * c;
#pragma unroll
      for (int s = 0; s < 8; ++s) qf[s] = *(const bf16x8*)(qp + 32 * s); }
    asm volatile("s_waitcnt vmcnt(0)" ::: "memory");
    __syncthreads();
    f32x4 S[16];
    {
        int kbase[4];
#pragma unroll
        for (int a = 0; a < 4; ++a) kbase[a] = i16 * 512 + 16 * ((4 * a + c) ^ i16);
#pragma unroll
        for (int kb = 0; kb < 16; ++kb) {
            f32x4 acc = {0.f, 0.f, 0.f, 0.f};
            int kofs = kb * 8192; asm volatile("" : "+v"(kofs));
#pragma unroll
            for (int s = 0; s < 8; ++s) { const bf16x8 kf = *(const bf16x8*)(smem + kofs + kbase[s & 3] + (s >> 2) * 256);
                acc = __builtin_amdgcn_mfma_f32_16x16x32_bf16(kf, qf[s], acc, 0, 0, 0); }
            asm volatile("" : "+v"(acc));
            S[kb] = acc;
        }
    }
    __syncthreads();
#pragma unroll 4
    for (int m = 0; m < 16; ++m) { const int o = (wid * 16 + m) * 1024 + lane * 16, sub = o >> 8, key = (sub >> 4) * 8 + ((o & 255) >> 5), chunk = (sub & 15) * 2 + ((o >> 4) & 1);
        __builtin_amdgcn_raw_ptr_buffer_load_lds(rsV, (__attribute__((address_space(3))) void*)(smem + o), 16, key * 2048 + hh * 512 + chunk * 16, 0, 0, 0); }
    const float lsum = softmax_cols16(S);
    asm volatile("s_waitcnt vmcnt(0)" ::: "memory");
    __syncthreads();
    f32x4 O[16];
#pragma unroll
    for (int d = 0; d < 16; ++d) O[d] = f32x4{0.f, 0.f, 0.f, 0.f};
    const int vlane = (int)(uintptr_t)smem + (c >> 1) * 4096 + (c & 1) * 128 + (i16 >> 2) * 32 + (i16 & 3) * 8;
#pragma unroll
    for (int u = 0; u < 8; ++u) {
        const int vb = vlane + u * 16384;
        const bf16x8 pf = pack_p(S[2 * u], S[2 * u + 1]);
#define MEM_PV(d0) do { s16x4 x0, x1; TRRD16(x0, vb, (d0) * 256); TRRD16(x1, vb, (d0) * 256 + 8192); \
        asm volatile("s_waitcnt lgkmcnt(0)" ::: "memory"); __builtin_amdgcn_sched_barrier(0); \
        O[d0] = __builtin_amdgcn_mfma_f32_16x16x32_bf16((bf16x8){x0[0], x0[1], x0[2], x0[3], x1[0], x1[1], x1[2], x1[3]}, pf, O[d0], 0, 0, 0); } while (0)
        MEM_PV(0); MEM_PV(1); MEM_PV(2); MEM_PV(3); MEM_PV(4); MEM_PV(5); MEM_PV(6); MEM_PV(7);
        MEM_PV(8); MEM_PV(9); MEM_PV(10); MEM_PV(11); MEM_PV(12); MEM_PV(13); MEM_PV(14); MEM_PV(15);
#undef MEM_PV
    }
    {
        const float linv = 1.f / lsum;
        const size_t ob = (size_t)(q0 + i16) * 1024 + hh * 256 + 4 * c;
        const u16* SZ = (const u16*)(p.ws + WS_SZC) + ob; u16* UC = (u16*)(p.ws + WS_UC) + ob;
        u32x2 zws[16];
#pragma unroll
        for (int d = 0; d < 16; ++d) zws[d] = *(const u32x2*)(SZ + d * 16);
#pragma unroll
        for (int d = 0; d < 16; ++d) { const u32x2 zw = zws[d];
            store4_bf16(UC + d * 16, O[d][0] * linv * __uint_as_float(zw[0] << 16), O[d][1] * linv * __uint_as_float(zw[0] & 0xffff0000u),
                        O[d][2] * linv * __uint_as_float(zw[1] << 16), O[d][3] * linv * __uint_as_float(zw[1] & 0xffff0000u)); }
    }
    __syncthreads();
}

constexpr int DUP_SEL = 0;
constexpr int MEGA_LDS = SP_RELB_OFF + 1024 + 128;

#define XB_TMO      128
#define XB_XCNT(j)  (256  + 64 * (j))
#define XB_XSUB(j)  (1280 + 64 * (j))
#define XB_XGEN(j)  (2304 + 64 * (j))
#define XB_TOP      3328
#define XB_TOPGEN   3392
#define XCD_BAR_WORDS 3456
#define XB_SPIN_CAP (1u << 22)
#define LAS __attribute__((address_space(3)))
constexpr size_t WS_BAR = WS_CNT + 256 * 1024;
__device__ __forceinline__ unsigned xb_ld(unsigned* p)              { return __hip_atomic_load(p, __ATOMIC_RELAXED, __HIP_MEMORY_SCOPE_AGENT); }
__device__ __forceinline__ unsigned xb_add(unsigned* p, unsigned v) { return __hip_atomic_fetch_add(p, v, __ATOMIC_RELAXED, __HIP_MEMORY_SCOPE_AGENT); }
__device__ __forceinline__ unsigned xb_xcc_id() { return (unsigned)__builtin_amdgcn_s_getreg((3 << 11) | 20) & 0xFu; }
#define XB_SPIN(cond, bar) do { unsigned _sp = 0; while (cond) { __builtin_amdgcn_s_sleep(1); \
    if ((++_sp & 255u) == 0u) { if (xb_ld(&(bar)[XB_TMO])) break; if (_sp > XB_SPIN_CAP) { atomicAdd(&(bar)[XB_TMO], 1u); break; } } } } while (0)
struct XcdBarrier { unsigned* bar; unsigned x; volatile LAS unsigned* st; };
__device__ __forceinline__ XcdBarrier xcd_barrier_post(unsigned* bar, volatile LAS unsigned* st) {
    XcdBarrier b; b.bar = bar; b.x = xb_xcc_id(); b.st = st;
    if (threadIdx.x == 0) (void)xb_add(&bar[XB_XCNT(b.x)], 1u);
    return b;
}
__device__ __forceinline__ void xcd_barrier_complete(unsigned* bar, unsigned x, unsigned& nloc, unsigned& nx) {
    const unsigned G = gridDim.x * gridDim.y * gridDim.z;
    unsigned sum, cnt, mine, sp = 0u;
    for (;;) {
        sum = 0u; cnt = 0u; mine = 0u;
#pragma unroll
        for (unsigned j = 0; j < 16; ++j) { const unsigned c = xb_ld(&bar[XB_XCNT(j)]); sum += c; cnt += (c > 0u) ? 1u : 0u; mine = (j == x) ? c : mine; }
        if (sum == G) break;
        __builtin_amdgcn_s_sleep(1);
        if ((++sp & 255u) == 0u) { if (xb_ld(&bar[XB_TMO])) break; if (sp > XB_SPIN_CAP) { atomicAdd(&bar[XB_TMO], 1u); break; } }
    }
    nloc = mine > 0u ? mine : 1u; nx = cnt > 0u ? cnt : 1u;
}
__device__ __forceinline__ void xcd_barrier(const XcdBarrier& b) {
    asm volatile("s_waitcnt vmcnt(0)" ::: "memory");
    __syncthreads();
    if (threadIdx.x == 0) {
        unsigned* bar = b.bar;
        __builtin_amdgcn_s_waitcnt(0);
        unsigned nloc = b.st[0], nx = b.st[1];
        if (nloc == 0u) { xcd_barrier_complete(bar, b.x, nloc, nx); b.st[0] = nloc; b.st[1] = nx; }
        const unsigned old = xb_add(&bar[XB_XSUB(b.x)], 1u);
        const unsigned gen = old / nloc;
        if (old + 1u == (gen + 1u) * nloc) {
            __builtin_amdgcn_fence(__ATOMIC_RELEASE, "agent");
            asm volatile("s_waitcnt vmcnt(0)" ::: "memory");
            const unsigned og = xb_add(&bar[XB_TOP], 1u);
            const unsigned tg = og / nx;
            if (og + 1u == (tg + 1u) * nx) xb_add(&bar[XB_TOPGEN], 1u);
            else XB_SPIN(xb_ld(&bar[XB_TOPGEN]) == tg, bar);
            __builtin_amdgcn_fence(__ATOMIC_ACQUIRE, "agent");
            xb_add(&bar[XB_XGEN(b.x)], 1u);
            asm volatile("s_waitcnt vmcnt(0)" ::: "memory");
        } else {
            XB_SPIN(xb_ld(&bar[XB_XGEN(b.x)]) == gen, bar);
            __builtin_amdgcn_fence(__ATOMIC_ACQUIRE, "agent");
            asm volatile("s_waitcnt vmcnt(0)" ::: "memory");
        }
    }
    __syncthreads();
}

__global__ void __launch_bounds__(512) mega_kernel(Params p_in) {
    extern __shared__ __attribute__((aligned(16))) char smem[];
    volatile LAS unsigned* st = (volatile LAS unsigned*)(smem + MEGA_LDS);
    if (threadIdx.x == 0) { st[0] = 0u; st[1] = 0u; st[2] = 0u; st[3] = 0u; }
    __syncthreads();
    const XcdBarrier xb = xcd_barrier_post((unsigned*)(p_in.ws + WS_BAR), st);
#define RUNP(id, call) do { call; if (DUP_SEL == (id) || (DUP_SEL == 10 && ((id) == 1 || (id) == 3 || (id) == 5 || (id) == 8 || (id) == 9))) { __syncthreads(); call; } } while (0)
#define FRESH_P() Params q = p_in; asm volatile("" : "+s"(q.ws), "+s"(q.dout)); const Params& p = q
    const int lo = p_in.phase_lo, hi = p_in.phase_hi;
    if (lo <= 1 && 1 < hi) { FRESH_P(); RUNP(1, phase_prep(p)); if (2 < hi) xcd_barrier(xb); }
    if (lo <= 2 && 2 < hi) { FRESH_P(); RUNP(2, phase_inproj(p)); if (3 < hi) xcd_barrier(xb); }
    if (lo <= 3 && 3 < hi) { FRESH_P(); RUNP(3, phase_mla_up(p)); RUNP(4, phase_indexer(p)); RUNP(5, phase_mem_attn(p)); if (4 < hi) xcd_barrier(xb); }
    if (lo <= 4 && 4 < hi) { FRESH_P(); RUNP(6, phase_mla_attn(p)); RUNP(7, phase_sparse_attn(p)); if (5 < hi) xcd_barrier(xb); }
    if (lo <= 5 && 5 < hi) { FRESH_P(); RUNP(8, phase_merge(p)); if (6 < hi) xcd_barrier(xb); }
    if (lo <= 6 && 6 < hi) { FRESH_P(); RUNP(9, phase_out(p)); }
    if (hi > 100) cooperative_groups::this_grid().sync();
}

extern "C" void kernel_launch(void* const* d_in, const int* in_sizes, int n_in, void* d_out, int out_size, void* d_ws, size_t ws_size,
                              hipStream_t stream) {
    if (ws_size < WS_END) { fprintf(stderr, "ws too small: %zu < %zu\n", ws_size, WS_END); return; }
    const float* x = (const float*)d_in[0];
    const float* mem = (const float*)d_in[1];
    const int* positions = (const int*)d_in[2];
    const float* rel_bias = (const float*)d_in[3];
    const float* norm_g = (const float*)d_in[4];
    const float* mem_norm_g = (const float*)d_in[5];
    const float* w_in = (const float*)d_in[6];
    const float* a_q_norm_g = (const float*)d_in[7];
    const float* a_k_norm_g = (const float*)d_in[8];
    const float* b_q_lat_norm_g = (const float*)d_in[9];
    const float* b_kv_lat_norm_g = (const float*)d_in[10];
    const float* w_b_uq = (const float*)d_in[11];
    const float* w_b_ukv = (const float*)d_in[12];
    const float* b_q_norm_g = (const float*)d_in[13];
    const float* b_k_norm_g = (const float*)d_in[14];
    const float* w_mem_kv = (const float*)d_in[15];
    const float* c_q_norm_g = (const float*)d_in[16];
    const float* c_k_norm_g = (const float*)d_in[17];
    const float* w_branch = (const float*)d_in[18];
    const float* w_out = (const float*)d_in[19];
    char* ws = (char*)d_ws;
    char* dout = (char*)d_out;
    u16* H = (u16*)(ws + WS_H); u16* HM = (u16*)(ws + WS_HM);
    u16* AQ = (u16*)(ws + WS_AQ); u16* KVA = (u16*)(ws + WS_KVA); u16* SZA = (u16*)(ws + WS_SZA);
    u16* IQ = (u16*)(ws + WS_IQ); u16* IK = (u16*)(ws + WS_IK); float* IW = (float*)(ws + WS_IW); float* BKPE = (float*)(ws + WS_BKPE);
    u16* BCQ = (u16*)(ws + WS_BCQ); u16* BCKV = (u16*)(ws + WS_BCKV); u16* SZB = (u16*)(ws + WS_SZB);
    u16* CQ = (u16*)(ws + WS_CQ); u16* SZC = (u16*)(ws + WS_SZC); u16* G = (u16*)(ws + WS_G);
    u16* CK = (u16*)(ws + WS_CK); u16* CV = (u16*)(ws + WS_CV);
    int* SEL = (int*)(ws + WS_SEL); int* CNT = (int*)(ws + WS_CNT);
    float* COS = (float*)(ws + WS_COS); float* SIN = (float*)(ws + WS_SIN);
    u16* UA = (u16*)(ws + WS_UA); u16* UB = (u16*)(ws + WS_UB); u16* UC = (u16*)(ws + WS_UC);
    u16* MERGED = (u16*)(ws + WS_MERGED);
    u16* QB = (u16*)(dout + DO_QB); u16* KB = (u16*)(dout + DO_KB); u16* VB = (u16*)(dout + DO_VB);
    float* RAW = (float*)(ws + WS_TMP_RAW);
    float* MF = (float*)(ws + WS_TMP_MERGEDF);
    float* Y = (float*)d_out;

    static bool attr_done = false;
    if (!attr_done) {
        attr_done = true;
        (void)hipFuncSetAttribute((const void*)nk_attn<192, 128, 64, true>, hipFuncAttributeMaxDynamicSharedMemorySize, 120 * 1024);
        (void)hipFuncSetAttribute((const void*)nk_attn<256, 256, 32, false>, hipFuncAttributeMaxDynamicSharedMemorySize, 120 * 1024);
        (void)hipFuncSetAttribute((const void*)mega_kernel, hipFuncAttributeMaxDynamicSharedMemorySize, MEGA_LDS + 16);
    }
    Params prm{};
    prm.x = x; prm.mem = mem; prm.positions = positions; prm.rel_bias = rel_bias; prm.norm_g = norm_g; prm.mem_norm_g = mem_norm_g;
    prm.w_in = w_in; prm.a_q_norm_g = a_q_norm_g; prm.a_k_norm_g = a_k_norm_g; prm.b_q_lat_norm_g = b_q_lat_norm_g; prm.b_kv_lat_norm_g = b_kv_lat_norm_g;
    prm.w_b_uq = w_b_uq; prm.w_b_ukv = w_b_ukv; prm.b_q_norm_g = b_q_norm_g; prm.b_k_norm_g = b_k_norm_g; prm.w_mem_kv = w_mem_kv;
    prm.c_q_norm_g = c_q_norm_g; prm.c_k_norm_g = c_k_norm_g; prm.w_branch = w_branch; prm.w_out = w_out;
    prm.ws = ws; prm.dout = dout;
#define GEMM(OutT, ACT, A_, lda_, B_, ldb_, C_, ldc_, M_, N_, K_, R_, ldr_) \
    nk_gemm<OutT, ACT><<<dim3(((N_) + 63) / 64, (M_) / 64), 256, 0, stream>>>(A_, lda_, B_, ldb_, C_, ldc_, M_, N_, K_, R_, ldr_)
    prm.phase_lo = 1; prm.phase_hi = 7;
    {
        (void)hipMemsetAsync(ws + WS_BAR, 0, XCD_BAR_WORDS * sizeof(unsigned), stream);
        void* args[] = {&prm};
        hipError_t e = hipLaunchCooperativeKernel((const void*)mega_kernel, dim3(256), dim3(512), args, MEGA_LDS + 16, stream);
        if (e != hipSuccess) fprintf(stderr, "cooperative launch failed: %s\n", hipGetErrorString(e));
    }
#undef GEMM
}
```

```cpp
#include <hip/hip_runtime.h>
#include <hip/hip_bf16.h>
#include <hip/hip_cooperative_groups.h>
#include <stdint.h>
#include <stdio.h>

typedef unsigned short u16;

constexpr int SEQ = 8192, DM = 2048, INW = 13712, NMEM = 256;
constexpr int OFF_AQ = 0, OFF_AK = 1024, OFF_AV = 1280, OFF_AZ = 1536, OFF_IQ = 2560, OFF_IK = 3584, OFF_IW = 3648,
              OFF_BCQ = 3664, OFF_BCKV = 4176, OFF_BKPE = 4432, OFF_BZ = 4496, OFF_CQ = 5520, OFF_CZ = 6544, OFF_G = 7568;
constexpr float EPS = 1e-6f;
constexpr float A_SCALE = 0.08838834764831845f;
constexpr float B_SCALE = 0.07216878364870322f;
constexpr float C_SCALE = 0.0625f;
constexpr int TOPK = 256;

constexpr size_t MiB = 1024 * 1024;
constexpr size_t WS_H = 0;
constexpr size_t WS_WINT = 32 * MiB;
constexpr size_t WS_WUQT = 86 * MiB;
constexpr size_t WS_WUKVT = 88 * MiB;
constexpr size_t WS_WMEMT = 89 * MiB;
constexpr size_t WS_WBRT = 97 * MiB;
constexpr size_t WS_WOUTT = 109 * MiB;
constexpr size_t WS_AQ = 117 * MiB;
constexpr size_t WS_KVA = 133 * MiB;
constexpr size_t WS_SZA = 141 * MiB;
constexpr size_t WS_IQ = 157 * MiB;
constexpr size_t WS_IK = 173 * MiB;
constexpr size_t WS_IW = 174 * MiB;
constexpr size_t WS_BKPE = 175 * MiB;
constexpr size_t WS_BCQ = 177 * MiB;
constexpr size_t WS_BCKV = 185 * MiB;
constexpr size_t WS_SZB = 189 * MiB;
constexpr size_t WS_CQ = 205 * MiB;
constexpr size_t WS_SZC = 221 * MiB;
constexpr size_t WS_G = 237 * MiB;
constexpr size_t WS_CK = 333 * MiB;
constexpr size_t WS_CV = WS_CK + 512 * 1024;
constexpr size_t WS_SEL = 334 * MiB;
constexpr size_t WS_CNT = 342 * MiB;
constexpr size_t WS_COS = 343 * MiB;
constexpr size_t WS_SIN = 344 * MiB;
constexpr size_t WS_UA = 345 * MiB;
constexpr size_t WS_UB = 361 * MiB;
constexpr size_t WS_UC = 377 * MiB;
constexpr size_t WS_MERGED = 393 * MiB;
constexpr size_t WS_HM = 425 * MiB;
constexpr size_t WS_END = 426 * MiB;
constexpr size_t WS_TMP_RAW = 345 * MiB;
constexpr size_t WS_TMP_MERGEDF = 0;
constexpr size_t DO_QB = 0, DO_KB = 24 * MiB, DO_VB = 48 * MiB;
constexpr size_t DO_H8 = 0;
constexpr size_t WS_WG8 = WS_WINT + 30 * MiB;
constexpr size_t WS_WS8 = WS_WINT + 42 * MiB;
constexpr size_t WS_WQ8 = WS_WINT + 48 * MiB;
constexpr size_t WS_WKV8 = WS_WINT + 4 * MiB;
constexpr float GATE_W_SCALE = 64.f;
constexpr float U8_SCALE = 16.f, WBR8_SCALE = 32.f, M8_SCALE = 32.f, WOUT8_SCALE = 64.f;
constexpr float MK8_SCALE = 8.f, MQ8_SCALE = 64.f;
constexpr float G8_SCALE = 256.f;
constexpr float K8_SCALE = 8.f, Q8_SCALE = 64.f;
constexpr int KV_TOK = 768, KV_GRP = 384;
constexpr size_t WS_M8 = WS_H;

__device__ __forceinline__ float bf2f(u16 u) { return __uint_as_float(((unsigned)u) << 16); }
__device__ __forceinline__ u16 f2bf(float f) {
    unsigned u = __float_as_uint(f);
    u += 0x7FFFu + ((u >> 16) & 1u);
    return (u16)(u >> 16);
}
__device__ __forceinline__ float sigmoid_f(float x) { return __builtin_amdgcn_rcpf(1.f + __builtin_amdgcn_exp2f(-1.4426950408889634f * x)); }
__device__ __forceinline__ float silu_f(float x) { return x * sigmoid_f(x); }
__device__ __forceinline__ int rope_phys(int j, int second) { return (j >> 4) * 32 + (j & 15) + second * 16; }

__device__ __forceinline__ float block_sum_256(float v, float* red) {
    for (int o = 32; o > 0; o >>= 1) v += __shfl_xor(v, o);
    __syncthreads();
    if ((threadIdx.x & 63) == 0) red[threadIdx.x >> 6] = v;
    __syncthreads();
    return red[0] + red[1] + red[2] + red[3];
}

__global__ void __launch_bounds__(256) nk_rmsnorm_rows(const float* __restrict__ x, const float* __restrict__ g, u16* __restrict__ out, int C) {
    __shared__ float red[4];
    const float* xr = x + (size_t)blockIdx.x * C;
    float ss = 0.f;
    for (int c = threadIdx.x; c < C; c += 256) { float v = xr[c]; ss += v * v; }
    ss = block_sum_256(ss, red);
    float rinv = rsqrtf(ss / (float)C + EPS);
    for (int c = threadIdx.x; c < C; c += 256) out[(size_t)blockIdx.x * C + c] = f2bf(xr[c] * rinv * g[c]);
}

__global__ void __launch_bounds__(256) nk_rope_tables(const int* __restrict__ pos, float* __restrict__ cs, float* __restrict__ sn) {
    int i = blockIdx.x * 256 + threadIdx.x;
    if (i >= SEQ * 32) return;
    int t = i >> 5, j = i & 31;
    float inv_freq = 1.0f / powf(10000.f, (float)(2 * j) / 64.f);
    float ang = (float)pos[t] * inv_freq;
    cs[i] = cosf(ang); sn[i] = sinf(ang);
}

template <typename OutT> __device__ __forceinline__ void store_out(OutT* p, float v);
template <> __device__ __forceinline__ void store_out<float>(float* p, float v) { *p = v; }
template <> __device__ __forceinline__ void store_out<u16>(u16* p, float v) { *p = f2bf(v); }

template <typename OutT, int ACT>
__global__ void __launch_bounds__(256) nk_gemm(const u16* __restrict__ A, int lda, const float* __restrict__ B, int ldb, OutT* __restrict__ C, int ldc,
                        int M, int N, int K, const float* __restrict__ R, int ldr) {
    __shared__ float As[16][65];
    __shared__ float Bs[16][65];
    const int tid = threadIdx.x, tx = tid & 15, ty = tid >> 4;
    const int m0 = blockIdx.y * 64, n0 = blockIdx.x * 64;
    float acc[4][4] = {};
    for (int k0 = 0; k0 < K; k0 += 16) {
        {
            int r = tid >> 2, kk = (tid & 3) * 4;
            const u16* ap = A + (size_t)(m0 + r) * lda + k0 + kk;
            for (int e = 0; e < 4; ++e) As[kk + e][r] = bf2f(ap[e]);
        }
        {
            int kk = tid >> 4, nn = (tid & 15) * 4;
            const float* bp = B + (size_t)(k0 + kk) * ldb + n0 + nn;
            for (int e = 0; e < 4; ++e) Bs[kk][nn + e] = (n0 + nn + e < N) ? bp[e] : 0.f;
        }
        __syncthreads();
#pragma unroll
        for (int k = 0; k < 16; ++k) {
            float a[4], b[4];
#pragma unroll
            for (int i = 0; i < 4; ++i) { a[i] = As[k][ty + 16 * i]; b[i] = Bs[k][tx + 16 * i]; }
#pragma unroll
            for (int i = 0; i < 4; ++i)
#pragma unroll
                for (int j = 0; j < 4; ++j) acc[i][j] = fmaf(a[i], b[j], acc[i][j]);
        }
        __syncthreads();
    }
    for (int i = 0; i < 4; ++i)
        for (int j = 0; j < 4; ++j) {
            int row = m0 + ty + 16 * i, col = n0 + tx + 16 * j;
            if (col < N) {
                float v = acc[i][j];
                if (ACT == 1) v = silu_f(v);
                if (ACT == 2) v = sigmoid_f(v);
                if (ACT == 3) v += R[(size_t)row * ldr + col];
                store_out<OutT>(C + (size_t)row * ldc + col, v);
            }
        }
}

__global__ void __launch_bounds__(256) nk_headnorm(u16* __restrict__ buf, long row_stride, long head_stride, int nheads, int HD,
                            const float* __restrict__ g, float scale, int nrows) {
    int wid = (blockIdx.x * 256 + threadIdx.x) >> 6, lane = threadIdx.x & 63;
    if (wid >= nrows * nheads) return;
    int row = wid / nheads, h = wid % nheads;
    u16* p = buf + (size_t)row * row_stride + (size_t)h * head_stride;
    float ss = 0.f;
    for (int i = lane; i < HD; i += 64) { float v = bf2f(p[i]); ss += v * v; }
    for (int o = 32; o > 0; o >>= 1) ss += __shfl_xor(ss, o);
    float rinv = rsqrtf(ss / (float)HD + EPS) * scale;
    for (int i = lane; i < HD; i += 64) p[i] = f2bf(bf2f(p[i]) * rinv * g[i]);
}

__global__ void __launch_bounds__(256) nk_rownorm_bf16(u16* __restrict__ buf, int C, const float* __restrict__ g, int nrows) {
    int wid = (blockIdx.x * 256 + threadIdx.x) >> 6, lane = threadIdx.x & 63;
    if (wid >= nrows) return;
    u16* p = buf + (size_t)wid * C;
    float ss = 0.f;
    for (int i = lane; i < C; i += 64) { float v = bf2f(p[i]); ss += v * v; }
    for (int o = 32; o > 0; o >>= 1) ss += __shfl_xor(ss, o);
    float rinv = rsqrtf(ss / (float)C + EPS);
    for (int i = lane; i < C; i += 64) p[i] = f2bf(bf2f(p[i]) * rinv * g[i]);
}

__global__ void __launch_bounds__(256) nk_mla_q_finish(const float* __restrict__ qraw, const float* __restrict__ g, const float* __restrict__ cs,
                                const float* __restrict__ sn, u16* __restrict__ QB) {
    int wid = (blockIdx.x * 256 + threadIdx.x) >> 6, lane = threadIdx.x & 63;
    if (wid >= SEQ * 8) return;
    int t = wid >> 3, h = wid & 7;
    const float* p = qraw + (size_t)t * 1536 + h * 192;
    float v0 = p[lane], v1 = p[64 + lane], v2 = p[128 + lane];
    float ss = v0 * v0 + v1 * v1 + v2 * v2;
    for (int o = 32; o > 0; o >>= 1) ss += __shfl_xor(ss, o);
    float rinv = rsqrtf(ss / 192.f + EPS);
    v0 *= rinv * g[lane]; v1 *= rinv * g[64 + lane]; v2 *= rinv * g[128 + lane];
    float other = __shfl_xor(v2, 32);
    int j = lane & 31;
    float c = cs[t * 32 + j], s = sn[t * 32 + j];
    float r = (lane < 32) ? (v2 * c - other * s) : (v2 * c + other * s);
    u16* o = QB + ((size_t)h * SEQ + t) * 192;
    o[lane] = f2bf(v0 * B_SCALE); o[64 + lane] = f2bf(v1 * B_SCALE);
    o[128 + rope_phys(j, lane >> 5)] = f2bf(r * B_SCALE);
}
__global__ void __launch_bounds__(256) nk_mla_kv_finish(const float* __restrict__ kvraw, const float* __restrict__ bkpe, const float* __restrict__ g,
                                 const float* __restrict__ cs, const float* __restrict__ sn, u16* __restrict__ KB, u16* __restrict__ VB) {
    int wid = (blockIdx.x * 256 + threadIdx.x) >> 6, lane = threadIdx.x & 63;
    if (wid >= SEQ * 8) return;
    int t = wid >> 3, h = wid & 7;
    const float* p = kvraw + (size_t)t * 2048 + h * 256;
    float v0 = p[lane], v1 = p[64 + lane], v2 = bkpe[(size_t)t * 64 + lane];
    float ss = v0 * v0 + v1 * v1 + v2 * v2;
    for (int o = 32; o > 0; o >>= 1) ss += __shfl_xor(ss, o);
    float rinv = rsqrtf(ss / 192.f + EPS);
    v0 *= rinv * g[lane]; v1 *= rinv * g[64 + lane]; v2 *= rinv * g[128 + lane];
    float other = __shfl_xor(v2, 32);
    int j = lane & 31;
    float c = cs[t * 32 + j], s = sn[t * 32 + j];
    float r = (lane < 32) ? (v2 * c - other * s) : (v2 * c + other * s);
    u16* o = KB + ((size_t)h * SEQ + t) * 192;
    o[lane] = f2bf(v0); o[64 + lane] = f2bf(v1);
    o[128 + rope_phys(j, lane >> 5)] = f2bf(r);
    u16* vo = VB + ((size_t)h * SEQ + t) * 128;
    vo[lane] = f2bf(p[128 + lane]); vo[64 + lane] = f2bf(p[192 + lane]);
}

template <int DQK, int DV, int KT, bool CAUSAL>
__global__ void __launch_bounds__(256) nk_attn(const u16* __restrict__ Q, long q_rs, long q_hs, const u16* __restrict__ K, long k_rs, long k_hs,
                        const u16* __restrict__ V, long v_rs, long v_hs, int Skv, const u16* __restrict__ SZ, u16* __restrict__ U) {
    extern __shared__ float sm[];
    float* Qs = sm;
    float* Ks = Qs + 32 * (DQK + 1);
    float* Vs = Ks + KT * (DQK + 1);
    float* Ss = Vs + KT * DV;
    float* mrow = Ss + 32 * (KT + 1);
    float* lrow = mrow + 32;
    float* arow = lrow + 32;
    const int tid = threadIdx.x, q0 = blockIdx.x * 32, h = blockIdx.y;
    for (int e = tid; e < 32 * DQK; e += 256) { int r = e / DQK, d = e % DQK; Qs[r * (DQK + 1) + d] = bf2f(Q[(size_t)(q0 + r) * q_rs + (size_t)h * q_hs + d]); }
    if (tid < 32) { mrow[tid] = -1e30f; lrow[tid] = 0.f; }
    constexpr int NO = DV / 8;
    float o[NO];
#pragma unroll
    for (int j = 0; j < NO; ++j) o[j] = 0.f;
    const int qi = tid >> 3, sub = tid & 7;
    const int kend = CAUSAL ? (q0 + 32) : Skv;
    for (int k0 = 0; k0 < kend; k0 += KT) {
        __syncthreads();
        for (int e = tid; e < KT * DQK; e += 256) { int r = e / DQK, d = e % DQK; int key = k0 + r;
            Ks[r * (DQK + 1) + d] = (key < Skv) ? bf2f(K[(size_t)key * k_rs + (size_t)h * k_hs + d]) : 0.f; }
        for (int e = tid; e < KT * DV; e += 256) { int r = e / DV, d = e % DV; int key = k0 + r;
            Vs[r * DV + d] = (key < Skv) ? bf2f(V[(size_t)key * v_rs + (size_t)h * v_hs + d]) : 0.f; }
        __syncthreads();
        {
            constexpr int NP = KT / 8;
            float s[NP];
#pragma unroll
            for (int j = 0; j < NP; ++j) s[j] = 0.f;
            for (int d = 0; d < DQK; ++d) { float qv = Qs[qi * (DQK + 1) + d];
#pragma unroll
                for (int j = 0; j < NP; ++j) s[j] = fmaf(qv, Ks[(sub + 8 * j) * (DQK + 1) + d], s[j]); }
#pragma unroll
            for (int j = 0; j < NP; ++j) { int key = k0 + sub + 8 * j;
                bool ok = key < Skv && (!CAUSAL || key <= q0 + qi);
                Ss[qi * (KT + 1) + sub + 8 * j] = ok ? s[j] : -INFINITY; }
        }
        __syncthreads();
        if (tid < 32) {
            float m = mrow[tid], mx = m;
            for (int k = 0; k < KT; ++k) mx = fmaxf(mx, Ss[tid * (KT + 1) + k]);
            float alpha = __expf(m - mx), sum = 0.f;
            for (int k = 0; k < KT; ++k) { float p = __expf(Ss[tid * (KT + 1) + k] - mx); Ss[tid * (KT + 1) + k] = p; sum += p; }
            mrow[tid] = mx; lrow[tid] = lrow[tid] * alpha + sum; arow[tid] = alpha;
        }
        __syncthreads();
        {
            float alpha = arow[qi];
#pragma unroll
            for (int j = 0; j < NO; ++j) o[j] *= alpha;
            for (int k = 0; k < KT; ++k) { float p = Ss[qi * (KT + 1) + k];
#pragma unroll
                for (int j = 0; j < NO; ++j) o[j] = fmaf(p, Vs[k * DV + sub + 8 * j], o[j]); }
        }
    }
    __syncthreads();
    float linv = 1.f / lrow[qi];
#pragma unroll
    for (int j = 0; j < NO; ++j) { int d = sub + 8 * j; size_t idx = (size_t)(q0 + qi) * 1024 + h * DV + d;
        U[idx] = f2bf(o[j] * linv * bf2f(SZ[idx])); }
}

__device__ __forceinline__ unsigned ord_key(float f) { unsigned u = __float_as_uint(f); return (u & 0x80000000u) ? ~u : (u | 0x80000000u); }
__global__ void __launch_bounds__(256) nk_indexer_topk(const u16* __restrict__ IQ, const u16* __restrict__ IK, const float* __restrict__ IW,
                                int* __restrict__ SEL, int* __restrict__ CNT) {
    __shared__ unsigned keys[SEQ];
    __shared__ float qs[16 * 64];
    __shared__ float ws[16];
    __shared__ int cnt_sh;
    __shared__ int wsum[8];
    const int t = blockIdx.x, tid = threadIdx.x, n = t + 1;
    int* sel = SEL + (size_t)t * TOPK;
    if (n <= TOPK) { for (int i = tid; i < n; i += 256) sel[i] = i; if (tid == 0) CNT[t] = n; return; }
    for (int e = tid; e < 1024; e += 256) qs[e] = bf2f(IQ[(size_t)t * 1024 + e]);
    if (tid < 16) ws[tid] = IW[(size_t)t * 16 + tid];
    __syncthreads();
    for (int s = tid; s < n; s += 256) {
        float kv[64];
        const u16* kp = IK + (size_t)s * 64;
#pragma unroll
        for (int d = 0; d < 64; ++d) kv[d] = bf2f(kp[d]);
        float sc = 0.f;
        for (int h = 0; h < 16; ++h) { float dot = 0.f;
#pragma unroll
            for (int d = 0; d < 64; ++d) dot = fmaf(qs[h * 64 + d], kv[d], dot);
            sc = fmaf(ws[h], fmaxf(dot, 0.f), sc); }
        keys[s] = ord_key(sc);
    }
    __syncthreads();
    unsigned prefix = 0; int need = TOPK;
    for (int bit = 31; bit >= 0; --bit) {
        if (tid == 0) cnt_sh = 0;
        __syncthreads();
        unsigned want = (prefix >> bit) | 1u;
        int c = 0;
        for (int s = tid; s < n; s += 256) c += ((keys[s] >> bit) == want) ? 1 : 0;
        for (int o = 32; o > 0; o >>= 1) c += __shfl_xor(c, o);
        if ((tid & 63) == 0) atomicAdd(&cnt_sh, c);
        __syncthreads();
        int tot = cnt_sh;
        if (tot >= need) prefix |= (1u << bit); else need -= tot;
        __syncthreads();
    }
    int base_sel = 0, base_eq = 0;
    for (int c0 = 0; c0 < n; c0 += 256) {
        int s = c0 + tid; bool in = s < n;
        unsigned kk = in ? keys[s] : 0u;
        bool gt = in && kk > prefix, eq = in && kk == prefix;
        unsigned long long beq = __ballot(eq);
        int w = tid >> 6, lane = tid & 63;
        if (lane == 0) wsum[w] = __popcll(beq);
        __syncthreads();
        int eqpre = base_eq + __popcll(beq & ((1ull << lane) - 1ull));
        for (int i = 0; i < w; ++i) eqpre += wsum[i];
        int eqtot = wsum[0] + wsum[1] + wsum[2] + wsum[3];
        bool selv = gt || (eq && eqpre < need);
        unsigned long long bs = __ballot(selv);
        if (lane == 0) wsum[4 + w] = __popcll(bs);
        __syncthreads();
        int pos = base_sel + __popcll(bs & ((1ull << lane) - 1ull));
        for (int i = 0; i < w; ++i) pos += wsum[4 + i];
        if (selv && pos < TOPK) sel[pos] = s;
        base_sel += wsum[4] + wsum[5] + wsum[6] + wsum[7];
        base_eq += eqtot;
        __syncthreads();
    }
    if (tid == 0) CNT[t] = TOPK;
}

__device__ __forceinline__ int t5_bucket(int dist) {
    int nn = dist > 0 ? dist : 0;
    if (nn < 16) return nn;
    float nf = (float)nn;
    int large = 16 + (int)(logf(nf / 16.f) / 2.0794415416798357f * 16.f);
    return large < 31 ? large : 31;
}
__global__ void __launch_bounds__(256) nk_sparse_attn(const u16* __restrict__ AQ, const u16* __restrict__ KVA, const int* __restrict__ SEL, const int* __restrict__ CNT,
                               const int* __restrict__ pos, const float* __restrict__ relb, const u16* __restrict__ SZA, u16* __restrict__ UA) {
    __shared__ float qs[1024];
    __shared__ int sl[TOPK];
    __shared__ int bk[TOPK];
    __shared__ float pr[TOPK];
    __shared__ float red[4];
    const int t = blockIdx.x, tid = threadIdx.x;
    const int cnt = CNT[t];
    for (int e = tid; e < 1024; e += 256) qs[e] = bf2f(AQ[(size_t)t * 1024 + e]);
    if (tid < cnt) { int s = SEL[(size_t)t * TOPK + tid]; sl[tid] = s; bk[tid] = t5_bucket(pos[t] - pos[s]); }
    __syncthreads();
    for (int h = 0; h < 8; ++h) {
        const int g = h >> 2;
        float logit = -INFINITY;
        if (tid < cnt) {
            const u16* kp = KVA + ((size_t)sl[tid] * 2 + g) * 256;
            float dot = 0.f;
            for (int d = 0; d < 128; ++d) dot = fmaf(qs[h * 128 + d], bf2f(kp[d]), dot);
            logit = dot + relb[bk[tid] * 8 + h];
        }
        float mx = logit;
        for (int o = 32; o > 0; o >>= 1) mx = fmaxf(mx, __shfl_xor(mx, o));
        __syncthreads();
        if ((tid & 63) == 0) red[tid >> 6] = mx;
        __syncthreads();
        mx = fmaxf(fmaxf(red[0], red[1]), fmaxf(red[2], red[3]));
        float p = (tid < cnt) ? __expf(logit - mx) : 0.f;
        pr[tid] = p;
        float sum = block_sum_256(p, red);
        __syncthreads();
        if (tid < 128) {
            float acc = 0.f;
            for (int k = 0; k < cnt; ++k) acc = fmaf(pr[k], bf2f(KVA[((size_t)sl[k] * 2 + g) * 256 + 128 + tid]), acc);
            size_t idx = (size_t)t * 1024 + h * 128 + tid;
            UA[idx] = f2bf(acc / sum * bf2f(SZA[idx]));
        }
        __syncthreads();
    }
}

__global__ void __launch_bounds__(256) nk_merge(const float* __restrict__ Y, const u16* __restrict__ G, int n, float* __restrict__ MF, u16* __restrict__ MERGED) {
    size_t i = (size_t)blockIdx.x * 256 + threadIdx.x;
    if (i >= (size_t)SEQ * DM) return;
    size_t t = i / DM, d = i % DM;
    float v = bf2f(G[t * 6144 + (size_t)n * DM + d]) * Y[i];
    if (n > 0) v += MF[i];
    MF[i] = v;
    if (n == 2) MERGED[i] = f2bf(v);
}


typedef short bf16x8 __attribute__((ext_vector_type(8)));
typedef float f32x4 __attribute__((ext_vector_type(4)));
typedef float f32x16 __attribute__((ext_vector_type(16)));
typedef unsigned u32x4 __attribute__((ext_vector_type(4)));
typedef unsigned u32x2 __attribute__((ext_vector_type(2)));

constexpr int DBG = 0;
constexpr size_t WS_DBG = WS_CNT + 240 * 1024;
#define DBG_T() ((long long)__builtin_amdgcn_s_memtime())
constexpr size_t WS_LATQ = WS_CNT + 64 * 1024;
constexpr size_t WS_LATKV = WS_CNT + 128 * 1024;
constexpr size_t WS_PESS = WS_CNT + 192 * 1024;
constexpr size_t WS_BKT = WS_CNT + 224 * 1024;
constexpr int NT_IN = 54;
constexpr int WINT_ROWS = NT_IN * 256;

struct Params {
    const float* x; const float* mem; const int* positions; const float* rel_bias; const float* norm_g; const float* mem_norm_g;
    const float* w_in; const float* a_q_norm_g; const float* a_k_norm_g; const float* b_q_lat_norm_g; const float* b_kv_lat_norm_g;
    const float* w_b_uq; const float* w_b_ukv; const float* b_q_norm_g; const float* b_k_norm_g; const float* w_mem_kv;
    const float* c_q_norm_g; const float* c_k_norm_g; const float* w_branch; const float* w_out;
    char* ws; char* dout;
    int phase_lo, phase_hi;
};

__device__ __forceinline__ int opaque_tid() { int t = threadIdx.x; asm volatile("" : "+v"(t)); return t; }
typedef float f32x2_cv __attribute__((ext_vector_type(2)));
typedef __bf16 bf16x2_cv __attribute__((ext_vector_type(2)));
__device__ __forceinline__ unsigned cvtpk_b(float lo, float hi) { f32x2_cv v = {lo, hi}; bf16x2_cv r = __builtin_convertvector(v, bf16x2_cv); return *reinterpret_cast<unsigned*>(&r); }
#define DPP_F(v, ctrl) __int_as_float(__builtin_amdgcn_update_dpp(0, __float_as_int(v), (ctrl), 0xf, 0xf, true))
__device__ __forceinline__ float row_sum16(float v) { v += DPP_F(v, 0xB1); v += DPP_F(v, 0x4E); v += DPP_F(v, 0x141); v += DPP_F(v, 0x140); return v; }
__device__ __forceinline__ float wave_sum32(float v) {
    v = row_sum16(v);
    const auto r = __builtin_amdgcn_permlane16_swap(__float_as_uint(v), __float_as_uint(v), false, false);
    return __uint_as_float(r[0]) + __uint_as_float(r[1]);
}
__device__ __forceinline__ float wave_sum64(float v) {
    v = wave_sum32(v);
    const auto r = __builtin_amdgcn_permlane32_swap(__float_as_uint(v), __float_as_uint(v), false, false);
    return __uint_as_float(r[0]) + __uint_as_float(r[1]);
}
__device__ __forceinline__ float xchg_xor4(float v) {
    const int a = __builtin_amdgcn_update_dpp(0, __float_as_int(v), 0x114, 0xf, 0xa, false);
    return __int_as_float(__builtin_amdgcn_update_dpp(a, __float_as_int(v), 0x104, 0xf, 0x5, false));
}
__device__ __forceinline__ float max_xor16_32(float v) {
    auto r = __builtin_amdgcn_permlane16_swap(__float_as_uint(v), __float_as_uint(v), false, false);
    v = fmaxf(__uint_as_float(r[0]), __uint_as_float(r[1]));
    r = __builtin_amdgcn_permlane32_swap(__float_as_uint(v), __float_as_uint(v), false, false);
    return fmaxf(__uint_as_float(r[0]), __uint_as_float(r[1]));
}
__device__ __forceinline__ float sum_xor16_32(float v) {
    auto r = __builtin_amdgcn_permlane16_swap(__float_as_uint(v), __float_as_uint(v), false, false);
    v = __uint_as_float(r[0]) + __uint_as_float(r[1]);
    r = __builtin_amdgcn_permlane32_swap(__float_as_uint(v), __float_as_uint(v), false, false);
    return __uint_as_float(r[0]) + __uint_as_float(r[1]);
}
__device__ __forceinline__ unsigned cvtpk(float lo, float hi) {
    unsigned r; asm volatile("v_cvt_pk_bf16_f32 %0, %1, %2" : "=v"(r) : "v"(lo), "v"(hi)); return r;
}

__device__ __forceinline__ int win_srccol(int n) {
    if (n < 3584) return n;
    if (n < 3840) { int j = n - 3584; if (j < 80) return 3584 + j; if (j < 144) return 4432 + (j - 80); return -1; }
    if (n < 4352) return 3664 + (n - 3840);
    if (n < 4608) return 4176 + (n - 4352);
    return 4496 + (n - 4608);
}
__device__ __forceinline__ int wuq_srccol(int n) {
    int h = n >> 8, j = n & 255;
    if (j < 128) return h * 192 + j;
    if (j < 192) { int p = j - 128, blk = p >> 5, within = p & 31, second = within >> 4, jj = blk * 16 + (within & 15);
        return h * 192 + 128 + second * 32 + jj; }
    return -1;
}
__device__ __forceinline__ void phase_prep(const Params& p) {
    extern __shared__ __attribute__((aligned(16))) char smem[];
    int tid = opaque_tid(); int wid = tid >> 6, lane = tid & 63;
    for (int r = blockIdx.x * 8 + wid; r < SEQ + NMEM; r += gridDim.x * 8) {
        const float* src; const float* g; u16* dst;
        if (r < SEQ) { src = p.x + (size_t)r * DM; g = p.norm_g; dst = (u16*)(p.ws + WS_H) + (size_t)r * DM; }
        else { src = p.mem + (size_t)(r - SEQ) * DM; g = p.mem_norm_g; dst = (u16*)(p.ws + WS_HM) + (size_t)(r - SEQ) * DM; }
        f32x4 v[8]; float ss = 0.f;
#pragma unroll
        for (int i = 0; i < 8; ++i) { v[i] = __builtin_nontemporal_load(((const f32x4*)src) + lane + 64 * i); ss += v[i][0] * v[i][0] + v[i][1] * v[i][1] + v[i][2] * v[i][2] + v[i][3] * v[i][3]; }
        ss = wave_sum64(ss);
        const float rinv = rsqrtf(ss / (float)DM + EPS);
#pragma unroll
        for (int i = 0; i < 8; ++i) { f32x4 gg = ((const f32x4*)g)[lane + 64 * i];
            const float h0 = v[i][0] * rinv * gg[0], h1 = v[i][1] * rinv * gg[1], h2 = v[i][2] * rinv * gg[2], h3 = v[i][3] * rinv * gg[3];
            int w8 = 0; w8 = __builtin_amdgcn_cvt_pk_fp8_f32(h0, h1, w8, false); w8 = __builtin_amdgcn_cvt_pk_fp8_f32(h2, h3, w8, true);
            if (r < SEQ) { u32x2 w = {cvtpk(h0, h1), cvtpk(h2, h3)};
                *(u32x2*)(dst + 4 * (lane + 64 * i)) = w;
                *(int*)(p.dout + DO_H8 + (size_t)r * DM + 4 * (lane + 64 * i)) = w8; }
            else *(int*)(p.ws + WS_HM + (size_t)(r - SEQ) * DM + 4 * (lane + 64 * i)) = w8; }
    }
    {
        tid = opaque_tid();
        if (blockIdx.x == 0 && tid < 128) ((unsigned char*)(p.ws + WS_BKT))[tid] = (unsigned char)t5_bucket(tid);
        float* cs = (float*)(p.ws + WS_COS); float* sn = (float*)(p.ws + WS_SIN);
        for (int i = blockIdx.x * 512 + tid; i < SEQ * 32; i += gridDim.x * 512) {
            int t = i >> 5, j = i & 31;
            float inv_freq = 1.0f / powf(10000.f, (float)(2 * j) / 64.f);
            float ang = (float)p.positions[t] * inv_freq;
            cs[i] = cosf(ang); sn[i] = sinf(ang);
        }
    }
    constexpr int T0 = 32 * 216, T1 = T0 + 8 * 32, T2 = T1 + 4 * 32, T3 = T2 + 32 * 32, T4 = T3 + 3 * 16 * 32, T5 = T4 + 32 * 32;
    tid = opaque_tid(); wid = __builtin_amdgcn_readfirstlane(tid >> 6); lane = tid & 63;
    for (int T = blockIdx.x * 8 + wid; T < T5; T += gridDim.x * 8) {
        const float* W; int ldw, K, kt, mode = 0; const float* gs = nullptr; u16* dst; float f8s = 0.f;
        int tt;
        if (T < T0) { tt = T; W = p.w_in; ldw = INW; K = 2048; kt = 32; mode = 1; dst = (u16*)(p.ws + WS_WINT); }
        else if (T < T1) { tt = T - T0; W = p.w_b_uq; ldw = 1536; K = 512; kt = 8; mode = 2; gs = p.b_q_lat_norm_g; dst = (u16*)(p.ws + WS_WUQT); }
        else if (T < T2) { tt = T - T1; W = p.w_b_ukv; ldw = 2048; K = 256; kt = 4; gs = p.b_kv_lat_norm_g; dst = (u16*)(p.ws + WS_WUKVT); }
        else if (T < T3) { tt = T - T2; W = p.w_mem_kv; ldw = 2048; K = 2048; kt = 32; dst = (u16*)(p.ws + WS_WMEMT); f8s = GATE_W_SCALE; }
        else if (T < T4) { tt = T - T3; int n = tt / 512; tt -= n * 512; W = p.w_branch + (size_t)n * 1024 * DM; ldw = DM; K = 1024; kt = 16;
                           dst = (u16*)(p.ws + WS_WBRT + (size_t)n * DM * 1024); f8s = WBR8_SCALE; }
        else { tt = T - T4; W = p.w_out; ldw = DM; K = 2048; kt = 32; dst = (u16*)(p.ws + WS_WOUTT); f8s = WOUT8_SCALE; }
        const int k0 = (tt % kt) * 64, n0 = (tt / kt) * 64, n = n0 + lane;
        int sc = n; if (mode == 1) sc = win_srccol(n); else if (mode == 2) sc = wuq_srccol(n);
        const float* src_p = W + (size_t)k0 * ldw + (sc >= 0 ? sc : 0);
        float v[64];
#pragma unroll
        for (int k = 0; k < 64; ++k) v[k] = __builtin_nontemporal_load(src_p + (size_t)k * ldw);
        if (sc < 0) {
#pragma unroll
            for (int k = 0; k < 64; ++k) v[k] = 0.f;
        }
        if (gs) {
#pragma unroll
            for (int k = 0; k < 64; ++k) v[k] *= gs[k0 + k];
        }
        const bool silu8 = (mode == 1) && ((n0 >= 1536 && n0 < 2560) || (n0 >= 4608 && n0 < 5632) || (n0 >= 6656 && n0 < 7680));
        const bool q8 = (mode == 1) && (n0 < 1024 || (n0 >= 5632 && n0 < 6656));
        const bool kv8 = (mode == 1) && (n0 >= 1024 && n0 < 1536);
        if ((mode == 1 && n0 >= 7680) || silu8 || q8 || kv8 || f8s > 0.f) {
            const int srow = (n0 < 2560) ? (n - 1536) : (n0 < 5632 ? 1024 + (n - 4608) : 2048 + (n - 6656));
            const int qrow8 = (n0 < 1024) ? n : 1024 + (n - 5632);
            char* dp8 = (f8s > 0.f) ? ((char*)dst + (size_t)n * K + k0) : kv8 ? (p.ws + WS_WKV8 + (size_t)(n - 1024) * 2048 + k0) : (q8 ? (p.ws + WS_WQ8 + (size_t)qrow8 * 2048 + k0) : (silu8 ? (p.ws + WS_WS8 + (size_t)srow * 2048 + k0) : (p.ws + WS_WG8 + (size_t)(n - 7680) * 2048 + k0)));
            const float GS = (f8s > 0.f) ? f8s : GATE_W_SCALE;
#pragma unroll
            for (int k16 = 0; k16 < 4; ++k16) { int q[4];
#pragma unroll
                for (int j = 0; j < 4; ++j) { int w8 = 0; w8 = __builtin_amdgcn_cvt_pk_fp8_f32(v[16 * k16 + 4 * j] * GS, v[16 * k16 + 4 * j + 1] * GS, w8, false);
                    w8 = __builtin_amdgcn_cvt_pk_fp8_f32(v[16 * k16 + 4 * j + 2] * GS, v[16 * k16 + 4 * j + 3] * GS, w8, true); q[j] = w8; }
                *(u32x4*)(dp8 + 16 * k16) = (u32x4){(unsigned)q[0], (unsigned)q[1], (unsigned)q[2], (unsigned)q[3]}; }
            continue;
        }
        u16* dp = dst + (size_t)n * K + k0;
#pragma unroll
        for (int k8 = 0; k8 < 8; ++k8) { u32x4 w4 = {cvtpk(v[8 * k8 + 0], v[8 * k8 + 1]), cvtpk(v[8 * k8 + 2], v[8 * k8 + 3]), cvtpk(v[8 * k8 + 4], v[8 * k8 + 5]), cvtpk(v[8 * k8 + 6], v[8 * k8 + 7])};
            *(u32x4*)(dp + 8 * k8) = w4; }
    }
}

constexpr int G_HT = 128 * 64;
__device__ __forceinline__ int g_lds_byte(int r, int c) { int st = (r >> 4) * 2 + (c >> 5), rr = r & 15, cc = c & 31, ob = rr * 64 + cc * 2; return st * 1024 + (ob ^ (((ob >> 9) & 1) << 5)); }
__device__ __forceinline__ void g_stage_rc(int b, int& R, int& C) { int st = b / 1024, sb = b % 1024, swz = sb ^ (((sb >> 9) & 1) << 5); R = (st >> 1) * 16 + swz / 64; C = (st & 1) * 32 + (swz % 64) / 2; }

typedef int i32x8 __attribute__((ext_vector_type(8)));
template <bool FP8>
__device__ __forceinline__ void gemm_kloop(const u16* __restrict__ A, const u16* __restrict__ Bt, const int K, const int brow, const int bcol,
                                           f32x4 (&acc)[2][2][4][2]) {
    extern __shared__ __attribute__((aligned(16))) char smem[];
    u16* shm = (u16*)smem;
#define SA(b, h) (shm + ((b) * 2 + (h)) * G_HT)
#define SB(b, h) (shm + (4 + (b) * 2 + (h)) * G_HT)
#define STAGE(P, RS, br, kt) do { const int _so = ((br) * K + (kt) * 64) * 2; \
    __builtin_amdgcn_raw_ptr_buffer_load_lds(RS, (__attribute__((address_space(3))) void*)((char*)(P) + wv_ * 1024), 16, voff0, _so, 0, 0); \
    __builtin_amdgcn_raw_ptr_buffer_load_lds(RS, (__attribute__((address_space(3))) void*)((char*)(P) + wv_ * 1024 + 8192), 16, voff1, _so, 0, 0); } while (0)
#define LDA(dst, b, h) do { if constexpr (FP8) { for (int m = 0; m < 4; ++m) { \
      const u32x4 lo_ = *reinterpret_cast<const u32x4*>((char*)SA(b, h) + g_lds_byte(wr * 64 + m * 16 + fr, fq * 8)); \
      const u32x4 hi_ = *reinterpret_cast<const u32x4*>((char*)SA(b, h) + g_lds_byte(wr * 64 + m * 16 + fr, 32 + fq * 8)); \
      dst##8[m] = __builtin_shufflevector(lo_, hi_, 0, 1, 2, 3, 4, 5, 6, 7); } } \
    else { for (int m = 0; m < 4; ++m) for (int k = 0; k < 2; ++k) \
      dst[m][k] = *reinterpret_cast<const bf16x8*>((char*)SA(b, h) + g_lds_byte(wr * 64 + m * 16 + fr, k * 32 + fq * 8)); } } while (0)
#define LDB(dst, b, h) do { if constexpr (FP8) { for (int n = 0; n < 2; ++n) { \
      const u32x4 lo_ = *reinterpret_cast<const u32x4*>((char*)SB(b, h) + g_lds_byte(wc * 32 + n * 16 + fr, fq * 8)); \
      const u32x4 hi_ = *reinterpret_cast<const u32x4*>((char*)SB(b, h) + g_lds_byte(wc * 32 + n * 16 + fr, 32 + fq * 8)); \
      dst##8[n] = __builtin_shufflevector(lo_, hi_, 0, 1, 2, 3, 4, 5, 6, 7); } } \
    else { for (int n = 0; n < 2; ++n) for (int k = 0; k < 2; ++k) \
      dst[n][k] = *reinterpret_cast<const bf16x8*>((char*)SB(b, h) + g_lds_byte(wc * 32 + n * 16 + fr, k * 32 + fq * 8)); } } while (0)
#define MMA(ai, bj, At_, Bt_) do { __builtin_amdgcn_s_setprio(1); \
    if constexpr (FP8) { for (int m = 0; m < 4; ++m) for (int n = 0; n < 2; ++n) \
        asm volatile("s_nop 1\n\tv_mfma_scale_f32_16x16x128_f8f6f4 %0, %1, %2, %0, %3, %3 op_sel_hi:[0,0,0]" \
                     : "+v"(acc[ai][bj][m][n]) : "v"(At_##8[m]), "v"(Bt_##8[n]), "v"(sc8_)); } \
    else { for (int m = 0; m < 4; ++m) for (int n = 0; n < 2; ++n) for (int k = 0; k < 2; ++k) \
      acc[ai][bj][m][n] = __builtin_amdgcn_mfma_f32_16x16x32_bf16(At_[m][k], Bt_[n][k], acc[ai][bj][m][n], 0, 0, 0); } \
      \
    asm volatile("" :: "v"(acc[ai][bj][0][0]), "v"(acc[ai][bj][0][1]), "v"(acc[ai][bj][1][0]), "v"(acc[ai][bj][1][1]), \
                      "v"(acc[ai][bj][2][0]), "v"(acc[ai][bj][2][1]), "v"(acc[ai][bj][3][0]), "v"(acc[ai][bj][3][1])); \
    __builtin_amdgcn_s_setprio(0); } while (0)
#define WAIT_V(n) asm volatile("s_waitcnt vmcnt(" #n ")" ::: "memory")
#define WAIT_L(n) asm volatile("s_waitcnt lgkmcnt(" #n ")" ::: "memory")
#define BAR __builtin_amdgcn_s_barrier()
#define SCHED __builtin_amdgcn_sched_barrier(0)
    const int tid_ = opaque_tid();
    const int wv_ = __builtin_amdgcn_readfirstlane(tid_ >> 6);
    const int wid = tid_ >> 6, lane = tid_ & 63, wr = wid >> 2, wc = wid & 3, fr = lane & 15, fq = lane >> 4;
#pragma unroll
    for (int a = 0; a < 2; ++a)
#pragma unroll
        for (int b = 0; b < 2; ++b)
#pragma unroll
            for (int m = 0; m < 4; ++m)
#pragma unroll
                for (int n = 0; n < 2; ++n) acc[a][b][m][n] = f32x4{0.f, 0.f, 0.f, 0.f};
    bf16x8 At[4][2], B0[2][2], B1[2][2];
    typedef unsigned u32x8 __attribute__((ext_vector_type(8)));
    u32x8 At8[4], B08[2], B18[2];
    int sc8_ = 0x7f7f7f7f; asm volatile("" : "+v"(sc8_));
    const int nt = K / 64;
    const __amdgpu_buffer_rsrc_t rsA = __builtin_amdgcn_make_buffer_rsrc((void*)A, (short)0, 0x7fffffff, 0x00020000);
    const __amdgpu_buffer_rsrc_t rsB = __builtin_amdgcn_make_buffer_rsrc((void*)Bt, (short)0, 0x7fffffff, 0x00020000);
    int voff0, voff1;
    { int _r, _c; g_stage_rc(tid_ * 16, _r, _c); voff0 = (_r * K + _c) * 2; g_stage_rc(tid_ * 16 + 8192, _r, _c); voff1 = (_r * K + _c) * 2; }
    STAGE(SB(0, 0), rsB, bcol, 0); STAGE(SA(0, 0), rsA, brow, 0);
    STAGE(SB(0, 1), rsB, bcol + 128, 0); STAGE(SA(0, 1), rsA, brow + 128, 0);
    if (wr == 1) BAR;
    WAIT_V(4); BAR;
    STAGE(SB(1, 0), rsB, bcol, 1); STAGE(SA(1, 0), rsA, brow, 1); STAGE(SB(1, 1), rsB, bcol + 128, 1);
    WAIT_V(6); BAR;
#define MMA_LO(ai, bj, At_, Bt_) MMA(ai, bj, At_, Bt_)
#define LDA_LO(dst, b, h) LDA(dst, b, h)
    for (int t = 0; t < nt - 2; t += 2) {
        int tq_ = tid_; asm volatile("" : "+v"(tq_));
        const int wid = tq_ >> 6, lane = tq_ & 63, wr = wid >> 2, wc = wid & 3, fr = lane & 15, fq = lane >> 4;
        LDB(B0, 0, 0); SCHED; LDA(At, 0, 0); STAGE(SA(1, 1), rsA, brow + 128, t + 1);
        WAIT_L(8); BAR; WAIT_L(0); MMA(0, 0, At, B0); BAR; SCHED;
        LDB(B1, 0, 1); STAGE(SB(0, 0), rsB, bcol, t + 2);
        BAR; WAIT_L(0); MMA(0, 1, At, B1); BAR;
        LDA_LO(At, 0, 1); STAGE(SA(0, 0), rsA, brow, t + 2);
        BAR; WAIT_L(0); MMA_LO(1, 0, At, B0); BAR; SCHED;
        STAGE(SB(0, 1), rsB, bcol + 128, t + 2);
        WAIT_V(6); BAR; MMA_LO(1, 1, At, B1); BAR;
        LDB(B0, 1, 0); SCHED; LDA(At, 1, 0); STAGE(SA(0, 1), rsA, brow + 128, t + 2);
        WAIT_L(8); BAR; WAIT_L(0); MMA(0, 0, At, B0); BAR; SCHED;
        LDB(B1, 1, 1); STAGE(SB(1, 0), rsB, bcol, t + 3);
        BAR; WAIT_L(0); MMA(0, 1, At, B1); BAR;
        LDA_LO(At, 1, 1); STAGE(SA(1, 0), rsA, brow, t + 3);
        BAR; WAIT_L(0); MMA_LO(1, 0, At, B0); BAR; SCHED;
        STAGE(SB(1, 1), rsB, bcol + 128, t + 3);
        WAIT_V(6); BAR; MMA_LO(1, 1, At, B1); BAR;
    }
    { LDB(B0, 0, 0); LDA(At, 0, 0); STAGE(SA(1, 1), rsA, brow + 128, nt - 1);
      BAR; WAIT_L(0); MMA(0, 0, At, B0); BAR;
      LDB(B1, 0, 1); BAR; WAIT_L(0); MMA(0, 1, At, B1); BAR;
      LDA_LO(At, 0, 1); WAIT_V(4); BAR; WAIT_L(0); MMA_LO(1, 0, At, B0); MMA_LO(1, 1, At, B1); BAR; }
    { LDB(B0, 1, 0); LDA(At, 1, 0); WAIT_V(2); BAR; WAIT_L(0); MMA(0, 0, At, B0); BAR;
      LDB(B1, 1, 1); WAIT_V(0); BAR; WAIT_L(0); MMA(0, 1, At, B1); BAR;
      LDA_LO(At, 1, 1); BAR; WAIT_L(0); MMA_LO(1, 0, At, B0); MMA_LO(1, 1, At, B1); BAR; }
    if constexpr (FP8) asm volatile("s_nop 15\n\ts_nop 15" ::: "memory");
    if (wr == 0) BAR;
#undef SA
#undef SB
#undef STAGE
#undef LDA
#undef LDB
#undef MMA
#undef MMA_LO
#undef LDA_LO
}

constexpr int EPT_LD = 260;
template <int AI>
__device__ __forceinline__ void acc_half_to_lds(const f32x4 (&acc)[2][2][4][2]) {
    extern __shared__ __attribute__((aligned(16))) char smem[];
    float* T = (float*)smem;
    const int tid_ = opaque_tid();
    const int wid = tid_ >> 6, lane = tid_ & 63, wr = wid >> 2, wc = wid & 3, fr = lane & 15, fq = lane >> 4;
    float* base = T + (wr * 64 + fq * 4) * EPT_LD + wc * 32 + fr;
#pragma unroll
    for (int bj = 0; bj < 2; ++bj)
#pragma unroll
        for (int m = 0; m < 4; ++m)
#pragma unroll
            for (int n = 0; n < 2; ++n)
#pragma unroll
                for (int j = 0; j < 4; ++j) base[(m * 16 + j) * EPT_LD + bj * 128 + n * 16] = acc[AI][bj][m][n][j];
}
__device__ __forceinline__ void store4_bf16(u16* p, float a, float b, float c, float d) { u32x2 w = {cvtpk(a, b), cvtpk(c, d)}; *(u32x2*)p = w; }
__device__ __forceinline__ void store4_fp8(unsigned char* p, float a, float b, float c, float d) { int w = 0; w = __builtin_amdgcn_cvt_pk_fp8_f32(a, b, w, false); w = __builtin_amdgcn_cvt_pk_fp8_f32(c, d, w, true); *(int*)p = w; }

enum { EP_RAW = 0, EP_SILU = 1, EP_SIGMOID = 2, EP_NORM128 = 3, EP_NORM256 = 4, EP_RAW_SS = 5, EP_MISC = 6 };

__device__ __forceinline__ void epi_rows_inproj(const int mode, const int grow0, u16* __restrict__ dst, const int ld, const int half_skip,
                                                const float* __restrict__ g, const float scale, float* __restrict__ ssout, const int ss_stride, const Params& p, const float prescale = 1.f, const bool k8 = false) {
    extern __shared__ __attribute__((aligned(16))) char smem[];
    const float* T = (const float*)smem;
    const int tid_ = opaque_tid();
    const int wid = tid_ >> 6, lane = tid_ & 63;
    const int col = lane * 4;
    f32x4 gg = {1.f, 1.f, 1.f, 1.f};
    if (mode == EP_NORM128) gg = *(const f32x4*)(g + (col & 127));
    else if (mode == EP_NORM256) gg = *(const f32x4*)(g + col);
#pragma unroll 1
    for (int r4 = 0; r4 < 4; ++r4) {
        const int lr0 = wid * 16 + r4 * 4; const size_t row0 = (size_t)(grow0 + lr0);
        f32x4 v[4];
#pragma unroll
        for (int u = 0; u < 4; ++u) { v[u] = *(const f32x4*)(T + (lr0 + u) * EPT_LD + col); v[u][0] *= prescale; v[u][1] *= prescale; v[u][2] *= prescale; v[u][3] *= prescale; }
        if (mode == EP_MISC) {
            u16* IK = (u16*)(p.ws + WS_IK); float* IW = (float*)(p.ws + WS_IW); float* BKPE = (float*)(p.ws + WS_BKPE); float* PESS = (float*)(p.ws + WS_PESS);
            const bool pe = (lane >= 20 && lane < 36);
#pragma unroll
            for (int u = 0; u < 4; ++u) {
                const size_t row = row0 + u;
                float ss = pe ? (v[u][0] * v[u][0] + v[u][1] * v[u][1] + v[u][2] * v[u][2] + v[u][3] * v[u][3]) : 0.f;
                ss = wave_sum64(ss);
                if (lane < 16) store4_bf16(IK + row * 64 + col, v[u][0], v[u][1], v[u][2], v[u][3]);
                else if (lane < 20) *(f32x4*)(IW + row * 16 + (col - 64)) = v[u];
                else if (lane < 36) *(f32x4*)(BKPE + row * 64 + (col - 80)) = v[u];
                if (lane == 0) PESS[row] = ss;
            }
            continue;
        }
        if (mode == EP_SILU) {
#pragma unroll
            for (int u = 0; u < 4; ++u) { v[u][0] = silu_f(v[u][0]); v[u][1] = silu_f(v[u][1]); v[u][2] = silu_f(v[u][2]); v[u][3] = silu_f(v[u][3]); }
        } else if (mode == EP_SIGMOID) {
#pragma unroll
            for (int u = 0; u < 4; ++u) { v[u][0] = sigmoid_f(v[u][0]); v[u][1] = sigmoid_f(v[u][1]); v[u][2] = sigmoid_f(v[u][2]); v[u][3] = sigmoid_f(v[u][3]); }
        } else if (mode >= EP_NORM128) {
            float ss[4];
#pragma unroll
            for (int u = 0; u < 4; ++u) ss[u] = v[u][0] * v[u][0] + v[u][1] * v[u][1] + v[u][2] * v[u][2] + v[u][3] * v[u][3];
            if (mode == EP_NORM128) {
#pragma unroll
                for (int u = 0; u < 4; ++u) ss[u] = wave_sum32(ss[u]);
#pragma unroll
                for (int u = 0; u < 4; ++u) { const float rinv = rsqrtf(ss[u] * (1.f / 128.f) + EPS) * scale; v[u][0] *= rinv * gg[0]; v[u][1] *= rinv * gg[1]; v[u][2] *= rinv * gg[2]; v[u][3] *= rinv * gg[3]; }
            } else {
#pragma unroll
                for (int u = 0; u < 4; ++u) ss[u] = wave_sum64(ss[u]);
                if (mode == EP_NORM256) {
#pragma unroll
                    for (int u = 0; u < 4; ++u) { const float rinv = rsqrtf(ss[u] * (1.f / 256.f) + EPS) * scale; v[u][0] *= rinv * gg[0]; v[u][1] *= rinv * gg[1]; v[u][2] *= rinv * gg[2]; v[u][3] *= rinv * gg[3]; }
                } else if (lane == 0) {
#pragma unroll
                    for (int u = 0; u < 4; ++u) ssout[(row0 + u) * ss_stride] = ss[u];
                }
            }
        }
        if (mode == EP_SIGMOID) {
#pragma unroll
            for (int u = 0; u < 4; ++u) { int w8 = 0; w8 = __builtin_amdgcn_cvt_pk_fp8_f32(v[u][0] * G8_SCALE, v[u][1] * G8_SCALE, w8, false); w8 = __builtin_amdgcn_cvt_pk_fp8_f32(v[u][2] * G8_SCALE, v[u][3] * G8_SCALE, w8, true);
                __builtin_nontemporal_store(w8, (int*)((unsigned char*)dst + (row0 + u) * ld + col)); }
            continue;
        }
        if (k8) {
#pragma unroll
            for (int u = 0; u < 4; ++u) store4_fp8((unsigned char*)dst + (row0 + u) * KV_TOK + (lane >> 5) * KV_GRP + (col & 127), v[u][0] * K8_SCALE, v[u][1] * K8_SCALE, v[u][2] * K8_SCALE, v[u][3] * K8_SCALE);
            continue;
        }
        if (mode == EP_SILU || ((mode == EP_NORM128 || mode == EP_NORM256) && scale != 1.f)) {
#pragma unroll
            for (int u = 0; u < 4; ++u) { const u32x2 w = {cvtpk(v[u][0], v[u][1]), cvtpk(v[u][2], v[u][3])}; __builtin_nontemporal_store(w, (u32x2*)(dst + (row0 + u) * ld + col)); }
            continue;
        }
#pragma unroll
        for (int u = 0; u < 4; ++u) store4_bf16(dst + (row0 + u) * ld + col + (lane >= 32 ? half_skip : 0), v[u][0], v[u][1], v[u][2], v[u][3]);
    }
}

__device__ __forceinline__ void phase_inproj(const Params& p) {
    const int r = blockIdx.x, xcd = r & 7, slot = r >> 3, mi = slot >> 3, ni = slot & 7;
    const int pm = xcd * 4 + mi;
    f32x4 acc[2][2][4][2];
    {
        const int pn = ni + 10;
        gemm_kloop<false>((const u16*)(p.ws + WS_H), (const u16*)(p.ws + WS_WINT), DM, pm * 256, pn * 256, acc);
        int mode; size_t dsto; int ld; float scale = 1.f; size_t sso = 0; int ss_stride = 0;
        if (pn < 14) { mode = EP_RAW; dsto = WS_IQ + (pn - 10) * 512; ld = 1024; }
        else if (pn == 14) { mode = EP_MISC; dsto = 0; ld = 0; }
        else if (pn < 17) { mode = EP_RAW_SS; dsto = WS_BCQ + (pn - 15) * 512; ld = 512; sso = WS_LATQ + (pn - 15) * 4; ss_stride = 2; }
        else { mode = EP_RAW_SS; dsto = WS_BCKV; ld = 256; sso = WS_LATKV; ss_stride = 1; }
#pragma unroll 1
        for (int half = 0; half < 2; ++half) {
            __syncthreads();
            if (half == 0) acc_half_to_lds<0>(acc); else acc_half_to_lds<1>(acc);
            __syncthreads();
            epi_rows_inproj(mode, pm * 256 + half * 128, (u16*)(p.ws + dsto), ld, 0, nullptr, scale, (float*)(p.ws + sso), ss_stride, p);
        }
        __syncthreads();
    }
    const bool lowpm = pm < 4;
    const int nf8 = (lowpm || ni < 6) ? 6 : 5;
    const int f0 = (lowpm || ni < 6) ? ni * 6 : 36 + (ni - 6) * 5;
#pragma unroll 1
    for (int j = 0; j < nf8; ++j) {
        const int f = f0 + j;
        const u16* A8 = (const u16*)(p.dout + DO_H8); const u16* B8; u16* dst; int ld, mode, half_skip = 0, brow = pm * 256; const float* g = nullptr; float scale = 1.f; bool k8 = false;
        if (f < 24) { B8 = (const u16*)(p.ws + WS_WG8) + (size_t)f * 256 * 1024; dst = (u16*)(p.ws + WS_G + f * 256); ld = 6144; mode = EP_SIGMOID; }
        else if (f < 36) { const int s8 = f - 24; B8 = (const u16*)(p.ws + WS_WS8) + (size_t)s8 * 256 * 1024;
            dst = (u16*)(p.ws + (s8 < 4 ? WS_SZA : (s8 < 8 ? WS_SZB : WS_SZC))) + (s8 & 3) * 256; ld = 1024; mode = EP_SILU; }
        else if (f < 44) { const int q8 = f - 36; B8 = (const u16*)(p.ws + WS_WQ8) + (size_t)q8 * 256 * 1024; ld = 1024;
            if (q8 < 4) { dst = (u16*)(p.ws + WS_AQ) + q8 * 256; mode = EP_NORM128; g = p.a_q_norm_g; scale = A_SCALE; }
            else { dst = (u16*)(p.ws + WS_CQ) + (q8 - 4) * 256; mode = EP_NORM256; g = p.c_q_norm_g; scale = C_SCALE; } }
        else if (f == 44) { B8 = (const u16*)(p.ws + WS_WKV8); dst = (u16*)(p.ws + WS_KVA); ld = 0; mode = EP_NORM128; g = p.a_k_norm_g; k8 = true; }
        else if (f == 45) { B8 = (const u16*)(p.ws + WS_WKV8) + (size_t)256 * 1024; dst = (u16*)(p.ws + WS_KVA + 128); ld = KV_TOK / 2; half_skip = KV_GRP / 2 - 128; mode = EP_RAW; }
        else { const int mtile = pm * 2 + (f - 46);
            A8 = (const u16*)(p.ws + WS_HM); B8 = (const u16*)(p.ws + WS_WMEMT) + (size_t)mtile * 256 * 1024; brow = 0; ld = 1024;
            if (mtile < 4) { mode = EP_NORM256; dst = (u16*)(p.ws + WS_CK) + mtile * 256; g = p.c_k_norm_g; }
            else { mode = EP_RAW; dst = (u16*)(p.ws + WS_CV) + (mtile - 4) * 256; } }
        gemm_kloop<true>(A8, B8, DM / 2, brow, 0, acc);
#pragma unroll 1
        for (int half = 0; half < 2; ++half) {
            __syncthreads();
            if (half == 0) acc_half_to_lds<0>(acc); else acc_half_to_lds<1>(acc);
            __syncthreads();
            epi_rows_inproj(mode, brow + half * 128, dst, ld, half_skip, g, scale, nullptr, 0, p, 1.f / GATE_W_SCALE, k8);
        }
        __syncthreads();
    }
}

__device__ __forceinline__ void epi_rows_mla_q(const int grow0, const int h, const Params& p) {
    extern __shared__ __attribute__((aligned(16))) char smem[];
    const float* T = (const float*)smem;
    const int tid_ = opaque_tid(); const int wid = tid_ >> 6, lane = tid_ & 63, col = lane * 4;
    const float* LATQ = (const float*)(p.ws + WS_LATQ); const float* COS = (const float*)(p.ws + WS_COS); const float* SIN = (const float*)(p.ws + WS_SIN);
    unsigned char* QB = (unsigned char*)(p.dout + DO_QB) + (size_t)h * SEQ * 192;
    const int pp = (col - 128) & 63, blk = pp >> 5, within = pp & 31, second = within >> 4, jj = blk * 16 + (within & 15);
    f32x4 gg = {0.f, 0.f, 0.f, 0.f};
    if (lane < 32) gg = *(const f32x4*)(p.b_q_norm_g + col);
    else if (lane < 48) gg = *(const f32x4*)(p.b_q_norm_g + 128 + second * 32 + jj);
#pragma unroll 1
    for (int r4 = 0; r4 < 8; ++r4) {
        const int lr0 = wid * 16 + r4 * 2; const size_t t0 = (size_t)(grow0 + lr0);
        f32x4 v[2], cc[2], sn[2]; float rlat[2], ss[2];
#pragma unroll
        for (int u = 0; u < 2; ++u) { v[u] = *(const f32x4*)(T + (lr0 + u) * EPT_LD + col);
            rlat[u] = rsqrtf((LATQ[(t0 + u) * 2] + LATQ[(t0 + u) * 2 + 1]) * (1.f / 512.f) + EPS);
            if (lane >= 32 && lane < 48) { cc[u] = *(const f32x4*)(COS + (t0 + u) * 32 + jj); sn[u] = *(const f32x4*)(SIN + (t0 + u) * 32 + jj); } }
#pragma unroll
        for (int u = 0; u < 2; ++u) { v[u][0] *= rlat[u]; v[u][1] *= rlat[u]; v[u][2] *= rlat[u]; v[u][3] *= rlat[u];
            ss[u] = v[u][0] * v[u][0] + v[u][1] * v[u][1] + v[u][2] * v[u][2] + v[u][3] * v[u][3]; }
#pragma unroll
        for (int u = 0; u < 2; ++u) ss[u] = wave_sum64(ss[u]);
#pragma unroll
        for (int u = 0; u < 2; ++u) {
            const float rinv = rsqrtf(ss[u] * (1.f / 192.f) + EPS);
            v[u][0] *= rinv * gg[0]; v[u][1] *= rinv * gg[1]; v[u][2] *= rinv * gg[2]; v[u][3] *= rinv * gg[3];
            f32x4 o;
            o[0] = xchg_xor4(v[u][0]); o[1] = xchg_xor4(v[u][1]); o[2] = xchg_xor4(v[u][2]); o[3] = xchg_xor4(v[u][3]);
            if (lane >= 32 && lane < 48) {
#pragma unroll
                for (int e = 0; e < 4; ++e) v[u][e] = second ? (v[u][e] * cc[u][e] + o[e] * sn[u][e]) : (v[u][e] * cc[u][e] - o[e] * sn[u][e]);
            }
            if (lane < 48) { constexpr float QS = B_SCALE * MQ8_SCALE; store4_fp8(QB + (t0 + u) * 192 + col, v[u][0] * QS, v[u][1] * QS, v[u][2] * QS, v[u][3] * QS); }
        }
    }
}
__device__ __forceinline__ void epi_rows_mla_kv(const int grow0, const int h, const Params& p) {
    extern __shared__ __attribute__((aligned(16))) char smem[];
    const float* T = (const float*)smem;
    const int tid_ = opaque_tid(); const int wid = tid_ >> 6, lane = tid_ & 63, col = lane * 4;
    const float* LATKV = (const float*)(p.ws + WS_LATKV); const float* PESS = (const float*)(p.ws + WS_PESS); const float* BKPE = (const float*)(p.ws + WS_BKPE);
    const float* COS = (const float*)(p.ws + WS_COS); const float* SIN = (const float*)(p.ws + WS_SIN);
    unsigned char* KB = (unsigned char*)(p.dout + DO_KB) + (size_t)h * SEQ * 192;
    u16* VB = (u16*)(p.dout + DO_VB) + (size_t)h * SEQ * 128;
    f32x4 gg = {1.f, 1.f, 1.f, 1.f};
    if (lane < 32) gg = *(const f32x4*)(p.b_k_norm_g + col);
    const int jj = (lane & 7) * 4;
    const f32x4 g1 = *(const f32x4*)(p.b_k_norm_g + 128 + jj), g2 = *(const f32x4*)(p.b_k_norm_g + 160 + jj);
#pragma unroll 1
    for (int r4 = 0; r4 < 8; ++r4) {
        const int lr0 = wid * 16 + r4 * 2; const size_t t0 = (size_t)(grow0 + lr0);
        f32x4 v[2], x1[2], x2[2], cc[2], sn[2]; float rlat[2], ss[2], pess[2];
#pragma unroll
        for (int u = 0; u < 2; ++u) { v[u] = *(const f32x4*)(T + (lr0 + u) * EPT_LD + col);
            rlat[u] = rsqrtf(LATKV[t0 + u] * (1.f / 256.f) + EPS); pess[u] = PESS[t0 + u];
            if (lane < 8) { x1[u] = *(const f32x4*)(BKPE + (t0 + u) * 64 + jj); x2[u] = *(const f32x4*)(BKPE + (t0 + u) * 64 + 32 + jj);
                cc[u] = *(const f32x4*)(COS + (t0 + u) * 32 + jj); sn[u] = *(const f32x4*)(SIN + (t0 + u) * 32 + jj); } }
#pragma unroll
        for (int u = 0; u < 2; ++u) { v[u][0] *= rlat[u]; v[u][1] *= rlat[u]; v[u][2] *= rlat[u]; v[u][3] *= rlat[u];
            ss[u] = v[u][0] * v[u][0] + v[u][1] * v[u][1] + v[u][2] * v[u][2] + v[u][3] * v[u][3]; }
#pragma unroll
        for (int u = 0; u < 2; ++u) ss[u] = wave_sum32(ss[u]);
#pragma unroll
        for (int u = 0; u < 2; ++u) {
            const size_t t = t0 + u;
            const float rinv = rsqrtf((ss[u] + pess[u]) * (1.f / 192.f) + EPS);
            const float rk = rinv * MK8_SCALE;
            if (lane < 32) store4_fp8(KB + t * 192 + col, v[u][0] * rk * gg[0], v[u][1] * rk * gg[1], v[u][2] * rk * gg[2], v[u][3] * rk * gg[3]);
            else store4_bf16(VB + t * 128 + (col - 128), v[u][0], v[u][1], v[u][2], v[u][3]);
            if (lane < 8) {
                float o1[4], o2[4];
#pragma unroll
                for (int e = 0; e < 4; ++e) { const float a = x1[u][e] * rinv * g1[e], b = x2[u][e] * rinv * g2[e]; o1[e] = a * cc[u][e] - b * sn[u][e]; o2[e] = b * cc[u][e] + a * sn[u][e]; }
                store4_fp8(KB + t * 192 + 128 + rope_phys(jj, 0), o1[0] * MK8_SCALE, o1[1] * MK8_SCALE, o1[2] * MK8_SCALE, o1[3] * MK8_SCALE);
                store4_fp8(KB + t * 192 + 128 + rope_phys(jj, 1), o2[0] * MK8_SCALE, o2[1] * MK8_SCALE, o2[2] * MK8_SCALE, o2[3] * MK8_SCALE);
            }
        }
    }
}
__device__ __forceinline__ void phase_mla_up(const Params& p) {
    const int r = blockIdx.x, xcd = r & 7, slot = r >> 3, pm = xcd * 4 + (slot >> 3), h = slot & 7;
    f32x4 acc[2][2][4][2];
#pragma unroll 1
    for (int which = 0; which < 2; ++which) {
        if (which == 0) gemm_kloop<false>((const u16*)(p.ws + WS_BCQ), (const u16*)(p.ws + WS_WUQT), 512, pm * 256, h * 256, acc);
        else gemm_kloop<false>((const u16*)(p.ws + WS_BCKV), (const u16*)(p.ws + WS_WUKVT), 256, pm * 256, h * 256, acc);
#pragma unroll 1
        for (int half = 0; half < 2; ++half) {
            __syncthreads();
            if (half == 0) acc_half_to_lds<0>(acc); else acc_half_to_lds<1>(acc);
            __syncthreads();
            if (which == 0) epi_rows_mla_q(pm * 256 + half * 128, h, p); else epi_rows_mla_kv(pm * 256 + half * 128, h, p);
        }
        __syncthreads();
    }
}

__device__ __forceinline__ void epi_rows_merge(const int grow0, const int pd, const int n, const Params& p) {
    extern __shared__ __attribute__((aligned(16))) char smem[];
    const float* T = (const float*)smem;
    const int tid_ = opaque_tid(); const int wid = tid_ >> 6, lane = tid_ & 63, col = lane * 4;
    const unsigned char* G = (const unsigned char*)(p.ws + WS_G); u16* M = (u16*)(p.ws + WS_MERGED);
#pragma unroll 1
    for (int r4 = 0; r4 < 4; ++r4) {
        const int lr0 = wid * 16 + r4 * 4; const size_t t0 = (size_t)(grow0 + lr0);
        f32x4 v[4]; unsigned gw[4]; u32x2 mw[4];
#pragma unroll
        for (int u = 0; u < 4; ++u) { v[u] = *(const f32x4*)(T + (lr0 + u) * EPT_LD + col); gw[u] = __builtin_nontemporal_load((const unsigned*)(G + (t0 + u) * 6144 + n * 2048 + pd * 256 + col));
            if (n > 0) mw[u] = *(const u32x2*)(M + (t0 + u) * DM + pd * 256 + col); }
#pragma unroll
        for (int u = 0; u < 4; ++u) {
            constexpr float YS = 1.f / (U8_SCALE * WBR8_SCALE * G8_SCALE);
            const auto glo = __builtin_amdgcn_cvt_pk_f32_fp8((int)gw[u], false), ghi = __builtin_amdgcn_cvt_pk_f32_fp8((int)gw[u], true);
            v[u][0] *= YS * glo[0]; v[u][1] *= YS * glo[1]; v[u][2] *= YS * ghi[0]; v[u][3] *= YS * ghi[1];
            if (n > 0) { v[u][0] += __uint_as_float(mw[u][0] << 16); v[u][1] += __uint_as_float(mw[u][0] & 0xffff0000u); v[u][2] += __uint_as_float(mw[u][1] << 16); v[u][3] += __uint_as_float(mw[u][1] & 0xffff0000u); }
        }
#pragma unroll
        for (int u = 0; u < 4; ++u) {
            if (n < 2) store4_bf16(M + (t0 + u) * DM + pd * 256 + col, v[u][0], v[u][1], v[u][2], v[u][3]);
            else store4_fp8((unsigned char*)(p.ws + WS_M8) + (t0 + u) * DM + pd * 256 + col, v[u][0] * M8_SCALE, v[u][1] * M8_SCALE, v[u][2] * M8_SCALE, v[u][3] * M8_SCALE);
        }
    }
}
__device__ __forceinline__ void phase_merge(const Params& p) {
    const int r = blockIdx.x, xcd = r & 7, slot = r >> 3, pm = xcd * 4 + (slot >> 3), pd = slot & 7;
    f32x4 acc[2][2][4][2];
#pragma unroll 1
    for (int n = 0; n < 3; ++n) {
        const u16* U = (const u16*)(p.ws + (n == 0 ? WS_UA : (n == 1 ? WS_UB : WS_UC)));
        gemm_kloop<true>(U, (const u16*)(p.ws + WS_WBRT + (size_t)n * DM * 1024), 512, pm * 256, pd * 256, acc);
#pragma unroll 1
        for (int half = 0; half < 2; ++half) {
            __syncthreads();
            if (half == 0) acc_half_to_lds<0>(acc); else acc_half_to_lds<1>(acc);
            __syncthreads();
            epi_rows_merge(pm * 256 + half * 128, pd, n, p);
        }
        __syncthreads();
    }
}
__device__ __forceinline__ void epi_rows_out(const int grow0, const int pd, const Params& p) {
    extern __shared__ __attribute__((aligned(16))) char smem[];
    const float* T = (const float*)smem;
    const int tid_ = opaque_tid(); const int wid = tid_ >> 6, lane = tid_ & 63, col = lane * 4;
    float* OUT = (float*)p.dout;
#pragma unroll 1
    for (int r4 = 0; r4 < 4; ++r4) {
        const int lr0 = wid * 16 + r4 * 4; const size_t t0 = (size_t)(grow0 + lr0);
        f32x4 v[4], xv[4];
#pragma unroll
        for (int u = 0; u < 4; ++u) { v[u] = *(const f32x4*)(T + (lr0 + u) * EPT_LD + col); xv[u] = __builtin_nontemporal_load((const f32x4*)(p.x + (t0 + u) * DM + pd * 256 + col)); }
#pragma unroll
        for (int u = 0; u < 4; ++u) { constexpr float OS = 1.f / (M8_SCALE * WOUT8_SCALE);
            v[u][0] = fmaf(v[u][0], OS, xv[u][0]); v[u][1] = fmaf(v[u][1], OS, xv[u][1]); v[u][2] = fmaf(v[u][2], OS, xv[u][2]); v[u][3] = fmaf(v[u][3], OS, xv[u][3]); __builtin_nontemporal_store(v[u], (f32x4*)(OUT + (t0 + u) * DM + pd * 256 + col)); }
    }
}
__device__ __forceinline__ void phase_out(const Params& p) {
    const int r = blockIdx.x, xcd = r & 7, slot = r >> 3, pm = xcd * 4 + (slot >> 3), pd = slot & 7;
    f32x4 acc[2][2][4][2];
    gemm_kloop<true>((const u16*)(p.ws + WS_M8), (const u16*)(p.ws + WS_WOUTT), DM / 2, pm * 256, pd * 256, acc);
#pragma unroll 1
    for (int half = 0; half < 2; ++half) {
        __syncthreads();
        if (half == 0) acc_half_to_lds<0>(acc); else acc_half_to_lds<1>(acc);
        __syncthreads();
        epi_rows_out(pm * 256 + half * 128, pd, p);
    }
    __syncthreads();
}

typedef short s16x4 __attribute__((ext_vector_type(4)));
constexpr float LOG2E = 1.4426950408889634f;
constexpr int MLA_KT = 12288, MLA_VT = 8192, MLA_GRP = MLA_KT + MLA_VT, MLA_BUF = 2 * MLA_GRP;
__device__ __forceinline__ int crow16(int r, int hi) { return (r & 3) + 8 * (r >> 2) + 4 * hi; }

constexpr int IDX_CAP = 1024, IDX_WAVE_LDS = 2 * IDX_CAP * 4 + 2 * IDX_CAP * 2 + 1024;
__device__ __forceinline__ unsigned ordk(unsigned b) { return (b & 0x80000000u) ? ~b : (b | 0x80000000u); }

#define DPP_SHL(v, n, oldv, bc) ((unsigned)__builtin_amdgcn_update_dpp((int)(oldv), (int)(v), 0x100 + (n), 0xf, 0xf, bc))
__device__ __forceinline__ unsigned wave_max_u32(unsigned m) {
    unsigned t;
    t = DPP_SHL(m, 1, 0u, true); m = t > m ? t : m;
    t = DPP_SHL(m, 2, 0u, true); m = t > m ? t : m;
    t = DPP_SHL(m, 4, 0u, true); m = t > m ? t : m;
    t = DPP_SHL(m, 8, 0u, true); m = t > m ? t : m;
    const unsigned a = __builtin_amdgcn_readlane(m, 0), b = __builtin_amdgcn_readlane(m, 16), c = __builtin_amdgcn_readlane(m, 32), d = __builtin_amdgcn_readlane(m, 48);
    const unsigned ab = a > b ? a : b, cd = c > d ? c : d;
    return ab > cd ? ab : cd;
}
__device__ __forceinline__ unsigned wave_min_u32(unsigned m) {
    unsigned t;
    t = DPP_SHL(m, 1, 0xffffffffu, false); m = t < m ? t : m;
    t = DPP_SHL(m, 2, 0xffffffffu, false); m = t < m ? t : m;
    t = DPP_SHL(m, 4, 0xffffffffu, false); m = t < m ? t : m;
    t = DPP_SHL(m, 8, 0xffffffffu, false); m = t < m ? t : m;
    const unsigned a = __builtin_amdgcn_readlane(m, 0), b = __builtin_amdgcn_readlane(m, 16), c = __builtin_amdgcn_readlane(m, 32), d = __builtin_amdgcn_readlane(m, 48);
    const unsigned ab = a < b ? a : b, cd = c < d ? c : d;
    return ab < cd ? ab : cd;
}
__device__ __forceinline__ int wave_suffix_sum(int s, const int lane) {
    int v = s;
    v += (int)DPP_SHL(v, 1, 0u, true); v += (int)DPP_SHL(v, 2, 0u, true); v += (int)DPP_SHL(v, 4, 0u, true); v += (int)DPP_SHL(v, 8, 0u, true);
    const int t1 = __builtin_amdgcn_readlane(v, 16), t2 = __builtin_amdgcn_readlane(v, 32), t3 = __builtin_amdgcn_readlane(v, 48);
    const int a3 = t3, a2 = t2 + t3, a1 = t1 + t2 + t3;
    return v + (lane < 16 ? a1 : (lane < 32 ? a2 : (lane < 48 ? a3 : 0)));
}
constexpr int IDX_KEEP = 320;
template<bool EXACT>
__device__ __forceinline__ float idx_prune(unsigned* lk, u16* li, unsigned* hist, const int n, const int lane, const float tau_q, const float smax_lane, const bool mine, int& n_out) {
    unsigned kk[16], ix[16];
#pragma unroll
    for (int j = 0; j < 16; ++j) { const int e = lane + 64 * j; const bool in = e < n; kk[j] = in ? lk[e] : 0u; ix[j] = in ? (unsigned)li[e] : 0u; }
#pragma unroll
    for (int j = 0; j < 16; ++j) kk[j] = (lane + 64 * j < n) ? ordk(kk[j]) : 0u;
    unsigned kmax = wave_max_u32(mine ? ordk(__float_as_uint(smax_lane)) : 0u), kmin;
    if (tau_q == -INFINITY) {
        kmin = 0xffffffffu;
#pragma unroll
        for (int j = 0; j < 16; ++j) if (lane + 64 * j < n) kmin = kk[j] < kmin ? kk[j] : kmin;
        kmin = wave_min_u32(kmin);
    } else kmin = ordk(__float_as_uint(tau_q));
    const unsigned range = kmax - kmin;
    int hib = range ? (32 - __builtin_clz(range)) : 0;
    unsigned pre = 0; int need = TOPK; bool first = true;
    const int hbase = (int)(uintptr_t)hist;
    while (hib > 0) {
        const int wbits = hib < 8 ? hib : 8, sh = hib - wbits;
        const unsigned dmask = (1u << wbits) - 1u;
        *(u32x4*)(hist + lane * 4) = (u32x4){0u, 0u, 0u, 0u};
#pragma unroll
        for (int j = 0; j < 16; ++j) {
            if (64 * j < n) { const unsigned rel = kk[j] - kmin;
                const bool match = (lane + 64 * j < n) && (first || ((hib < 32 ? (rel >> hib) : 0u) == (hib < 32 ? (pre >> hib) : 0u)));
                if (match) { const int ha = hbase + (int)(((rel >> sh) & dmask) << 2); const unsigned one = 1u; asm volatile("ds_add_u32 %0, %1" :: "v"(ha), "v"(one) : "memory"); } }
        }
        const u32x4 hv = *(const u32x4*)(hist + lane * 4);
        const int s = (int)(hv[0] + hv[1] + hv[2] + hv[3]);
        const int S = wave_suffix_sum(s, lane);
        const int above = S - s;
        const bool cross = (above < need) && (S >= need);
        const unsigned long long bm = __builtin_amdgcn_ballot_w64(cross);
        const int L = __ffsll((long long)bm) - 1;
        int dsel = 0, nneed = 0, hsel = 0, acc = above; bool found = false;
#pragma unroll
        for (int i = 3; i >= 0; --i) { const int hc = (int)hv[i];
            if (!found && acc + hc >= need) { dsel = lane * 4 + i; nneed = need - acc; hsel = hc; found = true; }
            acc += hc; }
        dsel = __builtin_amdgcn_readlane(dsel, L); nneed = __builtin_amdgcn_readlane(nneed, L);
        pre |= ((unsigned)dsel) << sh; need = nneed; hib = sh; first = false;
        if (!EXACT) {
            hsel = __builtin_amdgcn_readlane(hsel, L);
            const int nge = TOPK - nneed + hsel;
            if (nge <= IDX_KEEP && hib > 0) {
                const unsigned thr = kmin + pre;
                int outc = 0;
#pragma unroll
                for (int j = 0; j < 16; ++j) {
                    if (64 * j < n) {
                        const unsigned k = kk[j];
                        const bool keep = (lane + 64 * j < n) && k >= thr;
                        const unsigned long long bk = __builtin_amdgcn_ballot_w64(keep);
                        const int pos = outc + __popcll(bk & ((1ull << lane) - 1ull));
                        if (keep) { lk[pos] = (k & 0x80000000u) ? (k & 0x7fffffffu) : ~k; li[pos] = (u16)ix[j]; }
                        outc += __popcll(bk);
                    }
                }
                n_out = outc;
                const unsigned t1 = thr - 1u;
                return __uint_as_float((t1 & 0x80000000u) ? (t1 & 0x7fffffffu) : ~t1);
            }
        }
    }
    n_out = TOPK;
    const unsigned prefix = kmin + pre;
    int outc = 0, eqc = 0;
#pragma unroll
    for (int j = 0; j < 16; ++j) {
        if (64 * j < n) {
            const bool in = lane + 64 * j < n; const unsigned k = kk[j];
            const bool gt = in && k > prefix, eq = in && k == prefix;
            const unsigned long long beq = __builtin_amdgcn_ballot_w64(eq);
            const int eqr = eqc + __popcll(beq & ((1ull << lane) - 1ull));
            const bool keep = gt || (eq && eqr < need);
            const unsigned long long bk = __builtin_amdgcn_ballot_w64(keep);
            const int pos = outc + __popcll(bk & ((1ull << lane) - 1ull));
            if (keep) { lk[pos] = (k & 0x80000000u) ? (k & 0x7fffffffu) : ~k; li[pos] = (u16)ix[j]; }
            outc += __popcll(bk); eqc += __popcll(beq);
        }
    }
    const unsigned tb = (prefix & 0x80000000u) ? (prefix & 0x7fffffffu) : ~prefix;
    return __uint_as_float(tb);
}

constexpr int IDX_RING_OFF = 8 * IDX_WAVE_LDS;
__device__ __forceinline__ void idx_round(const Params& p, const int pr, const int pr_max, char* wlds, const int wid, const int lane) {
    extern __shared__ __attribute__((aligned(16))) char smem[];
    const int t0 = 2 * pr, c = lane & 31, hi = lane >> 5, tq = t0 + hi;
    int* SEL = (int*)(p.ws + WS_SEL); int* CNT = (int*)(p.ws + WS_CNT);
    const bool direct = (t0 + 1 < TOPK);
    if (direct) {
        for (int q = 0; q < 2; ++q) { const int t = t0 + q; for (int i = lane; i <= t; i += 64) SEL[(size_t)t * TOPK + i] = i; if (lane == 0) CNT[t] = t + 1; }
    }
    const int maxkeys = 2 * pr_max + 2;
    if (maxkeys <= TOPK) return;
    const int nch = (maxkeys + 127) >> 7;
    unsigned* lkA = (unsigned*)wlds; unsigned* lkB = lkA + IDX_CAP; u16* liA = (u16*)(lkB + IDX_CAP); u16* liB = liA + IDX_CAP; unsigned* hist = (unsigned*)(liB + IDX_CAP);
    unsigned* lk = hi ? lkB : lkA; u16* li = hi ? liB : liA;
    const u16* IQ = (const u16*)(p.ws + WS_IQ); const float* IW = (const float*)(p.ws + WS_IW);
    const __amdgpu_buffer_rsrc_t rs = __builtin_amdgcn_make_buffer_rsrc((void*)(p.ws + WS_IK), (short)0, 0x7fffffff, 0x00020000);
    bf16x8 af[4]; float w[16];
    if (!direct) {
        const int aq = (c >> 2) & 1, ah = (c & 3) + 4 * (c >> 3);
        const u16* ap = IQ + (size_t)(t0 + aq) * 1024 + ah * 64 + hi * 8;
#pragma unroll
        for (int s = 0; s < 4; ++s) af[s] = *(const bf16x8*)(ap + 16 * s);
        const f32x4* wp = (const f32x4*)(IW + (size_t)tq * 16);
#pragma unroll
        for (int i = 0; i < 4; ++i) { const f32x4 v = wp[i]; w[4 * i] = v[0]; w[4 * i + 1] = v[1]; w[4 * i + 2] = v[2]; w[4 * i + 3] = v[3]; }
    } else {
#pragma unroll
        for (int s = 0; s < 4; ++s) af[s] = (bf16x8){0, 0, 0, 0, 0, 0, 0, 0};
#pragma unroll
        for (int i = 0; i < 16; ++i) w[i] = 0.f;
    }
    asm volatile("s_waitcnt vmcnt(0)" : "+v"(af[0]), "+v"(af[1]), "+v"(af[2]), "+v"(af[3]) :: "memory");
    asm volatile("" : "+v"(w[0]), "+v"(w[1]), "+v"(w[2]), "+v"(w[3]), "+v"(w[4]), "+v"(w[5]), "+v"(w[6]), "+v"(w[7]));
    asm volatile("" : "+v"(w[8]), "+v"(w[9]), "+v"(w[10]), "+v"(w[11]), "+v"(w[12]), "+v"(w[13]), "+v"(w[14]), "+v"(w[15]));
    int voff[2];
#pragma unroll
    for (int i = 0; i < 2; ++i) { const int kl = (2 * wid + i) * 8 + (lane >> 3), cpos = lane & 7; voff[i] = kl * 128 + ((cpos ^ ((kl >> 1) & 7)) << 4); }
#define IDX_DMA(ch_) do { char* dst_ = smem + IDX_RING_OFF + ((ch_) % 3) * 16384; \
    _Pragma("unroll") for (int i = 0; i < 2; ++i) \
        __builtin_amdgcn_raw_ptr_buffer_load_lds(rs, (__attribute__((address_space(3))) void*)(dst_ + (2 * wid + i) * 1024), 16, voff[i], (ch_) * 16384, 0, 0); } while (0)
    int kadr[4];
    { const int f = (c >> 1) & 7;
#pragma unroll
      for (int s = 0; s < 4; ++s) kadr[s] = c * 128 + (((2 * s + hi) ^ f) << 4); }
    int cntA = 0, cntB = 0; float tau = -INFINITY, tauA = -INFINITY, tauB = -INFINITY, smax = -INFINITY;
    asm volatile("s_waitcnt vmcnt(0)" ::: "memory");
    __builtin_amdgcn_s_barrier();
    unsigned* flag = (unsigned*)(smem + IDX_RING_OFF + 49152);
    if (wid == 0 && lane < 3) flag[lane] = 0u;
    IDX_DMA(0);
    if (nch > 1) IDX_DMA(1);
    for (int ch = 0; ch < nch; ++ch) {
        if (ch + 1 < nch) asm volatile("s_waitcnt vmcnt(2)" ::: "memory"); else asm volatile("s_waitcnt vmcnt(0)" ::: "memory");
        asm volatile("s_waitcnt lgkmcnt(0)" ::: "memory");
        __builtin_amdgcn_s_barrier();
        if (ch + 2 < nch) IDX_DMA(ch + 2);
        {
            const unsigned fl = (ch > 0) ? flag[(ch + 2) % 3] : 0u;
            if (wid == 0 && lane == 0) flag[(ch + 1) % 3] = 0u;
            if (fl != 0u && !direct) {
                if (cntA > 512) { int no; tauA = idx_prune<false>(lkA, liA, hist, cntA, lane, tauA, smax, hi == 0, no); cntA = no; if (!hi) tau = tauA; }
                if (cntB > 512) { int no; tauB = idx_prune<false>(lkB, liB, hist, cntB, lane, tauB, smax, hi == 1, no); cntB = no; if (hi) tau = tauB; }
            }
        }
        if (!direct) {
            const char* buf = smem + IDX_RING_OFF + (ch % 3) * 16384;
#pragma unroll 1
            for (int tp = 0; tp < 2; ++tp) {
                const int key0 = ch * 128 + tp * 64;
                if (key0 > t0 + 1) break;
                f32x16 d0, d1;
#pragma unroll
                for (int r = 0; r < 16; ++r) { d0[r] = 0.f; d1[r] = 0.f; }
#pragma unroll
                for (int s = 0; s < 4; ++s) { const bf16x8 b0 = *(const bf16x8*)(buf + tp * 8192 + kadr[s]); const bf16x8 b1 = *(const bf16x8*)(buf + tp * 8192 + 4096 + kadr[s]);
                    d0 = __builtin_amdgcn_mfma_f32_32x32x16_bf16(af[s], b0, d0, 0, 0, 0);
                    d1 = __builtin_amdgcn_mfma_f32_32x32x16_bf16(af[s], b1, d1, 0, 0, 0); }
                f32x2_cv pa0[2] = {{0.f, 0.f}, {0.f, 0.f}}, pa1[2] = {{0.f, 0.f}, {0.f, 0.f}};
#pragma unroll
                for (int r = 0; r < 16; r += 2) {
                    const int i0 = __float_as_int(d0[r]), i1 = __float_as_int(d1[r]), j0 = __float_as_int(d0[r + 1]), j1 = __float_as_int(d1[r + 1]);
                    const f32x2_cv x0 = {__int_as_float(i0 > 0 ? i0 : 0), __int_as_float(j0 > 0 ? j0 : 0)}, x1 = {__int_as_float(i1 > 0 ? i1 : 0), __int_as_float(j1 > 0 ? j1 : 0)};
                    const f32x2_cv wv = {w[r], w[r + 1]};
                    pa0[(r >> 1) & 1] = __builtin_elementwise_fma(wv, x0, pa0[(r >> 1) & 1]); pa1[(r >> 1) & 1] = __builtin_elementwise_fma(wv, x1, pa1[(r >> 1) & 1]); }
                const f32x2_cv s0v = pa0[0] + pa0[1], s1v = pa1[0] + pa1[1];
                const float sc0 = s0v[0] + s0v[1], sc1 = s1v[0] + s1v[1];
#pragma unroll
                for (int hf = 0; hf < 2; ++hf) {
                    const float sc = hf ? sc1 : sc0;
                    const int key = key0 + hf * 32 + c;
                    const bool pass = (key <= tq) && (sc > tau);
                    const unsigned long long mask = __builtin_amdgcn_ballot_w64(pass);
                    if (mask != 0ull) {
                        const unsigned mA = (unsigned)mask, mB = (unsigned)(mask >> 32);
                        const unsigned mq = hi ? mB : mA;
                        const int pos = (hi ? cntB : cntA) + __popc(mq & ((1u << c) - 1u));
                        if (pass) { lk[pos] = __float_as_uint(sc); li[pos] = (u16)key; smax = fmaxf(smax, sc); }
                        cntA += __popc(mA); cntB += __popc(mB);
                    }
                }
            }
        }
        if ((cntA > IDX_CAP - 128 || cntB > IDX_CAP - 128) && lane == 0) flag[ch % 3] = 1u;
    }
#undef IDX_DMA
    if (!direct) {
        int no;
        if (cntA > TOPK) { idx_prune<true>(lkA, liA, hist, cntA, lane, tauA, smax, hi == 0, no); }
        if (cntB > TOPK) { idx_prune<true>(lkB, liB, hist, cntB, lane, tauB, smax, hi == 1, no); }
#pragma unroll
        for (int i = 0; i < 4; ++i) { SEL[(size_t)t0 * TOPK + lane + 64 * i] = (int)liA[lane + 64 * i]; SEL[(size_t)(t0 + 1) * TOPK + lane + 64 * i] = (int)liB[lane + 64 * i]; }
        if (lane == 0) { int tk = TOPK; asm volatile("" : "+v"(tk)); CNT[t0] = tk; CNT[t0 + 1] = tk; }
    }
}
__device__ __forceinline__ void phase_indexer(const Params& p) {
    extern __shared__ __attribute__((aligned(16))) char smem[];
    const int tid_ = opaque_tid();
    const int wid = __builtin_amdgcn_readfirstlane(tid_ >> 6), lane = tid_ & 63;
    char* wlds = smem + wid * IDX_WAVE_LDS;
    const int gw = blockIdx.x * 8 + wid;
    __syncthreads();
#pragma unroll 1
    for (int rnd = 0; rnd < 2; ++rnd) {
        const int pr = rnd ? gw : 4095 - gw, prmax = rnd ? (int)blockIdx.x * 8 + 7 : 4095 - (int)blockIdx.x * 8;
        idx_round(p, pr, prmax, wlds, wid, lane);
    }
    __syncthreads();
}

__device__ __forceinline__ float softmax_cols16(f32x4 (&S)[16]) {
    float mx = S[0][0];
#pragma unroll
    for (int kb = 0; kb < 16; ++kb)
#pragma unroll
        for (int i = 0; i < 4; ++i) mx = fmaxf(mx, S[kb][i]);
    mx = max_xor16_32(mx);
    const float mneg = -mx * LOG2E;
    float sum = 0.f;
#pragma unroll
    for (int kb = 0; kb < 16; ++kb)
#pragma unroll
        for (int i = 0; i < 4; ++i) { S[kb][i] = __builtin_amdgcn_exp2f(fmaf(S[kb][i], LOG2E, mneg)); sum += S[kb][i]; }
    sum = sum_xor16_32(sum);
    return sum;
}
__device__ __forceinline__ bf16x8 pack_p(const f32x4& a, const f32x4& b) {
    u32x4 w = {cvtpk(a[0], a[1]), cvtpk(a[2], a[3]), cvtpk(b[0], b[1]), cvtpk(b[2], b[3])};
    return *reinterpret_cast<bf16x8*>(&w);
}
#define TRRD16(dst, base, off) asm volatile("ds_read_b64_tr_b16 %0, %1 offset:%2" : "=&v"(dst) : "v"(base), "i"(off) : "memory")

constexpr int SP_KD = 8;
constexpr int SP_WAVE_LDS = 1024 + 2 * 8192;
constexpr int SP_RELB_OFF = 8 * SP_WAVE_LDS;
__device__ __forceinline__ void sp_item(const Params& p, const int t, const int g, char* wl, const float* relb_l, const int lane, const int (&selv)[4], const int cnt) {
    const unsigned char* bktab = (const unsigned char*)(relb_l + 256);
    u16* sel_l = (u16*)wl; unsigned char* bkt_l = (unsigned char*)(wl + 512); char* vtile = wl + 1024;
    const int i16 = lane & 15, c = lane >> 4;
    const __amdgpu_buffer_rsrc_t rs = __builtin_amdgcn_make_buffer_rsrc((void*)(p.ws + WS_KVA), (short)0, 0x7fffffff, 0x00020000);
#pragma unroll
    for (int i = 0; i < 4; ++i) sel_l[lane + 64 * i] = (u16)selv[i];
    int koff[16];
#pragma unroll
    for (int kb = 0; kb < 16; ++kb) koff[kb] = (int)sel_l[16 * kb + i16] * KV_TOK + g * KV_GRP + 32 * c;
    u32x4 kq[SP_KD][2];
#pragma unroll
    for (int kb = 0; kb < SP_KD; ++kb) { kq[kb][0] = __builtin_amdgcn_raw_buffer_load_b128(rs, koff[kb], 0, 0); kq[kb][1] = __builtin_amdgcn_raw_buffer_load_b128(rs, koff[kb] + 16, 0, 0); }
    {
        const int pt = p.positions[t];
        int ps[4];
#pragma unroll
        for (int i = 0; i < 4; ++i) ps[i] = p.positions[selv[i]];
#pragma unroll
        for (int i = 0; i < 4; ++i) { int dist = pt - ps[i]; dist = dist > 0 ? dist : 0; bkt_l[lane + 64 * i] = (dist < 128) ? bktab[dist] : (unsigned char)31; }
    }
    i32x8 qf8;
    { const u16* qp = (const u16*)(p.ws + WS_AQ) + (size_t)t * 1024 + (g * 4 + (i16 & 3)) * 128 + 32 * c;
#pragma unroll
      for (int s = 0; s < 4; ++s) { const u32x4 w = __builtin_nontemporal_load((const u32x4*)(qp + 8 * s));
          int lo = 0, hi = 0;
          lo = __builtin_amdgcn_cvt_pk_fp8_f32(__uint_as_float(w[0] << 16) * Q8_SCALE, __uint_as_float(w[0] & 0xffff0000u) * Q8_SCALE, lo, false);
          lo = __builtin_amdgcn_cvt_pk_fp8_f32(__uint_as_float(w[1] << 16) * Q8_SCALE, __uint_as_float(w[1] & 0xffff0000u) * Q8_SCALE, lo, true);
          hi = __builtin_amdgcn_cvt_pk_fp8_f32(__uint_as_float(w[2] << 16) * Q8_SCALE, __uint_as_float(w[2] & 0xffff0000u) * Q8_SCALE, hi, false);
          hi = __builtin_amdgcn_cvt_pk_fp8_f32(__uint_as_float(w[3] << 16) * Q8_SCALE, __uint_as_float(w[3] & 0xffff0000u) * Q8_SCALE, hi, true);
          qf8[2 * s] = (i16 < 4) ? lo : 0; qf8[2 * s + 1] = (i16 < 4) ? hi : 0; } }
    f32x4 S[16];
#pragma unroll
    for (int kb = 0; kb < 16; ++kb) {
        const u32x4 k0 = kq[kb % SP_KD][0], k1 = kq[kb % SP_KD][1];
        const i32x8 kf8 = {(int)k0[0], (int)k0[1], (int)k0[2], (int)k0[3], (int)k1[0], (int)k1[1], (int)k1[2], (int)k1[3]};
        S[kb] = __builtin_amdgcn_mfma_scale_f32_16x16x128_f8f6f4(kf8, qf8, (f32x4){0.f, 0.f, 0.f, 0.f}, 0, 0, 0, 0x7f7f7f7f, 0, 0x7f7f7f7f);
        if (kb + SP_KD < 16) { kq[kb % SP_KD][0] = __builtin_amdgcn_raw_buffer_load_b128(rs, koff[kb + SP_KD], 0, 0); kq[kb % SP_KD][1] = __builtin_amdgcn_raw_buffer_load_b128(rs, koff[kb + SP_KD] + 16, 0, 0); }
    }
#define SP_VDMA(u_) do { char* dst_ = vtile + ((u_) & 1) * 8192; \
    _Pragma("unroll") for (int m = 0; m < 8; ++m) { const int kl_ = 8 * (m >> 1) + (i16 >> 1), ch_ = 8 * (m & 1) + 2 * c + (lane & 1); \
        const int tok_ = sel_l[(u_) * 32 + kl_]; \
        __builtin_amdgcn_raw_ptr_buffer_load_lds(rs, (__attribute__((address_space(3))) void*)(dst_ + m * 1024), 16, tok_ * KV_TOK + g * KV_GRP + 128 + ch_ * 16, 0, 0, 0); } } while (0)
    SP_VDMA(0); SP_VDMA(1);
#pragma unroll
    for (int kb = 0; kb < 16; ++kb) {
        const unsigned bw = *(const unsigned*)(bkt_l + 16 * kb + 4 * c);
#pragma unroll
        for (int i = 0; i < 4; ++i) { const int slot = 16 * kb + 4 * c + i; const int b = (bw >> (8 * i)) & 255;
            const float bias = relb_l[b * 8 + g * 4 + (i16 & 3)];
            S[kb][i] = fmaf(S[kb][i], 1.f / (K8_SCALE * Q8_SCALE), bias) + ((slot < cnt) ? 0.f : -INFINITY); }
    }
    const float lsum = softmax_cols16(S);
    f32x4 O[8];
#pragma unroll
    for (int d = 0; d < 8; ++d) O[d] = f32x4{0.f, 0.f, 0.f, 0.f};
    const int vlane = (c >> 1) * 2048 + (c & 1) * 128 + (i16 >> 2) * 32 + (i16 & 3) * 8;
#pragma unroll
    for (int u = 0; u < 8; ++u) {
        if (u < 7) asm volatile("s_waitcnt vmcnt(8)" ::: "memory"); else asm volatile("s_waitcnt vmcnt(0)" ::: "memory");
        const int vb = (int)(uintptr_t)(vtile + (u & 1) * 8192) + vlane;
        const bf16x8 pf = pack_p(S[2 * u], S[2 * u + 1]);
        {
            s16x4 xa[8][2];
#define SP_TR(d0) TRRD16(xa[d0][0], vb, (d0) * 256); TRRD16(xa[d0][1], vb, (d0) * 256 + 4096)
            SP_TR(0); SP_TR(1); SP_TR(2); SP_TR(3); SP_TR(4); SP_TR(5); SP_TR(6); SP_TR(7);
#undef SP_TR
            asm volatile("s_waitcnt lgkmcnt(0)" ::: "memory"); __builtin_amdgcn_sched_barrier(0);
#pragma unroll
            for (int d0 = 0; d0 < 8; ++d0)
                O[d0] = __builtin_amdgcn_mfma_f32_16x16x32_bf16((bf16x8){xa[d0][0][0], xa[d0][0][1], xa[d0][0][2], xa[d0][0][3], xa[d0][1][0], xa[d0][1][1], xa[d0][1][2], xa[d0][1][3]}, pf, O[d0], 0, 0, 0);
        }
#define SP_PV(d0)
#undef SP_PV
        if (u + 2 < 8) SP_VDMA(u + 2);
    }
#undef SP_VDMA
    if (i16 < 4) {
        const float linv = U8_SCALE / lsum;
        const size_t ob = (size_t)t * 1024 + (g * 4 + i16) * 128 + 4 * c;
        const u16* SZ = (const u16*)(p.ws + WS_SZA) + ob; unsigned char* UA = (unsigned char*)(p.ws + WS_UA) + ob;
        u32x2 zws[8];
#pragma unroll
        for (int d = 0; d < 8; ++d) zws[d] = __builtin_nontemporal_load((const u32x2*)(SZ + d * 16));
#pragma unroll
        for (int d = 0; d < 8; ++d) { const u32x2 zw = zws[d];
            store4_fp8(UA + d * 16, O[d][0] * linv * __uint_as_float(zw[0] << 16), O[d][1] * linv * __uint_as_float(zw[0] & 0xffff0000u),
                        O[d][2] * linv * __uint_as_float(zw[1] << 16), O[d][3] * linv * __uint_as_float(zw[1] & 0xffff0000u)); }
    }
}
__device__ __forceinline__ void phase_sparse_attn(const Params& p) {
    extern __shared__ __attribute__((aligned(16))) char smem[];
    const int tid_ = opaque_tid();
    const int wid = __builtin_amdgcn_readfirstlane(tid_ >> 6), lane = tid_ & 63;
    float* relb_l = (float*)(smem + SP_RELB_OFF);
    __syncthreads();
    if (tid_ < 256) relb_l[tid_] = p.rel_bias[tid_];
    if (tid_ < 32) ((unsigned*)(smem + SP_RELB_OFF + 1024))[tid_] = ((const unsigned*)(p.ws + WS_BKT))[tid_];
    __syncthreads();
    char* wl = smem + wid * SP_WAVE_LDS;
    const int g = blockIdx.x & 1, wg = (blockIdx.x >> 1) * 8 + wid;
    const int* SEL = (const int*)(p.ws + WS_SEL); const int* CNT = (const int*)(p.ws + WS_CNT);
    int seln[4], cntn = CNT[wg];
#pragma unroll
    for (int i = 0; i < 4; ++i) seln[i] = (lane + 64 * i < cntn) ? SEL[(size_t)wg * TOPK + lane + 64 * i] : 0;
#pragma unroll 1
    for (int t = wg; t < SEQ; t += 1024) {
        int selv[4]; const int cnt = cntn;
#pragma unroll
        for (int i = 0; i < 4; ++i) selv[i] = seln[i];
        if (t + 1024 < SEQ) {
            cntn = CNT[t + 1024];
#pragma unroll
            for (int i = 0; i < 4; ++i) seln[i] = SEL[(size_t)(t + 1024) * TOPK + lane + 64 * i];
        }
        sp_item(p, t, g, wl, relb_l, lane, selv, cnt);
    }
    asm volatile("s_waitcnt vmcnt(0)" ::: "memory");
    __syncthreads();
}

constexpr int P4_SP_OFF = 0;
constexpr int P4_RING_OFF = 4 * SP_WAVE_LDS;
constexpr int P4_SP2_OFF = P4_RING_OFF;
constexpr int P4_RELB_OFF = P4_RING_OFF + 81920;
constexpr int P4_BAR_OFF = P4_RELB_OFF + 1024 + 128;
static_assert(4 * SP_WAVE_LDS <= 81920, "the MLA waves' sparse scratch must fit in the ring");
__device__ __forceinline__ void sw_barrier4(unsigned* cnt, const unsigned target, const int lane) {
    asm volatile("s_waitcnt lgkmcnt(0)" ::: "memory");
    if (lane == 0) {
        const int ca = (int)(uintptr_t)cnt; const unsigned one = 1u; unsigned v;
        asm volatile("ds_add_u32 %0, %1" :: "v"(ca), "v"(one) : "memory");
        for (;;) {
            asm volatile("ds_read_b32 %0, %1\n\ts_waitcnt lgkmcnt(0)" : "=v"(v) : "v"(ca) : "memory");
            if (v >= target) break;
        }
    }
    asm volatile("" ::: "memory");
}
constexpr int MLA4_KROW = 208, MLA4_KIMG = 7168, MLA4_TILE = MLA4_KIMG + MLA_VT;
constexpr float MLA4_C2 = LOG2E / (MK8_SCALE * MQ8_SCALE);
#define MLA4_KRD(ka_, s, j) (*(const __attribute__((address_space(3))) u32x4*)((ka_) + (s) * 64 + (j) * 16))
#define MLA4_KF(k0_, k1_) ((i32x8){(int)(k0_)[0], (int)(k0_)[1], (int)(k0_)[2], (int)(k0_)[3], (int)(k1_)[0], (int)(k1_)[1], (int)(k1_)[2], (int)(k1_)[3]})
#define MLA4_MMA(a_, b_, c_) __builtin_amdgcn_mfma_scale_f32_32x32x64_f8f6f4((a_), (b_), (c_), 0, 0, 0, 0x7f7f7f7f, 0, 0x7f7f7f7f)
__device__ __forceinline__ void mla4_qk(const int ka, const i32x8 (&qf)[3], f32x16& pt) {
#pragma unroll
    for (int r = 0; r < 16; ++r) pt[r] = 0.f;
    u32x4 k0[3], k1[3];
#pragma unroll
    for (int s = 0; s < 3; ++s) { k0[s] = MLA4_KRD(ka, s, 0); k1[s] = MLA4_KRD(ka, s, 1); }
#pragma unroll
    for (int s = 0; s < 3; ++s) pt = MLA4_MMA(MLA4_KF(k0[s], k1[s]), qf[s], pt);
}
__device__ __forceinline__ constexpr int mla4_es(int d) { return d <= 0 ? 0 : (d == 1 ? 6 : (d == 2 ? 11 : 16)); }
__device__ __forceinline__ float mla4_rowmax(const f32x16& pt) {
    float a = fmaxf(pt[0], pt[1]), b = fmaxf(pt[2], pt[3]), c = fmaxf(pt[4], pt[5]), d = fmaxf(pt[6], pt[7]);
    a = fmaxf(a, fmaxf(pt[8], pt[9])); b = fmaxf(b, fmaxf(pt[10], pt[11])); c = fmaxf(c, fmaxf(pt[12], pt[13])); d = fmaxf(d, fmaxf(pt[14], pt[15]));
    float pmax = fmaxf(fmaxf(a, b), fmaxf(c, d));
    auto rr = __builtin_amdgcn_permlane32_swap(__float_as_uint(pmax), __float_as_uint(pmax), false, false);
    return fmaxf(__uint_as_float(rr[0]), __uint_as_float(rr[1]));
}
#define MLA4_TRB(off) __builtin_amdgcn_ds_read_tr16_b64_v4i16((__attribute__((address_space(3))) s16x4*)(vt + (off)))
#define MLA4_TRRD(dst, off) asm volatile("ds_read_b64_tr_b16 %0, %1 offset:%2" : "=&v"(dst) : "v"(vt), "i"(off) : "memory")
#define MLA4_TR(d0) MLA4_TRRD(va[d0][0], (d0) * 256); MLA4_TRRD(va[d0][1], (d0) * 256 + 2048); MLA4_TRRD(va[d0][2], (d0) * 256 + 4096); MLA4_TRRD(va[d0][3], (d0) * 256 + 6144)
#define MLA4_PV() do { _Pragma("unroll") for (int d0 = 0; d0 < 4; ++d0) \
        o[d0] = __builtin_amdgcn_mfma_f32_32x32x16_bf16((bf16x8){va[d0][0][0], va[d0][0][1], va[d0][0][2], va[d0][0][3], va[d0][1][0], va[d0][1][1], va[d0][1][2], va[d0][1][3]}, pa[0], o[d0], 0, 0, 0); \
    _Pragma("unroll") for (int d0 = 0; d0 < 4; ++d0) \
        o[d0] = __builtin_amdgcn_mfma_f32_32x32x16_bf16((bf16x8){va[d0][2][0], va[d0][2][1], va[d0][2][2], va[d0][2][3], va[d0][3][0], va[d0][3][1], va[d0][3][2], va[d0][3][3]}, pa[1], o[d0], 0, 0, 0); } while (0)
__device__ __forceinline__ void mla_qblock4(const Params& p, const int h, const int qb, const int wq, const int lane, unsigned* bar, unsigned& bar_k) {
    extern __shared__ __attribute__((aligned(16))) char smem[];
    const int r32 = lane & 31, hi = lane >> 5;
    const int R0 = qb * 128, wrow0 = R0 + wq * 32, qrow = wrow0 + r32;
    const int n_it = 4 * (qb + 1);
    const int n_act = (wrow0 + 31) / 32 + 1;
    const unsigned char* QB = (const unsigned char*)(p.dout + DO_QB) + ((size_t)h * SEQ + qrow) * 192;
    const __amdgpu_buffer_rsrc_t rs = __builtin_amdgcn_make_buffer_rsrc((void*)p.dout, (short)0, 0x7fffffff, 0x00020000);
    i32x8 qf[3];
#pragma unroll
    for (int s = 0; s < 3; ++s) { const u32x4 a = *(const u32x4*)(QB + 64 * s + 32 * hi), b = *(const u32x4*)(QB + 64 * s + 32 * hi + 16);
        qf[s] = MLA4_KF(a, b); }
    int voff[4], pbase[4], pmul[4], pdst[4];
#pragma unroll
    for (int i = 0; i < 4; ++i) {
        const int pc = min(wq * 4 + i, 14);
        pdst[i] = pc * 1024;
        if (pc < 7) { const int L = pc * 64 + lane; int row = L / 13, c = L - row * 13; if (row > 31) { row = 31; c = 12; } if (c > 11) c = 11;
            voff[i] = row * 192 + c * 16; pbase[i] = (int)DO_KB + h * SEQ * 192; pmul[i] = 32 * 192; }
        else { const int o = (pc - 7) * 1024 + lane * 16, sub = o >> 8, ksub = sub >> 2, csub = sub & 3, kq = (o & 255) >> 6, cc = (o & 63) >> 4;
            voff[i] = (ksub * 4 + kq) * 256 + (csub * 4 + cc) * 16; pbase[i] = (int)DO_VB + h * SEQ * 256; pmul[i] = 32 * 256; }
    }
#define MLA4_SLOT(it_) (smem + P4_RING_OFF + ((it_) & 3) * MLA4_TILE)
#define MLA4_DMA(it_) do { char* img_ = MLA4_SLOT(it_); \
    _Pragma("unroll") for (int i = 0; i < 4; ++i) \
        __builtin_amdgcn_raw_ptr_buffer_load_lds(rs, (__attribute__((address_space(3))) void*)(img_ + pdst[i]), 16, voff[i], pbase[i] + (it_) * pmul[i], 0, 0); } while (0)
    const int kal = r32 * MLA4_KROW + 32 * hi;
    const int vlane = hi * 1024 + ((lane & 15) >> 2) * 64 + ((lane >> 4) & 1) * 32 + (lane & 3) * 8;
    f32x16 o[4];
#pragma unroll
    for (int d = 0; d < 4; ++d)
#pragma unroll
        for (int r = 0; r < 16; ++r) o[d][r] = 0.f;
    float m_run = -1e30f, l_run = 0.f;
    asm volatile("s_waitcnt vmcnt(0)" : "+v"(qf[0]), "+v"(qf[1]), "+v"(qf[2]) :: "memory");
    bar_k += 4; sw_barrier4(bar, bar_k, lane);
    MLA4_DMA(0);
    if (n_it > 1) MLA4_DMA(1);
    if (n_it > 2) MLA4_DMA(2);
    if (n_it > 2) asm volatile("s_waitcnt vmcnt(8)" ::: "memory"); else if (n_it > 1) asm volatile("s_waitcnt vmcnt(4)" ::: "memory"); else asm volatile("s_waitcnt vmcnt(0)" ::: "memory");
    bar_k += 4; sw_barrier4(bar, bar_k, lane);
    f32x16 pt;
    mla4_qk((int)(uintptr_t)MLA4_SLOT(0) + kal, qf, pt);
    float pmax = mla4_rowmax(pt);
    for (int it = 0; it < n_it; ++it) {
        if (it + 1 < n_it) {
            if (it + 2 < n_it) asm volatile("s_waitcnt vmcnt(4)" ::: "memory"); else asm volatile("s_waitcnt vmcnt(0)" ::: "memory");
        }
        bar_k += 4; sw_barrier4(bar, bar_k, lane);
        if (it + 3 < n_it) MLA4_DMA(it + 3);
        if (it < n_act) {
            const int key0 = it * 32;
            const int vt = (int)(uintptr_t)(MLA4_SLOT(it) + MLA4_KIMG) + vlane;
            s16x4 va[4][4];
            bf16x8 pa[2];
            if (key0 + 31 > wrow0) {
#pragma unroll
                for (int r = 0; r < 16; ++r) if (key0 + crow16(r, hi) > qrow) pt[r] = -INFINITY;
                pmax = mla4_rowmax(pt);
            }
            if (!__all((pmax - m_run) * MLA4_C2 <= 8.f)) {
                const float mn = fmaxf(m_run, pmax);
                const float alpha = __builtin_amdgcn_exp2f((m_run - mn) * MLA4_C2);
                m_run = mn; l_run *= alpha;
#pragma unroll
                for (int d = 0; d < 4; ++d)
#pragma unroll
                    for (int r = 0; r < 16; ++r) o[d][r] *= alpha;
            }
            {
                const float mneg = -m_run * MLA4_C2;
                const int ka = (int)(uintptr_t)MLA4_SLOT(it + 1) + kal;
                f32x16 ptn;
#pragma unroll
                for (int r = 0; r < 16; ++r) ptn[r] = 0.f;
                float ps = 0.f;
                unsigned pw[8];
                u32x4 k0[3], k1[3];
#pragma unroll
                for (int s = 0; s < 3; ++s) { k0[s] = MLA4_KRD(ka, s, 0); k1[s] = MLA4_KRD(ka, s, 1); }
                __builtin_amdgcn_sched_barrier(0);
#pragma unroll
                for (int d0 = 0; d0 < 3; ++d0) {
                    ptn = MLA4_MMA(MLA4_KF(k0[d0], k1[d0]), qf[d0], ptn);
#pragma unroll
                    for (int e = mla4_es(d0); e < mla4_es(d0 + 1); ++e) { pt[e] = __builtin_amdgcn_exp2f(fmaf(pt[e], MLA4_C2, mneg)); ps += pt[e]; }
#pragma unroll
                    for (int j = mla4_es(d0 - 1) / 2; j < mla4_es(d0) / 2; ++j) pw[j] = cvtpk_b(pt[2 * j], pt[2 * j + 1]);
                    __builtin_amdgcn_sched_barrier(0);
                }
                MLA4_TR(0); MLA4_TR(1); MLA4_TR(2); MLA4_TR(3);
#pragma unroll
                for (int j = mla4_es(2) / 2; j < 8; ++j) pw[j] = cvtpk_b(pt[2 * j], pt[2 * j + 1]);
                { auto rr = __builtin_amdgcn_permlane32_swap(__float_as_uint(ps), __float_as_uint(ps), false, false);
                  ps = __uint_as_float(rr[0]) + __uint_as_float(rr[1]); }
                l_run += ps;
                { u32x4 w0 = {pw[0], pw[1], pw[2], pw[3]}, w1 = {pw[4], pw[5], pw[6], pw[7]};
                  pa[0] = *reinterpret_cast<bf16x8*>(&w0); pa[1] = *reinterpret_cast<bf16x8*>(&w1); }
                asm volatile("s_waitcnt lgkmcnt(0)" ::: "memory"); __builtin_amdgcn_sched_barrier(0);
                MLA4_PV();
                pmax = mla4_rowmax(ptn);
                pt = ptn;
            }
        }
    }
#undef MLA4_DMA
#undef MLA4_SLOT
    {
        const float linv = U8_SCALE / l_run;
        const u16* SZ = (const u16*)(p.ws + WS_SZB) + (size_t)qrow * 1024 + h * 128;
        unsigned char* UB = (unsigned char*)(p.ws + WS_UB) + (size_t)qrow * 1024 + h * 128;
        u32x2 zws[16];
#pragma unroll
        for (int d = 0; d < 4; ++d)
#pragma unroll
            for (int a = 0; a < 4; ++a) zws[d * 4 + a] = __builtin_nontemporal_load((const u32x2*)(SZ + d * 32 + 8 * a + 4 * hi));
#pragma unroll
        for (int d = 0; d < 4; ++d)
#pragma unroll
            for (int a = 0; a < 4; ++a) {
                const int dim = d * 32 + 8 * a + 4 * hi;
                const u32x2 zw = zws[d * 4 + a];
                store4_fp8(UB + dim, o[d][4 * a + 0] * linv * __uint_as_float(zw[0] << 16), o[d][4 * a + 1] * linv * __uint_as_float(zw[0] & 0xffff0000u),
                           o[d][4 * a + 2] * linv * __uint_as_float(zw[1] << 16), o[d][4 * a + 3] * linv * __uint_as_float(zw[1] & 0xffff0000u));
            }
    }
}
__device__ __forceinline__ void phase_p4(const Params& p) {
    extern __shared__ __attribute__((aligned(16))) char smem[];
    const int tid_ = opaque_tid();
    const int wid = __builtin_amdgcn_readfirstlane(tid_ >> 6), lane = tid_ & 63;
    float* relb_l = (float*)(smem + P4_RELB_OFF);
    unsigned* bar = (unsigned*)(smem + P4_BAR_OFF);
    __syncthreads();
    if (tid_ < 256) relb_l[tid_] = p.rel_bias[tid_];
    if (tid_ < 32) ((unsigned*)(smem + P4_RELB_OFF + 1024))[tid_] = ((const unsigned*)(p.ws + WS_BKT))[tid_];
    if (tid_ == 0) { bar[0] = 0u; bar[1] = 0u; }
    __syncthreads();
    const int g = blockIdx.x & 1, t_lo = (blockIdx.x >> 1) * 4;
    unsigned* qhead = bar + 1;
    char* wl;
    if (wid < 4) {
        unsigned bar_k = 0;
        const int h = blockIdx.x & 7, i = blockIdx.x >> 3;
        mla_qblock4(p, h, 63 - i, wid, lane, bar, bar_k);
        mla_qblock4(p, h, i, wid, lane, bar, bar_k);
        bar_k += 4; sw_barrier4(bar, bar_k, lane);
        wl = smem + P4_SP2_OFF + wid * SP_WAVE_LDS;
    } else wl = smem + P4_SP_OFF + (wid - 4) * SP_WAVE_LDS;
    int lane_s = lane;
    asm volatile("" : "+v"(lane_s));
    {
        const int lane = lane_s;
        const int* SEL = (const int*)(p.ws + WS_SEL); const int* CNT = (const int*)(p.ws + WS_CNT);
#define P4_GRAB(qv) do { unsigned q_ = 0; if (lane == 0) { const int qa_ = (int)(uintptr_t)qhead; const unsigned one_ = 1u;   asm volatile("ds_add_rtn_u32 %0, %1, %2\n\ts_waitcnt lgkmcnt(0)" : "=v"(q_) : "v"(qa_), "v"(one_) : "memory"); } qv = (int)__builtin_amdgcn_readfirstlane(q_); } while (0)
#define P4_TOK(qv) (t_lo + 512 * ((qv) >> 2) + ((qv) & 3))
        int q; P4_GRAB(q);
        int seln[4] = {0, 0, 0, 0}, cntn = 0;
        if (q < 64) { const int t = P4_TOK(q); cntn = CNT[t];
#pragma unroll
            for (int i = 0; i < 4; ++i) seln[i] = (lane + 64 * i < cntn) ? SEL[(size_t)t * TOPK + lane + 64 * i] : 0; }
#pragma unroll 1
        while (q < 64) {
            int selv[4]; const int cnt = cntn; const int t = P4_TOK(q);
#pragma unroll
            for (int i = 0; i < 4; ++i) selv[i] = seln[i];
            int qn; P4_GRAB(qn);
            if (qn < 64) { const int tn = P4_TOK(qn); cntn = CNT[tn];
#pragma unroll
                for (int i = 0; i < 4; ++i) seln[i] = (lane + 64 * i < cntn) ? SEL[(size_t)tn * TOPK + lane + 64 * i] : 0; }
            sp_item(p, t, g, wl, relb_l, lane, selv, cnt);
            q = qn;
        }
#undef P4_GRAB
#undef P4_TOK
    }
    asm volatile("s_waitcnt vmcnt(0)" ::: "memory");
    __syncthreads();
}

__device__ __forceinline__ void phase_mem_attn(const Params& p) {
    extern __shared__ __attribute__((aligned(16))) char smem[];
    const int tid_ = opaque_tid();
    const int wid = __builtin_amdgcn_readfirstlane(tid_ >> 6), lane = tid_ & 63, i16 = lane & 15, c = lane >> 4;
    const int hh = blockIdx.x & 3, q0 = (blockIdx.x >> 2) * 128 + wid * 16;
    const __amdgpu_buffer_rsrc_t rsK = __builtin_amdgcn_make_buffer_rsrc((void*)(p.ws + WS_CK), (short)0, 0x7fffffff, 0x00020000);
    const __amdgpu_buffer_rsrc_t rsV = __builtin_amdgcn_make_buffer_rsrc((void*)(p.ws + WS_CV), (short)0, 0x7fffffff, 0x00020000);
    __syncthreads();
#pragma unroll 4
    for (int m = 0; m < 16; ++m) { const int o = (wid * 16 + m) * 1024 + lane * 16, key = o >> 9, cpos = (o & 511) >> 4;
        const int chunk = (cpos & 16) | ((cpos & 15) ^ (key & 15));
        __builtin_amdgcn_raw_ptr_buffer_load_lds(rsK, (__attribute__((address_space(3))) void*)(smem + (wid * 16 + m) * 1024), 16, key * 2048 + hh * 512 + chunk * 16, 0, 0, 0); }
    bf16x8 qf[8];
    { const u16* qp = (const u16*)(p.ws + WS_CQ) + (size_t)(q0 + i16) * 1024 + hh * 256 + 8 * c;
#pragma unroll
      for (int s = 0; s < 8; ++s) qf[s] = __builtin_nontemporal_load((const bf16x8*)(qp + 32 * s)); }
    asm volatile("s_waitcnt vmcnt(0)" ::: "memory");
    __syncthreads();
    f32x4 S[16];
    {
        int kbase[4];
#pragma unroll
        for (int a = 0; a < 4; ++a) kbase[a] = i16 * 512 + 16 * ((4 * a + c) ^ i16);
#pragma unroll
        for (int kb = 0; kb < 16; ++kb) {
            f32x4 acc = {0.f, 0.f, 0.f, 0.f};
            int kofs = kb * 8192; asm volatile("" : "+v"(kofs));
#pragma unroll
            for (int s = 0; s < 8; ++s) { const bf16x8 kf = *(const bf16x8*)(smem + kofs + kbase[s & 3] + (s >> 2) * 256);
                acc = __builtin_amdgcn_mfma_f32_16x16x32_bf16(kf, qf[s], acc, 0, 0, 0); }
            asm volatile("" : "+v"(acc));
            S[kb] = acc;
        }
    }
    __syncthreads();
#pragma unroll 4
    for (int m = 0; m < 16; ++m) { const int o = (wid * 16 + m) * 1024 + lane * 16, sub = o >> 8, key = (sub >> 4) * 8 + ((o & 255) >> 5), chunk = (sub & 15) * 2 + ((o >> 4) & 1);
        __builtin_amdgcn_raw_ptr_buffer_load_lds(rsV, (__attribute__((address_space(3))) void*)(smem + (wid * 16 + m) * 1024), 16, key * 2048 + hh * 512 + chunk * 16, 0, 0, 0); }
    const float lsum = softmax_cols16(S);
    asm volatile("s_waitcnt vmcnt(0)" ::: "memory");
    __syncthreads();
    f32x4 O[16];
#pragma unroll
    for (int d = 0; d < 16; ++d) O[d] = f32x4{0.f, 0.f, 0.f, 0.f};
    const int vlane = (int)(uintptr_t)smem + (c >> 1) * 4096 + (c & 1) * 128 + (i16 >> 2) * 32 + (i16 & 3) * 8;
#pragma unroll
    for (int u = 0; u < 8; ++u) {
        const int vb = vlane + u * 16384;
        const bf16x8 pf = pack_p(S[2 * u], S[2 * u + 1]);
#pragma unroll
        for (int hb = 0; hb < 2; ++hb) {
            s16x4 xa[8][2];
#define MEM_TR(d0) TRRD16(xa[d0][0], vb, (d0) * 256); TRRD16(xa[d0][1], vb, (d0) * 256 + 8192)
            if (hb == 0) { MEM_TR(0); MEM_TR(1); MEM_TR(2); MEM_TR(3); MEM_TR(4); MEM_TR(5); MEM_TR(6); MEM_TR(7); }
#undef MEM_TR
#define MEM_TR(d0) TRRD16(xa[d0][0], vb, (d0 + 8) * 256); TRRD16(xa[d0][1], vb, (d0 + 8) * 256 + 8192)
            if (hb == 1) { MEM_TR(0); MEM_TR(1); MEM_TR(2); MEM_TR(3); MEM_TR(4); MEM_TR(5); MEM_TR(6); MEM_TR(7); }
#undef MEM_TR
            asm volatile("s_waitcnt lgkmcnt(0)" ::: "memory"); __builtin_amdgcn_sched_barrier(0);
#pragma unroll
            for (int d0 = 0; d0 < 8; ++d0)
                O[hb * 8 + d0] = __builtin_amdgcn_mfma_f32_16x16x32_bf16((bf16x8){xa[d0][0][0], xa[d0][0][1], xa[d0][0][2], xa[d0][0][3], xa[d0][1][0], xa[d0][1][1], xa[d0][1][2], xa[d0][1][3]}, pf, O[hb * 8 + d0], 0, 0, 0);
        }
#define MEM_PV(d0)
#undef MEM_PV
    }
    {
        const float linv = U8_SCALE / lsum;
        const size_t ob = (size_t)(q0 + i16) * 1024 + hh * 256 + 4 * c;
        const u16* SZ = (const u16*)(p.ws + WS_SZC) + ob; unsigned char* UC = (unsigned char*)(p.ws + WS_UC) + ob;
        u32x2 zws[16];
#pragma unroll
        for (int d = 0; d < 16; ++d) zws[d] = __builtin_nontemporal_load((const u32x2*)(SZ + d * 16));
#pragma unroll
        for (int d = 0; d < 16; ++d) { const u32x2 zw = zws[d];
            store4_fp8(UC + d * 16, O[d][0] * linv * __uint_as_float(zw[0] << 16), O[d][1] * linv * __uint_as_float(zw[0] & 0xffff0000u),
                        O[d][2] * linv * __uint_as_float(zw[1] << 16), O[d][3] * linv * __uint_as_float(zw[1] & 0xffff0000u)); }
    }
    __syncthreads();
}

constexpr int DUP_SEL = 0;
constexpr int MEGA_LDS = IDX_RING_OFF + 49152 + 64;
static_assert(P4_BAR_OFF + 16 <= MEGA_LDS, "phase 4 LDS");

#define XB_TMO      128
#define XB_XCNT(j)  (256  + 64 * (j))
#define XB_XSUB(j)  (1280 + 64 * (j))
#define XB_XGEN(j)  (2304 + 64 * (j))
#define XB_TOP      3328
#define XB_TOPGEN   3392
#define XCD_BAR_WORDS 3456
#define XB_SPIN_CAP (1u << 22)
#define LAS __attribute__((address_space(3)))
constexpr size_t WS_BAR = WS_CNT + 256 * 1024;
__device__ __forceinline__ unsigned xb_ld(unsigned* p)              { return __hip_atomic_load(p, __ATOMIC_RELAXED, __HIP_MEMORY_SCOPE_AGENT); }
__device__ __forceinline__ unsigned xb_add(unsigned* p, unsigned v) { return __hip_atomic_fetch_add(p, v, __ATOMIC_RELAXED, __HIP_MEMORY_SCOPE_AGENT); }
__device__ __forceinline__ unsigned xb_xcc_id() { return (unsigned)__builtin_amdgcn_s_getreg((3 << 11) | 20) & 0xFu; }
#define XB_SPIN(cond, bar) do { unsigned _sp = 0; while (cond) { __builtin_amdgcn_s_sleep(1); \
    if ((++_sp & 255u) == 0u) { if (xb_ld(&(bar)[XB_TMO])) break; if (_sp > XB_SPIN_CAP) { atomicAdd(&(bar)[XB_TMO], 1u); break; } } } } while (0)
struct XcdBarrier { unsigned* bar; unsigned x; volatile LAS unsigned* st; };
__device__ __forceinline__ XcdBarrier xcd_barrier_post(unsigned* bar, volatile LAS unsigned* st) {
    XcdBarrier b; b.bar = bar; b.x = xb_xcc_id(); b.st = st;
    if (threadIdx.x == 0) (void)xb_add(&bar[XB_XCNT(b.x)], 1u);
    return b;
}
__device__ __forceinline__ void xcd_barrier_complete(unsigned* bar, unsigned x, unsigned& nloc, unsigned& nx) {
    const unsigned G = gridDim.x * gridDim.y * gridDim.z;
    unsigned sum, cnt, mine, sp = 0u;
    for (;;) {
        sum = 0u; cnt = 0u; mine = 0u;
#pragma unroll
        for (unsigned j = 0; j < 16; ++j) { const unsigned c = xb_ld(&bar[XB_XCNT(j)]); sum += c; cnt += (c > 0u) ? 1u : 0u; mine = (j == x) ? c : mine; }
        if (sum == G) break;
        __builtin_amdgcn_s_sleep(1);
        if ((++sp & 255u) == 0u) { if (xb_ld(&bar[XB_TMO])) break; if (sp > XB_SPIN_CAP) { atomicAdd(&bar[XB_TMO], 1u); break; } }
    }
    nloc = mine > 0u ? mine : 1u; nx = cnt > 0u ? cnt : 1u;
}
__device__ __forceinline__ void xcd_barrier(const XcdBarrier& b) {
    asm volatile("s_waitcnt vmcnt(0)" ::: "memory");
    __syncthreads();
    if (threadIdx.x == 0) {
        unsigned* bar = b.bar;
        __builtin_amdgcn_s_waitcnt(0);
        unsigned nloc = b.st[0], nx = b.st[1];
        if (nloc == 0u) { xcd_barrier_complete(bar, b.x, nloc, nx); b.st[0] = nloc; b.st[1] = nx; }
        const unsigned old = xb_add(&bar[XB_XSUB(b.x)], 1u);
        const unsigned gen = old / nloc;
        if (old + 1u == (gen + 1u) * nloc) {
            __builtin_amdgcn_fence(__ATOMIC_RELEASE, "agent");
            asm volatile("s_waitcnt vmcnt(0)" ::: "memory");
            const unsigned og = xb_add(&bar[XB_TOP], 1u);
            const unsigned tg = og / nx;
            if (og + 1u == (tg + 1u) * nx) xb_add(&bar[XB_TOPGEN], 1u);
            else XB_SPIN(xb_ld(&bar[XB_TOPGEN]) == tg, bar);
            __builtin_amdgcn_fence(__ATOMIC_ACQUIRE, "agent");
            xb_add(&bar[XB_XGEN(b.x)], 1u);
            asm volatile("s_waitcnt vmcnt(0)" ::: "memory");
        } else {
            XB_SPIN(xb_ld(&bar[XB_XGEN(b.x)]) == gen, bar);
            __builtin_amdgcn_fence(__ATOMIC_ACQUIRE, "agent");
            asm volatile("s_waitcnt vmcnt(0)" ::: "memory");
        }
    }
    __syncthreads();
}

typedef __attribute__((address_space(1))) char gchar_t;
__global__ void __launch_bounds__(512) mega_kernel(Params p_in) {
    extern __shared__ __attribute__((aligned(16))) char smem[];
    volatile LAS unsigned* st = (volatile LAS unsigned*)(smem + MEGA_LDS);
    if (threadIdx.x == 0) { st[0] = 0u; st[1] = 0u; st[2] = 0u; st[3] = 0u; }
    __syncthreads();
    const XcdBarrier xb = xcd_barrier_post((unsigned*)(p_in.ws + WS_BAR), st);
#define RUNP(id, call) do { call; if (DUP_SEL == (id) || (DUP_SEL == 10 && ((id) == 1 || (id) == 3 || (id) == 5 || (id) == 8 || (id) == 9))) { __syncthreads(); call; } } while (0)
#define FRESH_P() Params q = p_in; asm volatile("" : "+s"(q.ws), "+s"(q.dout)); const Params& p = q
    const int lo = p_in.phase_lo, hi = p_in.phase_hi;
    if (lo <= 1 && 1 < hi) { FRESH_P(); RUNP(1, phase_prep(p)); if (2 < hi) xcd_barrier(xb); }
    if (lo <= 2 && 2 < hi) { FRESH_P(); RUNP(2, phase_inproj(p)); if (3 < hi) xcd_barrier(xb); }
    if (lo <= 3 && 3 < hi) { FRESH_P(); RUNP(3, phase_mla_up(p)); RUNP(4, phase_indexer(p)); RUNP(5, phase_mem_attn(p)); if (4 < hi) xcd_barrier(xb); }
    if (lo <= 4 && 4 < hi) { FRESH_P(); RUNP(6, phase_p4(p)); if (5 < hi) xcd_barrier(xb); }
    if (lo <= 5 && 5 < hi) { FRESH_P(); RUNP(8, phase_merge(p)); if (6 < hi) xcd_barrier(xb); }
    if (lo <= 6 && 6 < hi) { FRESH_P(); RUNP(9, phase_out(p)); }
    if (DBG) {
        if (blockIdx.x == 0) {
            __syncthreads();
            const float* dbg = (const float*)(p_in.ws + WS_DBG); float* OUT = (float*)p_in.dout;
            const float y = __hip_atomic_load(&dbg[1], __ATOMIC_RELAXED, __HIP_MEMORY_SCOPE_AGENT), x = __hip_atomic_load(&dbg[0], __ATOMIC_RELAXED, __HIP_MEMORY_SCOPE_AGENT);
            for (int i = threadIdx.x; i < 65536; i += 512) OUT[(size_t)(i >> 8) * DM + (i & 255)] += y;
            __syncthreads();
            if (threadIdx.x == 0) OUT[0] += x;
        }
    }
    if (hi > 100) cooperative_groups::this_grid().sync();
}

extern "C" void kernel_launch(void* const* d_in, const int* in_sizes, int n_in, void* d_out, int out_size, void* d_ws, size_t ws_size,
                              hipStream_t stream) {
    if (ws_size < WS_END) { fprintf(stderr, "ws too small: %zu < %zu\n", ws_size, WS_END); return; }
    const float* x = (const float*)d_in[0];
    const float* mem = (const float*)d_in[1];
    const int* positions = (const int*)d_in[2];
    const float* rel_bias = (const float*)d_in[3];
    const float* norm_g = (const float*)d_in[4];
    const float* mem_norm_g = (const float*)d_in[5];
    const float* w_in = (const float*)d_in[6];
    const float* a_q_norm_g = (const float*)d_in[7];
    const float* a_k_norm_g = (const float*)d_in[8];
    const float* b_q_lat_norm_g = (const float*)d_in[9];
    const float* b_kv_lat_norm_g = (const float*)d_in[10];
    const float* w_b_uq = (const float*)d_in[11];
    const float* w_b_ukv = (const float*)d_in[12];
    const float* b_q_norm_g = (const float*)d_in[13];
    const float* b_k_norm_g = (const float*)d_in[14];
    const float* w_mem_kv = (const float*)d_in[15];
    const float* c_q_norm_g = (const float*)d_in[16];
    const float* c_k_norm_g = (const float*)d_in[17];
    const float* w_branch = (const float*)d_in[18];
    const float* w_out = (const float*)d_in[19];
    char* ws = (char*)d_ws;
    char* dout = (char*)d_out;
    u16* H = (u16*)(ws + WS_H); u16* HM = (u16*)(ws + WS_HM);
    u16* AQ = (u16*)(ws + WS_AQ); u16* KVA = (u16*)(ws + WS_KVA); u16* SZA = (u16*)(ws + WS_SZA);
    u16* IQ = (u16*)(ws + WS_IQ); u16* IK = (u16*)(ws + WS_IK); float* IW = (float*)(ws + WS_IW); float* BKPE = (float*)(ws + WS_BKPE);
    u16* BCQ = (u16*)(ws + WS_BCQ); u16* BCKV = (u16*)(ws + WS_BCKV); u16* SZB = (u16*)(ws + WS_SZB);
    u16* CQ = (u16*)(ws + WS_CQ); u16* SZC = (u16*)(ws + WS_SZC); u16* G = (u16*)(ws + WS_G);
    u16* CK = (u16*)(ws + WS_CK); u16* CV = (u16*)(ws + WS_CV);
    int* SEL = (int*)(ws + WS_SEL); int* CNT = (int*)(ws + WS_CNT);
    float* COS = (float*)(ws + WS_COS); float* SIN = (float*)(ws + WS_SIN);
    u16* UA = (u16*)(ws + WS_UA); u16* UB = (u16*)(ws + WS_UB); u16* UC = (u16*)(ws + WS_UC);
    u16* MERGED = (u16*)(ws + WS_MERGED);
    u16* QB = (u16*)(dout + DO_QB); u16* KB = (u16*)(dout + DO_KB); u16* VB = (u16*)(dout + DO_VB);
    float* RAW = (float*)(ws + WS_TMP_RAW);
    float* MF = (float*)(ws + WS_TMP_MERGEDF);
    float* Y = (float*)d_out;

    static bool attr_done = false;
    if (!attr_done) {
        attr_done = true;
        (void)hipFuncSetAttribute((const void*)nk_attn<192, 128, 64, true>, hipFuncAttributeMaxDynamicSharedMemorySize, 120 * 1024);
        (void)hipFuncSetAttribute((const void*)nk_attn<256, 256, 32, false>, hipFuncAttributeMaxDynamicSharedMemorySize, 120 * 1024);
        (void)hipFuncSetAttribute((const void*)mega_kernel, hipFuncAttributeMaxDynamicSharedMemorySize, MEGA_LDS + 16);
    }
    Params prm{};
    prm.x = x; prm.mem = mem; prm.positions = positions; prm.rel_bias = rel_bias; prm.norm_g = norm_g; prm.mem_norm_g = mem_norm_g;
    prm.w_in = w_in; prm.a_q_norm_g = a_q_norm_g; prm.a_k_norm_g = a_k_norm_g; prm.b_q_lat_norm_g = b_q_lat_norm_g; prm.b_kv_lat_norm_g = b_kv_lat_norm_g;
    prm.w_b_uq = w_b_uq; prm.w_b_ukv = w_b_ukv; prm.b_q_norm_g = b_q_norm_g; prm.b_k_norm_g = b_k_norm_g; prm.w_mem_kv = w_mem_kv;
    prm.c_q_norm_g = c_q_norm_g; prm.c_k_norm_g = c_k_norm_g; prm.w_branch = w_branch; prm.w_out = w_out;
    prm.ws = ws; prm.dout = dout;
#define GEMM(OutT, ACT, A_, lda_, B_, ldb_, C_, ldc_, M_, N_, K_, R_, ldr_) \
    nk_gemm<OutT, ACT><<<dim3(((N_) + 63) / 64, (M_) / 64), 256, 0, stream>>>(A_, lda_, B_, ldb_, C_, ldc_, M_, N_, K_, R_, ldr_)
    prm.phase_lo = 1; prm.phase_hi = 7;
    {
        (void)hipMemsetAsync(ws + WS_BAR, 0, XCD_BAR_WORDS * sizeof(unsigned), stream);
        void* args[] = {&prm};
        hipError_t e = hipLaunchCooperativeKernel((const void*)mega_kernel, dim3(256), dim3(512), args, MEGA_LDS + 16, stream);
        if (e != hipSuccess) fprintf(stderr, "cooperative launch failed: %s\n", hipGetErrorString(e));
    }
#undef GEMM
}
```

```cpp
#include <hip/hip_runtime.h>
#include <hip/hip_bf16.h>
#include <hip/hip_cooperative_groups.h>
#include <stdint.h>
#include <stdio.h>

typedef unsigned short u16;

constexpr int SEQ = 8192, DM = 2048, INW = 13712, NMEM = 256;
constexpr int OFF_AQ = 0, OFF_AK = 1024, OFF_AV = 1280, OFF_AZ = 1536, OFF_IQ = 2560, OFF_IK = 3584, OFF_IW = 3648,
              OFF_BCQ = 3664, OFF_BCKV = 4176, OFF_BKPE = 4432, OFF_BZ = 4496, OFF_CQ = 5520, OFF_CZ = 6544, OFF_G = 7568;
constexpr float EPS = 1e-6f;
constexpr float A_SCALE = 0.08838834764831845f;
constexpr float B_SCALE = 0.07216878364870322f;
constexpr float C_SCALE = 0.0625f;
constexpr int TOPK = 256;

constexpr size_t MiB = 1024 * 1024;
constexpr size_t WS_H = 0;
constexpr size_t WS_WINT = 32 * MiB;
constexpr size_t WS_WUQT = 86 * MiB;
constexpr size_t WS_WUKVT = 88 * MiB;
constexpr size_t WS_WMEMT = 89 * MiB;
constexpr size_t WS_WBRT = 97 * MiB;
constexpr size_t WS_WOUTT = 109 * MiB;
constexpr size_t WS_AQ = 117 * MiB;
constexpr size_t WS_KVA = 133 * MiB;
constexpr size_t WS_SZA = 141 * MiB;
constexpr size_t WS_IQ = 157 * MiB;
constexpr size_t WS_IK = 173 * MiB;
constexpr size_t WS_IW = 174 * MiB;
constexpr size_t WS_BKPE = 175 * MiB;
constexpr size_t WS_BCQ = 177 * MiB;
constexpr size_t WS_BCKV = 185 * MiB;
constexpr size_t WS_SZB = 189 * MiB;
constexpr size_t WS_CQ = 205 * MiB;
constexpr size_t WS_SZC = 221 * MiB;
constexpr size_t WS_G = 237 * MiB;
constexpr size_t WS_CK = 333 * MiB;
constexpr size_t WS_CV = WS_CK + 512 * 1024;
constexpr size_t WS_SEL = 334 * MiB;
constexpr size_t WS_CNT = 342 * MiB;
constexpr size_t WS_COS = 343 * MiB;
constexpr size_t WS_SIN = 344 * MiB;
constexpr size_t WS_UA = 345 * MiB;
constexpr size_t WS_UB = 361 * MiB;
constexpr size_t WS_UC = 377 * MiB;
constexpr size_t WS_MERGED = 393 * MiB;
constexpr size_t WS_HM = 425 * MiB;
constexpr size_t WS_END = 426 * MiB;
constexpr size_t WS_TMP_RAW = 345 * MiB;
constexpr size_t WS_TMP_MERGEDF = 0;
constexpr size_t DO_QB = 0, DO_KB = 24 * MiB, DO_VB = 48 * MiB;
constexpr size_t DO_H8 = 0;
constexpr size_t WS_WG8 = WS_WINT + 30 * MiB;
constexpr size_t WS_WS8 = WS_WINT + 42 * MiB;
constexpr size_t WS_WQ8 = WS_WINT + 48 * MiB;
constexpr size_t WS_WKV8 = WS_WINT + 4 * MiB;
constexpr float GATE_W_SCALE = 64.f;
constexpr float U8_SCALE = 16.f, WBR8_SCALE = 32.f, M8_SCALE = 32.f, WOUT8_SCALE = 64.f;
constexpr float MK8_SCALE = 8.f, MQ8_SCALE = 64.f;
constexpr float LAT8_SCALE = 16.f;
constexpr float G8_SCALE = 256.f;
constexpr float K8_SCALE = 8.f, Q8_SCALE = 64.f;
constexpr int KV_TOK = 768, KV_GRP = 384;
constexpr size_t WS_M8 = WS_H;

__device__ __forceinline__ float bf2f(u16 u) { return __uint_as_float(((unsigned)u) << 16); }
__device__ __forceinline__ u16 f2bf(float f) {
    unsigned u = __float_as_uint(f);
    u += 0x7FFFu + ((u >> 16) & 1u);
    return (u16)(u >> 16);
}
__device__ __forceinline__ float sigmoid_f(float x) { return __builtin_amdgcn_rcpf(1.f + __builtin_amdgcn_exp2f(-1.4426950408889634f * x)); }
__device__ __forceinline__ float silu_f(float x) { return x * sigmoid_f(x); }
__device__ __forceinline__ int rope_phys(int j, int second) { return (j >> 4) * 32 + (j & 15) + second * 16; }

__device__ __forceinline__ float block_sum_256(float v, float* red) {
    for (int o = 32; o > 0; o >>= 1) v += __shfl_xor(v, o);
    __syncthreads();
    if ((threadIdx.x & 63) == 0) red[threadIdx.x >> 6] = v;
    __syncthreads();
    return red[0] + red[1] + red[2] + red[3];
}

__global__ void __launch_bounds__(256) nk_rmsnorm_rows(const float* __restrict__ x, const float* __restrict__ g, u16* __restrict__ out, int C) {
    __shared__ float red[4];
    const float* xr = x + (size_t)blockIdx.x * C;
    float ss = 0.f;
    for (int c = threadIdx.x; c < C; c += 256) { float v = xr[c]; ss += v * v; }
    ss = block_sum_256(ss, red);
    float rinv = rsqrtf(ss / (float)C + EPS);
    for (int c = threadIdx.x; c < C; c += 256) out[(size_t)blockIdx.x * C + c] = f2bf(xr[c] * rinv * g[c]);
}

__global__ void __launch_bounds__(256) nk_rope_tables(const int* __restrict__ pos, float* __restrict__ cs, float* __restrict__ sn) {
    int i = blockIdx.x * 256 + threadIdx.x;
    if (i >= SEQ * 32) return;
    int t = i >> 5, j = i & 31;
    float inv_freq = 1.0f / powf(10000.f, (float)(2 * j) / 64.f);
    float ang = (float)pos[t] * inv_freq;
    cs[i] = cosf(ang); sn[i] = sinf(ang);
}

template <typename OutT> __device__ __forceinline__ void store_out(OutT* p, float v);
template <> __device__ __forceinline__ void store_out<float>(float* p, float v) { *p = v; }
template <> __device__ __forceinline__ void store_out<u16>(u16* p, float v) { *p = f2bf(v); }

template <typename OutT, int ACT>
__global__ void __launch_bounds__(256) nk_gemm(const u16* __restrict__ A, int lda, const float* __restrict__ B, int ldb, OutT* __restrict__ C, int ldc,
                        int M, int N, int K, const float* __restrict__ R, int ldr) {
    __shared__ float As[16][65];
    __shared__ float Bs[16][65];
    const int tid = threadIdx.x, tx = tid & 15, ty = tid >> 4;
    const int m0 = blockIdx.y * 64, n0 = blockIdx.x * 64;
    float acc[4][4] = {};
    for (int k0 = 0; k0 < K; k0 += 16) {
        {
            int r = tid >> 2, kk = (tid & 3) * 4;
            const u16* ap = A + (size_t)(m0 + r) * lda + k0 + kk;
            for (int e = 0; e < 4; ++e) As[kk + e][r] = bf2f(ap[e]);
        }
        {
            int kk = tid >> 4, nn = (tid & 15) * 4;
            const float* bp = B + (size_t)(k0 + kk) * ldb + n0 + nn;
            for (int e = 0; e < 4; ++e) Bs[kk][nn + e] = (n0 + nn + e < N) ? bp[e] : 0.f;
        }
        __syncthreads();
#pragma unroll
        for (int k = 0; k < 16; ++k) {
            float a[4], b[4];
#pragma unroll
            for (int i = 0; i < 4; ++i) { a[i] = As[k][ty + 16 * i]; b[i] = Bs[k][tx + 16 * i]; }
#pragma unroll
            for (int i = 0; i < 4; ++i)
#pragma unroll
                for (int j = 0; j < 4; ++j) acc[i][j] = fmaf(a[i], b[j], acc[i][j]);
        }
        __syncthreads();
    }
    for (int i = 0; i < 4; ++i)
        for (int j = 0; j < 4; ++j) {
            int row = m0 + ty + 16 * i, col = n0 + tx + 16 * j;
            if (col < N) {
                float v = acc[i][j];
                if (ACT == 1) v = silu_f(v);
                if (ACT == 2) v = sigmoid_f(v);
                if (ACT == 3) v += R[(size_t)row * ldr + col];
                store_out<OutT>(C + (size_t)row * ldc + col, v);
            }
        }
}

__global__ void __launch_bounds__(256) nk_headnorm(u16* __restrict__ buf, long row_stride, long head_stride, int nheads, int HD,
                            const float* __restrict__ g, float scale, int nrows) {
    int wid = (blockIdx.x * 256 + threadIdx.x) >> 6, lane = threadIdx.x & 63;
    if (wid >= nrows * nheads) return;
    int row = wid / nheads, h = wid % nheads;
    u16* p = buf + (size_t)row * row_stride + (size_t)h * head_stride;
    float ss = 0.f;
    for (int i = lane; i < HD; i += 64) { float v = bf2f(p[i]); ss += v * v; }
    for (int o = 32; o > 0; o >>= 1) ss += __shfl_xor(ss, o);
    float rinv = rsqrtf(ss / (float)HD + EPS) * scale;
    for (int i = lane; i < HD; i += 64) p[i] = f2bf(bf2f(p[i]) * rinv * g[i]);
}

__global__ void __launch_bounds__(256) nk_rownorm_bf16(u16* __restrict__ buf, int C, const float* __restrict__ g, int nrows) {
    int wid = (blockIdx.x * 256 + threadIdx.x) >> 6, lane = threadIdx.x & 63;
    if (wid >= nrows) return;
    u16* p = buf + (size_t)wid * C;
    float ss = 0.f;
    for (int i = lane; i < C; i += 64) { float v = bf2f(p[i]); ss += v * v; }
    for (int o = 32; o > 0; o >>= 1) ss += __shfl_xor(ss, o);
    float rinv = rsqrtf(ss / (float)C + EPS);
    for (int i = lane; i < C; i += 64) p[i] = f2bf(bf2f(p[i]) * rinv * g[i]);
}

__global__ void __launch_bounds__(256) nk_mla_q_finish(const float* __restrict__ qraw, const float* __restrict__ g, const float* __restrict__ cs,
                                const float* __restrict__ sn, u16* __restrict__ QB) {
    int wid = (blockIdx.x * 256 + threadIdx.x) >> 6, lane = threadIdx.x & 63;
    if (wid >= SEQ * 8) return;
    int t = wid >> 3, h = wid & 7;
    const float* p = qraw + (size_t)t * 1536 + h * 192;
    float v0 = p[lane], v1 = p[64 + lane], v2 = p[128 + lane];
    float ss = v0 * v0 + v1 * v1 + v2 * v2;
    for (int o = 32; o > 0; o >>= 1) ss += __shfl_xor(ss, o);
    float rinv = rsqrtf(ss / 192.f + EPS);
    v0 *= rinv * g[lane]; v1 *= rinv * g[64 + lane]; v2 *= rinv * g[128 + lane];
    float other = __shfl_xor(v2, 32);
    int j = lane & 31;
    float c = cs[t * 32 + j], s = sn[t * 32 + j];
    float r = (lane < 32) ? (v2 * c - other * s) : (v2 * c + other * s);
    u16* o = QB + ((size_t)h * SEQ + t) * 192;
    o[lane] = f2bf(v0 * B_SCALE); o[64 + lane] = f2bf(v1 * B_SCALE);
    o[128 + rope_phys(j, lane >> 5)] = f2bf(r * B_SCALE);
}
__global__ void __launch_bounds__(256) nk_mla_kv_finish(const float* __restrict__ kvraw, const float* __restrict__ bkpe, const float* __restrict__ g,
                                 const float* __restrict__ cs, const float* __restrict__ sn, u16* __restrict__ KB, u16* __restrict__ VB) {
    int wid = (blockIdx.x * 256 + threadIdx.x) >> 6, lane = threadIdx.x & 63;
    if (wid >= SEQ * 8) return;
    int t = wid >> 3, h = wid & 7;
    const float* p = kvraw + (size_t)t * 2048 + h * 256;
    float v0 = p[lane], v1 = p[64 + lane], v2 = bkpe[(size_t)t * 64 + lane];
    float ss = v0 * v0 + v1 * v1 + v2 * v2;
    for (int o = 32; o > 0; o >>= 1) ss += __shfl_xor(ss, o);
    float rinv = rsqrtf(ss / 192.f + EPS);
    v0 *= rinv * g[lane]; v1 *= rinv * g[64 + lane]; v2 *= rinv * g[128 + lane];
    float other = __shfl_xor(v2, 32);
    int j = lane & 31;
    float c = cs[t * 32 + j], s = sn[t * 32 + j];
    float r = (lane < 32) ? (v2 * c - other * s) : (v2 * c + other * s);
    u16* o = KB + ((size_t)h * SEQ + t) * 192;
    o[lane] = f2bf(v0); o[64 + lane] = f2bf(v1);
    o[128 + rope_phys(j, lane >> 5)] = f2bf(r);
    u16* vo = VB + ((size_t)h * SEQ + t) * 128;
    vo[lane] = f2bf(p[128 + lane]); vo[64 + lane] = f2bf(p[192 + lane]);
}

template <int DQK, int DV, int KT, bool CAUSAL>
__global__ void __launch_bounds__(256) nk_attn(const u16* __restrict__ Q, long q_rs, long q_hs, const u16* __restrict__ K, long k_rs, long k_hs,
                        const u16* __restrict__ V, long v_rs, long v_hs, int Skv, const u16* __restrict__ SZ, u16* __restrict__ U) {
    extern __shared__ float sm[];
    float* Qs = sm;
    float* Ks = Qs + 32 * (DQK + 1);
    float* Vs = Ks + KT * (DQK + 1);
    float* Ss = Vs + KT * DV;
    float* mrow = Ss + 32 * (KT + 1);
    float* lrow = mrow + 32;
    float* arow = lrow + 32;
    const int tid = threadIdx.x, q0 = blockIdx.x * 32, h = blockIdx.y;
    for (int e = tid; e < 32 * DQK; e += 256) { int r = e / DQK, d = e % DQK; Qs[r * (DQK + 1) + d] = bf2f(Q[(size_t)(q0 + r) * q_rs + (size_t)h * q_hs + d]); }
    if (tid < 32) { mrow[tid] = -1e30f; lrow[tid] = 0.f; }
    constexpr int NO = DV / 8;
    float o[NO];
#pragma unroll
    for (int j = 0; j < NO; ++j) o[j] = 0.f;
    const int qi = tid >> 3, sub = tid & 7;
    const int kend = CAUSAL ? (q0 + 32) : Skv;
    for (int k0 = 0; k0 < kend; k0 += KT) {
        __syncthreads();
        for (int e = tid; e < KT * DQK; e += 256) { int r = e / DQK, d = e % DQK; int key = k0 + r;
            Ks[r * (DQK + 1) + d] = (key < Skv) ? bf2f(K[(size_t)key * k_rs + (size_t)h * k_hs + d]) : 0.f; }
        for (int e = tid; e < KT * DV; e += 256) { int r = e / DV, d = e % DV; int key = k0 + r;
            Vs[r * DV + d] = (key < Skv) ? bf2f(V[(size_t)key * v_rs + (size_t)h * v_hs + d]) : 0.f; }
        __syncthreads();
        {
            constexpr int NP = KT / 8;
            float s[NP];
#pragma unroll
            for (int j = 0; j < NP; ++j) s[j] = 0.f;
            for (int d = 0; d < DQK; ++d) { float qv = Qs[qi * (DQK + 1) + d];
#pragma unroll
                for (int j = 0; j < NP; ++j) s[j] = fmaf(qv, Ks[(sub + 8 * j) * (DQK + 1) + d], s[j]); }
#pragma unroll
            for (int j = 0; j < NP; ++j) { int key = k0 + sub + 8 * j;
                bool ok = key < Skv && (!CAUSAL || key <= q0 + qi);
                Ss[qi * (KT + 1) + sub + 8 * j] = ok ? s[j] : -INFINITY; }
        }
        __syncthreads();
        if (tid < 32) {
            float m = mrow[tid], mx = m;
            for (int k = 0; k < KT; ++k) mx = fmaxf(mx, Ss[tid * (KT + 1) + k]);
            float alpha = __expf(m - mx), sum = 0.f;
            for (int k = 0; k < KT; ++k) { float p = __expf(Ss[tid * (KT + 1) + k] - mx); Ss[tid * (KT + 1) + k] = p; sum += p; }
            mrow[tid] = mx; lrow[tid] = lrow[tid] * alpha + sum; arow[tid] = alpha;
        }
        __syncthreads();
        {
            float alpha = arow[qi];
#pragma unroll
            for (int j = 0; j < NO; ++j) o[j] *= alpha;
            for (int k = 0; k < KT; ++k) { float p = Ss[qi * (KT + 1) + k];
#pragma unroll
                for (int j = 0; j < NO; ++j) o[j] = fmaf(p, Vs[k * DV + sub + 8 * j], o[j]); }
        }
    }
    __syncthreads();
    float linv = 1.f / lrow[qi];
#pragma unroll
    for (int j = 0; j < NO; ++j) { int d = sub + 8 * j; size_t idx = (size_t)(q0 + qi) * 1024 + h * DV + d;
        U[idx] = f2bf(o[j] * linv * bf2f(SZ[idx])); }
}

__device__ __forceinline__ unsigned ord_key(float f) { unsigned u = __float_as_uint(f); return (u & 0x80000000u) ? ~u : (u | 0x80000000u); }
__global__ void __launch_bounds__(256) nk_indexer_topk(const u16* __restrict__ IQ, const u16* __restrict__ IK, const float* __restrict__ IW,
                                int* __restrict__ SEL, int* __restrict__ CNT) {
    __shared__ unsigned keys[SEQ];
    __shared__ float qs[16 * 64];
    __shared__ float ws[16];
    __shared__ int cnt_sh;
    __shared__ int wsum[8];
    const int t = blockIdx.x, tid = threadIdx.x, n = t + 1;
    int* sel = SEL + (size_t)t * TOPK;
    if (n <= TOPK) { for (int i = tid; i < n; i += 256) sel[i] = i; if (tid == 0) CNT[t] = n; return; }
    for (int e = tid; e < 1024; e += 256) qs[e] = bf2f(IQ[(size_t)t * 1024 + e]);
    if (tid < 16) ws[tid] = IW[(size_t)t * 16 + tid];
    __syncthreads();
    for (int s = tid; s < n; s += 256) {
        float kv[64];
        const u16* kp = IK + (size_t)s * 64;
#pragma unroll
        for (int d = 0; d < 64; ++d) kv[d] = bf2f(kp[d]);
        float sc = 0.f;
        for (int h = 0; h < 16; ++h) { float dot = 0.f;
#pragma unroll
            for (int d = 0; d < 64; ++d) dot = fmaf(qs[h * 64 + d], kv[d], dot);
            sc = fmaf(ws[h], fmaxf(dot, 0.f), sc); }
        keys[s] = ord_key(sc);
    }
    __syncthreads();
    unsigned prefix = 0; int need = TOPK;
    for (int bit = 31; bit >= 0; --bit) {
        if (tid == 0) cnt_sh = 0;
        __syncthreads();
        unsigned want = (prefix >> bit) | 1u;
        int c = 0;
        for (int s = tid; s < n; s += 256) c += ((keys[s] >> bit) == want) ? 1 : 0;
        for (int o = 32; o > 0; o >>= 1) c += __shfl_xor(c, o);
        if ((tid & 63) == 0) atomicAdd(&cnt_sh, c);
        __syncthreads();
        int tot = cnt_sh;
        if (tot >= need) prefix |= (1u << bit); else need -= tot;
        __syncthreads();
    }
    int base_sel = 0, base_eq = 0;
    for (int c0 = 0; c0 < n; c0 += 256) {
        int s = c0 + tid; bool in = s < n;
        unsigned kk = in ? keys[s] : 0u;
        bool gt = in && kk > prefix, eq = in && kk == prefix;
        unsigned long long beq = __ballot(eq);
        int w = tid >> 6, lane = tid & 63;
        if (lane == 0) wsum[w] = __popcll(beq);
        __syncthreads();
        int eqpre = base_eq + __popcll(beq & ((1ull << lane) - 1ull));
        for (int i = 0; i < w; ++i) eqpre += wsum[i];
        int eqtot = wsum[0] + wsum[1] + wsum[2] + wsum[3];
        bool selv = gt || (eq && eqpre < need);
        unsigned long long bs = __ballot(selv);
        if (lane == 0) wsum[4 + w] = __popcll(bs);
        __syncthreads();
        int pos = base_sel + __popcll(bs & ((1ull << lane) - 1ull));
        for (int i = 0; i < w; ++i) pos += wsum[4 + i];
        if (selv && pos < TOPK) sel[pos] = s;
        base_sel += wsum[4] + wsum[5] + wsum[6] + wsum[7];
        base_eq += eqtot;
        __syncthreads();
    }
    if (tid == 0) CNT[t] = TOPK;
}

__device__ __forceinline__ int t5_bucket(int dist) {
    int nn = dist > 0 ? dist : 0;
    if (nn < 16) return nn;
    float nf = (float)nn;
    int large = 16 + (int)(logf(nf / 16.f) / 2.0794415416798357f * 16.f);
    return large < 31 ? large : 31;
}
__global__ void __launch_bounds__(256) nk_sparse_attn(const u16* __restrict__ AQ, const u16* __restrict__ KVA, const int* __restrict__ SEL, const int* __restrict__ CNT,
                               const int* __restrict__ pos, const float* __restrict__ relb, const u16* __restrict__ SZA, u16* __restrict__ UA) {
    __shared__ float qs[1024];
    __shared__ int sl[TOPK];
    __shared__ int bk[TOPK];
    __shared__ float pr[TOPK];
    __shared__ float red[4];
    const int t = blockIdx.x, tid = threadIdx.x;
    const int cnt = CNT[t];
    for (int e = tid; e < 1024; e += 256) qs[e] = bf2f(AQ[(size_t)t * 1024 + e]);
    if (tid < cnt) { int s = SEL[(size_t)t * TOPK + tid]; sl[tid] = s; bk[tid] = t5_bucket(pos[t] - pos[s]); }
    __syncthreads();
    for (int h = 0; h < 8; ++h) {
        const int g = h >> 2;
        float logit = -INFINITY;
        if (tid < cnt) {
            const u16* kp = KVA + ((size_t)sl[tid] * 2 + g) * 256;
            float dot = 0.f;
            for (int d = 0; d < 128; ++d) dot = fmaf(qs[h * 128 + d], bf2f(kp[d]), dot);
            logit = dot + relb[bk[tid] * 8 + h];
        }
        float mx = logit;
        for (int o = 32; o > 0; o >>= 1) mx = fmaxf(mx, __shfl_xor(mx, o));
        __syncthreads();
        if ((tid & 63) == 0) red[tid >> 6] = mx;
        __syncthreads();
        mx = fmaxf(fmaxf(red[0], red[1]), fmaxf(red[2], red[3]));
        float p = (tid < cnt) ? __expf(logit - mx) : 0.f;
        pr[tid] = p;
        float sum = block_sum_256(p, red);
        __syncthreads();
        if (tid < 128) {
            float acc = 0.f;
            for (int k = 0; k < cnt; ++k) acc = fmaf(pr[k], bf2f(KVA[((size_t)sl[k] * 2 + g) * 256 + 128 + tid]), acc);
            size_t idx = (size_t)t * 1024 + h * 128 + tid;
            UA[idx] = f2bf(acc / sum * bf2f(SZA[idx]));
        }
        __syncthreads();
    }
}

__global__ void __launch_bounds__(256) nk_merge(const float* __restrict__ Y, const u16* __restrict__ G, int n, float* __restrict__ MF, u16* __restrict__ MERGED) {
    size_t i = (size_t)blockIdx.x * 256 + threadIdx.x;
    if (i >= (size_t)SEQ * DM) return;
    size_t t = i / DM, d = i % DM;
    float v = bf2f(G[t * 6144 + (size_t)n * DM + d]) * Y[i];
    if (n > 0) v += MF[i];
    MF[i] = v;
    if (n == 2) MERGED[i] = f2bf(v);
}


typedef short bf16x8 __attribute__((ext_vector_type(8)));
typedef float f32x4 __attribute__((ext_vector_type(4)));
typedef float f32x16 __attribute__((ext_vector_type(16)));
typedef unsigned u32x4 __attribute__((ext_vector_type(4)));
typedef unsigned u32x2 __attribute__((ext_vector_type(2)));

constexpr int DBG = 0;
constexpr size_t WS_DBG = WS_CNT + 240 * 1024;
#define DBG_T() ((long long)__builtin_amdgcn_s_memtime())
constexpr size_t WS_LATQ = WS_CNT + 64 * 1024;
constexpr size_t WS_LATKV = WS_CNT + 128 * 1024;
constexpr size_t WS_PESS = WS_CNT + 192 * 1024;
constexpr size_t WS_BKT = WS_CNT + 224 * 1024;
constexpr int NT_IN = 54;
constexpr int WINT_ROWS = NT_IN * 256;

struct Params {
    const float* x; const float* mem; const int* positions; const float* rel_bias; const float* norm_g; const float* mem_norm_g;
    const float* w_in; const float* a_q_norm_g; const float* a_k_norm_g; const float* b_q_lat_norm_g; const float* b_kv_lat_norm_g;
    const float* w_b_uq; const float* w_b_ukv; const float* b_q_norm_g; const float* b_k_norm_g; const float* w_mem_kv;
    const float* c_q_norm_g; const float* c_k_norm_g; const float* w_branch; const float* w_out;
    char* ws; char* dout;
    int phase_lo, phase_hi;
};

__device__ __forceinline__ int opaque_tid() { int t = threadIdx.x; asm volatile("" : "+v"(t)); return t; }
typedef float f32x2_cv __attribute__((ext_vector_type(2)));
typedef __bf16 bf16x2_cv __attribute__((ext_vector_type(2)));
__device__ __forceinline__ unsigned cvtpk_b(float lo, float hi) { f32x2_cv v = {lo, hi}; bf16x2_cv r = __builtin_convertvector(v, bf16x2_cv); return *reinterpret_cast<unsigned*>(&r); }
#define DPP_F(v, ctrl) __int_as_float(__builtin_amdgcn_update_dpp(0, __float_as_int(v), (ctrl), 0xf, 0xf, true))
__device__ __forceinline__ float row_sum16(float v) { v += DPP_F(v, 0xB1); v += DPP_F(v, 0x4E); v += DPP_F(v, 0x141); v += DPP_F(v, 0x140); return v; }
__device__ __forceinline__ float wave_sum32(float v) {
    v = row_sum16(v);
    const auto r = __builtin_amdgcn_permlane16_swap(__float_as_uint(v), __float_as_uint(v), false, false);
    return __uint_as_float(r[0]) + __uint_as_float(r[1]);
}
__device__ __forceinline__ float wave_sum64(float v) {
    v = wave_sum32(v);
    const auto r = __builtin_amdgcn_permlane32_swap(__float_as_uint(v), __float_as_uint(v), false, false);
    return __uint_as_float(r[0]) + __uint_as_float(r[1]);
}
__device__ __forceinline__ float xchg_xor4(float v) {
    const int a = __builtin_amdgcn_update_dpp(0, __float_as_int(v), 0x114, 0xf, 0xa, false);
    return __int_as_float(__builtin_amdgcn_update_dpp(a, __float_as_int(v), 0x104, 0xf, 0x5, false));
}
__device__ __forceinline__ float max_xor16_32(float v) {
    auto r = __builtin_amdgcn_permlane16_swap(__float_as_uint(v), __float_as_uint(v), false, false);
    v = fmaxf(__uint_as_float(r[0]), __uint_as_float(r[1]));
    r = __builtin_amdgcn_permlane32_swap(__float_as_uint(v), __float_as_uint(v), false, false);
    return fmaxf(__uint_as_float(r[0]), __uint_as_float(r[1]));
}
__device__ __forceinline__ float sum_xor16_32(float v) {
    auto r = __builtin_amdgcn_permlane16_swap(__float_as_uint(v), __float_as_uint(v), false, false);
    v = __uint_as_float(r[0]) + __uint_as_float(r[1]);
    r = __builtin_amdgcn_permlane32_swap(__float_as_uint(v), __float_as_uint(v), false, false);
    return __uint_as_float(r[0]) + __uint_as_float(r[1]);
}
__device__ __forceinline__ unsigned cvtpk(float lo, float hi) {
    unsigned r; asm volatile("v_cvt_pk_bf16_f32 %0, %1, %2" : "=v"(r) : "v"(lo), "v"(hi)); return r;
}

__device__ __forceinline__ int win_srccol(int n) {
    if (n < 3584) return n;
    if (n < 3840) { int j = n - 3584; if (j < 80) return 3584 + j; if (j < 144) return 4432 + (j - 80); return -1; }
    if (n < 4352) return 3664 + (n - 3840);
    if (n < 4608) return 4176 + (n - 4352);
    return 4496 + (n - 4608);
}
__device__ __forceinline__ int wuq_srccol(int n) {
    int h = n >> 8, j = n & 255;
    if (j < 128) return h * 192 + j;
    if (j < 192) { int p = j - 128, blk = p >> 5, within = p & 31, second = within >> 4, jj = blk * 16 + (within & 15);
        return h * 192 + 128 + second * 32 + jj; }
    return -1;
}
constexpr int PREP_T0 = 32 * 216, PREP_T1 = PREP_T0 + 8 * 32, PREP_T2 = PREP_T1 + 4 * 32, PREP_T3 = PREP_T2 + 32 * 32, PREP_T4 = PREP_T3 + 3 * 16 * 32, PREP_T5 = PREP_T4 + 32 * 32;
__device__ __forceinline__ void prep_weight_tiles(const Params& p, const int t_first, const int t_end, const int t_stride, const int lane) {
    constexpr int T0 = PREP_T0, T1 = PREP_T1, T2 = PREP_T2, T3 = PREP_T3, T4 = PREP_T4;
    for (int T = t_first; T < t_end; T += t_stride) {
        const float* W; int ldw, K, kt, mode = 0; const float* gs = nullptr; u16* dst; float f8s = 0.f;
        int tt;
        if (T < T0) { tt = T; W = p.w_in; ldw = INW; K = 2048; kt = 32; mode = 1; dst = (u16*)(p.ws + WS_WINT); }
        else if (T < T1) { tt = T - T0; W = p.w_b_uq; ldw = 1536; K = 512; kt = 8; mode = 2; gs = p.b_q_lat_norm_g; dst = (u16*)(p.ws + WS_WUQT); f8s = GATE_W_SCALE; }
        else if (T < T2) { tt = T - T1; W = p.w_b_ukv; ldw = 2048; K = 256; kt = 4; gs = p.b_kv_lat_norm_g; dst = (u16*)(p.ws + WS_WUKVT); f8s = GATE_W_SCALE; }
        else if (T < T3) { tt = T - T2; W = p.w_mem_kv; ldw = 2048; K = 2048; kt = 32; dst = (u16*)(p.ws + WS_WMEMT); f8s = GATE_W_SCALE; }
        else if (T < T4) { tt = T - T3; int n = tt / 512; tt -= n * 512; W = p.w_branch + (size_t)n * 1024 * DM; ldw = DM; K = 1024; kt = 16;
                           dst = (u16*)(p.ws + WS_WBRT + (size_t)n * DM * 1024); f8s = WBR8_SCALE; }
        else { tt = T - T4; W = p.w_out; ldw = DM; K = 2048; kt = 32; dst = (u16*)(p.ws + WS_WOUTT); f8s = WOUT8_SCALE; }
        const int k0 = (tt % kt) * 64, n0 = (tt / kt) * 64, n = n0 + lane;
        int sc = n; if (mode == 1) sc = win_srccol(n); else if (mode == 2) sc = wuq_srccol(n);
        const float* src_p = W + (size_t)k0 * ldw + (sc >= 0 ? sc : 0);
        float v[64];
#pragma unroll
        for (int k = 0; k < 64; ++k) v[k] = __builtin_nontemporal_load(src_p + (size_t)k * ldw);
        if (sc < 0) {
#pragma unroll
            for (int k = 0; k < 64; ++k) v[k] = 0.f;
        }
        if (gs) {
#pragma unroll
            for (int k = 0; k < 64; ++k) v[k] *= gs[k0 + k];
        }
        const bool silu8 = (mode == 1) && ((n0 >= 1536 && n0 < 2560) || (n0 >= 4608 && n0 < 5632) || (n0 >= 6656 && n0 < 7680));
        const bool q8 = (mode == 1) && (n0 < 1024 || (n0 >= 5632 && n0 < 6656));
        const bool kv8 = (mode == 1) && (n0 >= 1024 && n0 < 1536);
        if ((mode == 1 && n0 >= 7680) || silu8 || q8 || kv8 || f8s > 0.f) {
            const int srow = (n0 < 2560) ? (n - 1536) : (n0 < 5632 ? 1024 + (n - 4608) : 2048 + (n - 6656));
            const int qrow8 = (n0 < 1024) ? n : 1024 + (n - 5632);
            char* dp8 = (f8s > 0.f) ? ((char*)dst + (size_t)n * K + k0) : kv8 ? (p.ws + WS_WKV8 + (size_t)(n - 1024) * 2048 + k0) : (q8 ? (p.ws + WS_WQ8 + (size_t)qrow8 * 2048 + k0) : (silu8 ? (p.ws + WS_WS8 + (size_t)srow * 2048 + k0) : (p.ws + WS_WG8 + (size_t)(n - 7680) * 2048 + k0)));
            const float GS = (f8s > 0.f) ? f8s : GATE_W_SCALE;
#pragma unroll
            for (int k16 = 0; k16 < 4; ++k16) { int q[4];
#pragma unroll
                for (int j = 0; j < 4; ++j) { int w8 = 0; w8 = __builtin_amdgcn_cvt_pk_fp8_f32(v[16 * k16 + 4 * j] * GS, v[16 * k16 + 4 * j + 1] * GS, w8, false);
                    w8 = __builtin_amdgcn_cvt_pk_fp8_f32(v[16 * k16 + 4 * j + 2] * GS, v[16 * k16 + 4 * j + 3] * GS, w8, true); q[j] = w8; }
                *(u32x4*)(dp8 + 16 * k16) = (u32x4){(unsigned)q[0], (unsigned)q[1], (unsigned)q[2], (unsigned)q[3]}; }
            continue;
        }
        u16* dp = dst + (size_t)n * K + k0;
#pragma unroll
        for (int k8 = 0; k8 < 8; ++k8) { u32x4 w4 = {cvtpk(v[8 * k8 + 0], v[8 * k8 + 1]), cvtpk(v[8 * k8 + 2], v[8 * k8 + 3]), cvtpk(v[8 * k8 + 4], v[8 * k8 + 5]), cvtpk(v[8 * k8 + 6], v[8 * k8 + 7])};
            *(u32x4*)(dp + 8 * k8) = w4; }
    }
}
__device__ __forceinline__ void prep_tiles_late(const Params& p, const int t_first, const int t_stride, const int lane) {
    for (int T = t_first; T < PREP_T5; T += 2 * t_stride) {
        const float* src_[2]; char* dst_[2]; float gs_[2]; bool on_[2];
#pragma unroll
        for (int q = 0; q < 2; ++q) {
            const int Tq = T + q * t_stride; on_[q] = Tq < PREP_T5;
            const int Tc = on_[q] ? Tq : PREP_T5 - 1;
            const float* W; int K, kt, tt; char* dst;
            if (Tc < PREP_T4) { tt = Tc - PREP_T3; const int n = tt / 512; tt -= n * 512; W = p.w_branch + (size_t)n * 1024 * DM; K = 1024; kt = 16; dst = p.ws + WS_WBRT + (size_t)n * DM * 1024; gs_[q] = WBR8_SCALE; }
            else { tt = Tc - PREP_T4; W = p.w_out; K = 2048; kt = 32; dst = p.ws + WS_WOUTT; gs_[q] = WOUT8_SCALE; }
            const int k0 = (tt % kt) * 64, n = (tt / kt) * 64 + lane;
            src_[q] = W + (size_t)k0 * DM + n; dst_[q] = dst + (size_t)n * K + k0;
        }
        float va[64], vb[64];
#pragma unroll
        for (int k = 0; k < 64; ++k) va[k] = __builtin_nontemporal_load(src_[0] + (size_t)k * DM);
#pragma unroll
        for (int k = 0; k < 64; ++k) vb[k] = __builtin_nontemporal_load(src_[1] + (size_t)k * DM);
#pragma unroll
        for (int k16 = 0; k16 < 4; ++k16) { int w[4];
#pragma unroll
            for (int j = 0; j < 4; ++j) { int w8 = 0; w8 = __builtin_amdgcn_cvt_pk_fp8_f32(va[16 * k16 + 4 * j] * gs_[0], va[16 * k16 + 4 * j + 1] * gs_[0], w8, false);
                w8 = __builtin_amdgcn_cvt_pk_fp8_f32(va[16 * k16 + 4 * j + 2] * gs_[0], va[16 * k16 + 4 * j + 3] * gs_[0], w8, true); w[j] = w8; }
            *(u32x4*)(dst_[0] + 16 * k16) = (u32x4){(unsigned)w[0], (unsigned)w[1], (unsigned)w[2], (unsigned)w[3]}; }
        if (on_[1]) {
#pragma unroll
            for (int k16 = 0; k16 < 4; ++k16) { int w[4];
#pragma unroll
                for (int j = 0; j < 4; ++j) { int w8 = 0; w8 = __builtin_amdgcn_cvt_pk_fp8_f32(vb[16 * k16 + 4 * j] * gs_[1], vb[16 * k16 + 4 * j + 1] * gs_[1], w8, false);
                    w8 = __builtin_amdgcn_cvt_pk_fp8_f32(vb[16 * k16 + 4 * j + 2] * gs_[1], vb[16 * k16 + 4 * j + 3] * gs_[1], w8, true); w[j] = w8; }
                *(u32x4*)(dst_[1] + 16 * k16) = (u32x4){(unsigned)w[0], (unsigned)w[1], (unsigned)w[2], (unsigned)w[3]}; }
        }
    }
}
__device__ __forceinline__ void phase_prep(const Params& p) {
    extern __shared__ __attribute__((aligned(16))) char smem[];
    int tid = opaque_tid(); int wid = tid >> 6, lane = tid & 63;
    {
        const int r_first = (int)gridDim.x * 8 - 1 - ((int)blockIdx.x * 8 + wid), r_step = (int)gridDim.x * 8;
        f32x4 vn[8];
#define PREP_SRC(r_) ((r_) < SEQ ? p.x + (size_t)(r_) * DM : p.mem + (size_t)((r_) - SEQ) * DM)
        if (r_first < SEQ + NMEM) {
            const float* s0 = PREP_SRC(r_first);
#pragma unroll
            for (int i = 0; i < 8; ++i) vn[i] = __builtin_nontemporal_load(((const f32x4*)s0) + lane + 64 * i);
        }
        for (int r = r_first; r < SEQ + NMEM; r += r_step) {
            const float* g; u16* dst;
            if (r < SEQ) { g = p.norm_g; dst = (u16*)(p.ws + WS_H) + (size_t)r * DM; }
            else { g = p.mem_norm_g; dst = (u16*)(p.ws + WS_HM) + (size_t)(r - SEQ) * DM; }
            f32x4 v[8]; float ss = 0.f;
#pragma unroll
            for (int i = 0; i < 8; ++i) { v[i] = vn[i]; ss += v[i][0] * v[i][0] + v[i][1] * v[i][1] + v[i][2] * v[i][2] + v[i][3] * v[i][3]; }
            const bool more = r + r_step < SEQ + NMEM;
            if (more) { const float* sn_ = PREP_SRC(r + r_step);
#pragma unroll
                for (int i = 0; i < 8; ++i) vn[i] = __builtin_nontemporal_load(((const f32x4*)sn_) + lane + 64 * i); }
            ss = wave_sum64(ss);
            const float rinv = rsqrtf(ss / (float)DM + EPS);
            f32x4 gg[8];
#pragma unroll
            for (int i = 0; i < 8; ++i) gg[i] = ((const f32x4*)g)[lane + 64 * i];
            asm volatile("s_waitcnt vmcnt(0)" : "+v"(vn[0]), "+v"(vn[1]), "+v"(vn[2]), "+v"(vn[3]), "+v"(vn[4]), "+v"(vn[5]), "+v"(vn[6]), "+v"(vn[7]) :: "memory");
#pragma unroll
            for (int i = 0; i < 8; ++i) {
                const float h0 = v[i][0] * rinv * gg[i][0], h1 = v[i][1] * rinv * gg[i][1], h2 = v[i][2] * rinv * gg[i][2], h3 = v[i][3] * rinv * gg[i][3];
                int w8 = 0; w8 = __builtin_amdgcn_cvt_pk_fp8_f32(h0, h1, w8, false); w8 = __builtin_amdgcn_cvt_pk_fp8_f32(h2, h3, w8, true);
                if (r < SEQ) { u32x2 w = {cvtpk(h0, h1), cvtpk(h2, h3)};
                    *(u32x2*)(dst + 4 * (lane + 64 * i)) = w;
                    *(int*)(p.dout + DO_H8 + (size_t)r * DM + 4 * (lane + 64 * i)) = w8; }
                else *(int*)(p.ws + WS_HM + (size_t)(r - SEQ) * DM + 4 * (lane + 64 * i)) = w8; }
        }
#undef PREP_SRC
    }
    {
        tid = opaque_tid();
        if (blockIdx.x == 0 && tid < 128) ((unsigned char*)(p.ws + WS_BKT))[tid] = (unsigned char)t5_bucket(tid);
        float* cs = (float*)(p.ws + WS_COS); float* sn = (float*)(p.ws + WS_SIN);
        for (int i = blockIdx.x * 512 + tid; i < SEQ * 32; i += gridDim.x * 512) {
            int t = i >> 5, j = i & 31;
            float inv_freq = 1.0f / powf(10000.f, (float)(2 * j) / 64.f);
            float ang = (float)p.positions[t] * inv_freq;
            cs[i] = cosf(ang); sn[i] = sinf(ang);
        }
    }
    tid = opaque_tid(); wid = __builtin_amdgcn_readfirstlane(tid >> 6); lane = tid & 63;
    prep_weight_tiles(p, blockIdx.x * 8 + wid, PREP_T3, gridDim.x * 8, lane);
}

constexpr int G_HT = 128 * 64;
__device__ __forceinline__ int g_lds_byte(int r, int c) { int st = (r >> 4) * 2 + (c >> 5), rr = r & 15, cc = c & 31, ob = rr * 64 + cc * 2; return st * 1024 + (ob ^ (((ob >> 9) & 1) << 5)); }
__device__ __forceinline__ void g_stage_rc(int b, int& R, int& C) { int st = b / 1024, sb = b % 1024, swz = sb ^ (((sb >> 9) & 1) << 5); R = (st >> 1) * 16 + swz / 64; C = (st & 1) * 32 + (swz % 64) / 2; }

typedef int i32x8 __attribute__((ext_vector_type(8)));
template <bool FP8>
__device__ __forceinline__ void gemm_kloop(const u16* __restrict__ A, const u16* __restrict__ Bt, const int K, const int brow, const int bcol,
                                           f32x4 (&acc)[2][2][4][2]) {
    extern __shared__ __attribute__((aligned(16))) char smem[];
    u16* shm = (u16*)smem;
#define SA(b, h) (shm + ((b) * 2 + (h)) * G_HT)
#define SB(b, h) (shm + (4 + (b) * 2 + (h)) * G_HT)
#define STAGE(P, RS, br, kt) do { const int _so = ((br) * K + (kt) * 64) * 2; \
    __builtin_amdgcn_raw_ptr_buffer_load_lds(RS, (__attribute__((address_space(3))) void*)((char*)(P) + wv_ * 1024), 16, voff0, _so, 0, 0); \
    __builtin_amdgcn_raw_ptr_buffer_load_lds(RS, (__attribute__((address_space(3))) void*)((char*)(P) + wv_ * 1024 + 8192), 16, voff1, _so, 0, 0); } while (0)
#define LDA(dst, b, h) do { if constexpr (FP8) { for (int m = 0; m < 4; ++m) { \
      const u32x4 lo_ = *reinterpret_cast<const u32x4*>((char*)SA(b, h) + g_lds_byte(wr * 64 + m * 16 + fr, fq * 8)); \
      const u32x4 hi_ = *reinterpret_cast<const u32x4*>((char*)SA(b, h) + g_lds_byte(wr * 64 + m * 16 + fr, 32 + fq * 8)); \
      dst##8[m] = __builtin_shufflevector(lo_, hi_, 0, 1, 2, 3, 4, 5, 6, 7); } } \
    else { for (int m = 0; m < 4; ++m) for (int k = 0; k < 2; ++k) \
      dst[m][k] = *reinterpret_cast<const bf16x8*>((char*)SA(b, h) + g_lds_byte(wr * 64 + m * 16 + fr, k * 32 + fq * 8)); } } while (0)
#define LDB(dst, b, h) do { if constexpr (FP8) { for (int n = 0; n < 2; ++n) { \
      const u32x4 lo_ = *reinterpret_cast<const u32x4*>((char*)SB(b, h) + g_lds_byte(wc * 32 + n * 16 + fr, fq * 8)); \
      const u32x4 hi_ = *reinterpret_cast<const u32x4*>((char*)SB(b, h) + g_lds_byte(wc * 32 + n * 16 + fr, 32 + fq * 8)); \
      dst##8[n] = __builtin_shufflevector(lo_, hi_, 0, 1, 2, 3, 4, 5, 6, 7); } } \
    else { for (int n = 0; n < 2; ++n) for (int k = 0; k < 2; ++k) \
      dst[n][k] = *reinterpret_cast<const bf16x8*>((char*)SB(b, h) + g_lds_byte(wc * 32 + n * 16 + fr, k * 32 + fq * 8)); } } while (0)
#define MMA(ai, bj, At_, Bt_) do { __builtin_amdgcn_s_setprio(1); \
    if constexpr (FP8) { for (int m = 0; m < 4; ++m) for (int n = 0; n < 2; ++n) \
        asm volatile("s_nop 1\n\tv_mfma_scale_f32_16x16x128_f8f6f4 %0, %1, %2, %0, %3, %3 op_sel_hi:[0,0,0]" \
                     : "+v"(acc[ai][bj][m][n]) : "v"(At_##8[m]), "v"(Bt_##8[n]), "v"(sc8_)); } \
    else { for (int m = 0; m < 4; ++m) for (int n = 0; n < 2; ++n) for (int k = 0; k < 2; ++k) \
      acc[ai][bj][m][n] = __builtin_amdgcn_mfma_f32_16x16x32_bf16(At_[m][k], Bt_[n][k], acc[ai][bj][m][n], 0, 0, 0); } \
      \
    asm volatile("" :: "v"(acc[ai][bj][0][0]), "v"(acc[ai][bj][0][1]), "v"(acc[ai][bj][1][0]), "v"(acc[ai][bj][1][1]), \
                      "v"(acc[ai][bj][2][0]), "v"(acc[ai][bj][2][1]), "v"(acc[ai][bj][3][0]), "v"(acc[ai][bj][3][1])); \
    __builtin_amdgcn_s_setprio(0); } while (0)
#define WAIT_V(n) asm volatile("s_waitcnt vmcnt(" #n ")" ::: "memory")
#define WAIT_L(n) asm volatile("s_waitcnt lgkmcnt(" #n ")" ::: "memory")
#define BAR __builtin_amdgcn_s_barrier()
#define SCHED __builtin_amdgcn_sched_barrier(0)
    const int tid_ = opaque_tid();
    const int wv_ = __builtin_amdgcn_readfirstlane(tid_ >> 6);
    const int wid = tid_ >> 6, lane = tid_ & 63, wr = wid >> 2, wc = wid & 3, fr = lane & 15, fq = lane >> 4;
#pragma unroll
    for (int a = 0; a < 2; ++a)
#pragma unroll
        for (int b = 0; b < 2; ++b)
#pragma unroll
            for (int m = 0; m < 4; ++m)
#pragma unroll
                for (int n = 0; n < 2; ++n) acc[a][b][m][n] = f32x4{0.f, 0.f, 0.f, 0.f};
    bf16x8 At[4][2], B0[2][2], B1[2][2];
    typedef unsigned u32x8 __attribute__((ext_vector_type(8)));
    u32x8 At8[4], B08[2], B18[2];
    int sc8_ = 0x7f7f7f7f; asm volatile("" : "+v"(sc8_));
    const int nt = K / 64;
    const __amdgpu_buffer_rsrc_t rsA = __builtin_amdgcn_make_buffer_rsrc((void*)A, (short)0, 0x7fffffff, 0x00020000);
    const __amdgpu_buffer_rsrc_t rsB = __builtin_amdgcn_make_buffer_rsrc((void*)Bt, (short)0, 0x7fffffff, 0x00020000);
    int voff0, voff1;
    { int _r, _c; g_stage_rc(tid_ * 16, _r, _c); voff0 = (_r * K + _c) * 2; g_stage_rc(tid_ * 16 + 8192, _r, _c); voff1 = (_r * K + _c) * 2; }
    STAGE(SB(0, 0), rsB, bcol, 0); STAGE(SA(0, 0), rsA, brow, 0);
    STAGE(SB(0, 1), rsB, bcol + 128, 0); STAGE(SA(0, 1), rsA, brow + 128, 0);
    if (wr == 1) BAR;
    WAIT_V(4); BAR;
    STAGE(SB(1, 0), rsB, bcol, 1); STAGE(SA(1, 0), rsA, brow, 1); STAGE(SB(1, 1), rsB, bcol + 128, 1);
    WAIT_V(6); BAR;
#define MMA_LO(ai, bj, At_, Bt_) MMA(ai, bj, At_, Bt_)
#define LDA_LO(dst, b, h) LDA(dst, b, h)
    for (int t = 0; t < nt - 2; t += 2) {
        int tq_ = tid_; asm volatile("" : "+v"(tq_));
        const int wid = tq_ >> 6, lane = tq_ & 63, wr = wid >> 2, wc = wid & 3, fr = lane & 15, fq = lane >> 4;
        LDB(B0, 0, 0); SCHED; LDA(At, 0, 0); STAGE(SA(1, 1), rsA, brow + 128, t + 1);
        WAIT_L(8); BAR; WAIT_L(0); MMA(0, 0, At, B0); BAR; SCHED;
        LDB(B1, 0, 1); STAGE(SB(0, 0), rsB, bcol, t + 2);
        BAR; WAIT_L(0); MMA(0, 1, At, B1); BAR;
        LDA_LO(At, 0, 1); STAGE(SA(0, 0), rsA, brow, t + 2);
        BAR; WAIT_L(0); MMA_LO(1, 0, At, B0); BAR; SCHED;
        STAGE(SB(0, 1), rsB, bcol + 128, t + 2);
        WAIT_V(6); BAR; MMA_LO(1, 1, At, B1); BAR;
        LDB(B0, 1, 0); SCHED; LDA(At, 1, 0); STAGE(SA(0, 1), rsA, brow + 128, t + 2);
        WAIT_L(8); BAR; WAIT_L(0); MMA(0, 0, At, B0); BAR; SCHED;
        LDB(B1, 1, 1); STAGE(SB(1, 0), rsB, bcol, t + 3);
        BAR; WAIT_L(0); MMA(0, 1, At, B1); BAR;
        LDA_LO(At, 1, 1); STAGE(SA(1, 0), rsA, brow, t + 3);
        BAR; WAIT_L(0); MMA_LO(1, 0, At, B0); BAR; SCHED;
        STAGE(SB(1, 1), rsB, bcol + 128, t + 3);
        WAIT_V(6); BAR; MMA_LO(1, 1, At, B1); BAR;
    }
    { LDB(B0, 0, 0); LDA(At, 0, 0); STAGE(SA(1, 1), rsA, brow + 128, nt - 1);
      BAR; WAIT_L(0); MMA(0, 0, At, B0); BAR;
      LDB(B1, 0, 1); BAR; WAIT_L(0); MMA(0, 1, At, B1); BAR;
      LDA_LO(At, 0, 1); WAIT_V(4); BAR; WAIT_L(0); MMA_LO(1, 0, At, B0); MMA_LO(1, 1, At, B1); BAR; }
    { LDB(B0, 1, 0); LDA(At, 1, 0); WAIT_V(2); BAR; WAIT_L(0); MMA(0, 0, At, B0); BAR;
      LDB(B1, 1, 1); WAIT_V(0); BAR; WAIT_L(0); MMA(0, 1, At, B1); BAR;
      LDA_LO(At, 1, 1); BAR; WAIT_L(0); MMA_LO(1, 0, At, B0); MMA_LO(1, 1, At, B1); BAR; }
    if constexpr (FP8) asm volatile("s_nop 15\n\ts_nop 15" ::: "memory");
    if (wr == 0) BAR;
#undef SA
#undef SB
#undef STAGE
#undef LDA
#undef LDB
#undef MMA
#undef MMA_LO
#undef LDA_LO
}

constexpr int EPT_LD = 260;
template <int AI>
__device__ __forceinline__ void acc_half_to_lds(const f32x4 (&acc)[2][2][4][2]) {
    extern __shared__ __attribute__((aligned(16))) char smem[];
    float* T = (float*)smem;
    const int tid_ = opaque_tid();
    const int wid = tid_ >> 6, lane = tid_ & 63, wr = wid >> 2, wc = wid & 3, fr = lane & 15, fq = lane >> 4;
    float* base = T + (wr * 64 + fq * 4) * EPT_LD + wc * 32 + fr;
#pragma unroll
    for (int bj = 0; bj < 2; ++bj)
#pragma unroll
        for (int m = 0; m < 4; ++m)
#pragma unroll
            for (int n = 0; n < 2; ++n)
#pragma unroll
                for (int j = 0; j < 4; ++j) base[(m * 16 + j) * EPT_LD + bj * 128 + n * 16] = acc[AI][bj][m][n][j];
}
__device__ __forceinline__ void store4_bf16(u16* p, float a, float b, float c, float d) { u32x2 w = {cvtpk(a, b), cvtpk(c, d)}; *(u32x2*)p = w; }
__device__ __forceinline__ void store4_fp8(unsigned char* p, float a, float b, float c, float d) { int w = 0; w = __builtin_amdgcn_cvt_pk_fp8_f32(a, b, w, false); w = __builtin_amdgcn_cvt_pk_fp8_f32(c, d, w, true); *(int*)p = w; }

enum { EP_RAW = 0, EP_SILU = 1, EP_SIGMOID = 2, EP_NORM128 = 3, EP_NORM256 = 4, EP_RAW_SS = 5, EP_MISC = 6 };

__device__ __forceinline__ void epi_rows_inproj(const int mode, const int grow0, u16* __restrict__ dst, const int ld, const int half_skip,
                                                const float* __restrict__ g, const float scale, float* __restrict__ ssout, const int ss_stride, const Params& p, const float prescale = 1.f, const bool k8 = false) {
    extern __shared__ __attribute__((aligned(16))) char smem[];
    const float* T = (const float*)smem;
    const int tid_ = opaque_tid();
    const int wid = tid_ >> 6, lane = tid_ & 63;
    const int col = lane * 4;
    if (mode == EP_SIGMOID) {
        const int rs = lane >> 4, cg = lane & 15;
#pragma unroll
        for (int r4 = 0; r4 < 4; ++r4) {
            const int lr = wid * 16 + r4 * 4 + rs; const size_t row = (size_t)(grow0 + lr);
            f32x4 v[4]; int w[4];
#pragma unroll
            for (int j = 0; j < 4; ++j) v[j] = *(const f32x4*)(T + lr * EPT_LD + cg * 16 + j * 4);
#pragma unroll
            for (int j = 0; j < 4; ++j) { int w8 = 0;
                w8 = __builtin_amdgcn_cvt_pk_fp8_f32(sigmoid_f(v[j][0] * prescale) * G8_SCALE, sigmoid_f(v[j][1] * prescale) * G8_SCALE, w8, false);
                w8 = __builtin_amdgcn_cvt_pk_fp8_f32(sigmoid_f(v[j][2] * prescale) * G8_SCALE, sigmoid_f(v[j][3] * prescale) * G8_SCALE, w8, true); w[j] = w8; }
            __builtin_nontemporal_store((u32x4){(unsigned)w[0], (unsigned)w[1], (unsigned)w[2], (unsigned)w[3]}, (u32x4*)((unsigned char*)dst + row * ld + cg * 16));
        }
        return;
    }
    f32x4 gg = {1.f, 1.f, 1.f, 1.f};
    if (mode == EP_NORM128) gg = *(const f32x4*)(g + (col & 127));
    else if (mode == EP_NORM256) gg = *(const f32x4*)(g + col);
#pragma unroll 1
    for (int r4 = 0; r4 < 4; ++r4) {
        const int lr0 = wid * 16 + r4 * 4; const size_t row0 = (size_t)(grow0 + lr0);
        f32x4 v[4];
#pragma unroll
        for (int u = 0; u < 4; ++u) { v[u] = *(const f32x4*)(T + (lr0 + u) * EPT_LD + col); v[u][0] *= prescale; v[u][1] *= prescale; v[u][2] *= prescale; v[u][3] *= prescale; }
        if (mode == EP_MISC) {
            u16* IK = (u16*)(p.ws + WS_IK); float* IW = (float*)(p.ws + WS_IW); float* BKPE = (float*)(p.ws + WS_BKPE); float* PESS = (float*)(p.ws + WS_PESS);
            const bool pe = (lane >= 20 && lane < 36);
#pragma unroll
            for (int u = 0; u < 4; ++u) {
                const size_t row = row0 + u;
                float ss = pe ? (v[u][0] * v[u][0] + v[u][1] * v[u][1] + v[u][2] * v[u][2] + v[u][3] * v[u][3]) : 0.f;
                ss = wave_sum64(ss);
                if (lane < 16) store4_bf16(IK + row * 64 + col, v[u][0], v[u][1], v[u][2], v[u][3]);
                else if (lane < 20) *(f32x4*)(IW + row * 16 + (col - 64)) = v[u];
                else if (lane < 36) *(f32x4*)(BKPE + row * 64 + (col - 80)) = v[u];
                if (lane == 0) PESS[row] = ss;
            }
            continue;
        }
        if (mode == EP_SILU) {
#pragma unroll
            for (int u = 0; u < 4; ++u) { v[u][0] = silu_f(v[u][0]); v[u][1] = silu_f(v[u][1]); v[u][2] = silu_f(v[u][2]); v[u][3] = silu_f(v[u][3]); }
        } else if (mode == EP_SIGMOID) {
#pragma unroll
            for (int u = 0; u < 4; ++u) { v[u][0] = sigmoid_f(v[u][0]); v[u][1] = sigmoid_f(v[u][1]); v[u][2] = sigmoid_f(v[u][2]); v[u][3] = sigmoid_f(v[u][3]); }
        } else if (mode >= EP_NORM128) {
            float ss[4];
#pragma unroll
            for (int u = 0; u < 4; ++u) ss[u] = v[u][0] * v[u][0] + v[u][1] * v[u][1] + v[u][2] * v[u][2] + v[u][3] * v[u][3];
            if (mode == EP_NORM128) {
#pragma unroll
                for (int u = 0; u < 4; ++u) ss[u] = wave_sum32(ss[u]);
#pragma unroll
                for (int u = 0; u < 4; ++u) { const float rinv = rsqrtf(ss[u] * (1.f / 128.f) + EPS) * scale; v[u][0] *= rinv * gg[0]; v[u][1] *= rinv * gg[1]; v[u][2] *= rinv * gg[2]; v[u][3] *= rinv * gg[3]; }
            } else {
#pragma unroll
                for (int u = 0; u < 4; ++u) ss[u] = wave_sum64(ss[u]);
                if (mode == EP_NORM256) {
#pragma unroll
                    for (int u = 0; u < 4; ++u) { const float rinv = rsqrtf(ss[u] * (1.f / 256.f) + EPS) * scale; v[u][0] *= rinv * gg[0]; v[u][1] *= rinv * gg[1]; v[u][2] *= rinv * gg[2]; v[u][3] *= rinv * gg[3]; }
                } else if (lane == 0) {
#pragma unroll
                    for (int u = 0; u < 4; ++u) ssout[(row0 + u) * ss_stride] = ss[u];
                }
            }
        }
        if (mode == EP_RAW_SS) {
#pragma unroll
            for (int u = 0; u < 4; ++u) store4_fp8((unsigned char*)dst + (row0 + u) * ld + col, v[u][0] * LAT8_SCALE, v[u][1] * LAT8_SCALE, v[u][2] * LAT8_SCALE, v[u][3] * LAT8_SCALE);
            continue;
        }
        if (mode == EP_SIGMOID) {
#pragma unroll
            for (int u = 0; u < 4; ++u) { int w8 = 0; w8 = __builtin_amdgcn_cvt_pk_fp8_f32(v[u][0] * G8_SCALE, v[u][1] * G8_SCALE, w8, false); w8 = __builtin_amdgcn_cvt_pk_fp8_f32(v[u][2] * G8_SCALE, v[u][3] * G8_SCALE, w8, true);
                __builtin_nontemporal_store(w8, (int*)((unsigned char*)dst + (row0 + u) * ld + col)); }
            continue;
        }
        if (k8) {
#pragma unroll
            for (int u = 0; u < 4; ++u) store4_fp8((unsigned char*)dst + (row0 + u) * KV_TOK + (lane >> 5) * KV_GRP + (col & 127), v[u][0] * K8_SCALE, v[u][1] * K8_SCALE, v[u][2] * K8_SCALE, v[u][3] * K8_SCALE);
            continue;
        }
#pragma unroll
        for (int u = 0; u < 4; ++u) store4_bf16(dst + (row0 + u) * ld + col + (lane >= 32 ? half_skip : 0), v[u][0], v[u][1], v[u][2], v[u][3]);
    }
}

__device__ __forceinline__ void phase_inproj(const Params& p) {
    const int r = blockIdx.x, xcd = r & 7, slot = r >> 3, mi = slot >> 3, ni = slot & 7;
    const int pm = xcd * 4 + mi;
    f32x4 acc[2][2][4][2];
    {
        const int pn = ni + 10;
        gemm_kloop<false>((const u16*)(p.ws + WS_H), (const u16*)(p.ws + WS_WINT), DM, pm * 256, pn * 256, acc);
        int mode; size_t dsto; int ld; float scale = 1.f; size_t sso = 0; int ss_stride = 0;
        if (pn < 14) { mode = EP_RAW; dsto = WS_IQ + (pn - 10) * 512; ld = 1024; }
        else if (pn == 14) { mode = EP_MISC; dsto = 0; ld = 0; }
        else if (pn < 17) { mode = EP_RAW_SS; dsto = WS_BCQ + (pn - 15) * 256; ld = 512; sso = WS_LATQ + (pn - 15) * 4; ss_stride = 2; }
        else { mode = EP_RAW_SS; dsto = WS_BCKV; ld = 256; sso = WS_LATKV; ss_stride = 1; }
#pragma unroll 1
        for (int half = 0; half < 2; ++half) {
            __syncthreads();
            if (half == 0) acc_half_to_lds<0>(acc); else acc_half_to_lds<1>(acc);
            __syncthreads();
            epi_rows_inproj(mode, pm * 256 + half * 128, (u16*)(p.ws + dsto), ld, 0, nullptr, scale, (float*)(p.ws + sso), ss_stride, p);
        }
        __syncthreads();
    }
    const bool lowpm = pm < 4;
    const int nf8 = (lowpm || ni < 6) ? 6 : 5;
    const int f0 = (lowpm || ni < 6) ? ni * 6 : 36 + (ni - 6) * 5;
#pragma unroll 1
    for (int j = 0; j < nf8; ++j) {
        const int f = f0 + j;
        const u16* A8 = (const u16*)(p.dout + DO_H8); const u16* B8; u16* dst; int ld, mode, half_skip = 0, brow = pm * 256; const float* g = nullptr; float scale = 1.f; bool k8 = false;
        if (f < 24) { B8 = (const u16*)(p.ws + WS_WG8) + (size_t)f * 256 * 1024; dst = (u16*)(p.ws + WS_G + f * 256); ld = 6144; mode = EP_SIGMOID; }
        else if (f < 36) { const int s8 = f - 24; B8 = (const u16*)(p.ws + WS_WS8) + (size_t)s8 * 256 * 1024;
            dst = (u16*)(p.ws + (s8 < 4 ? WS_SZA : (s8 < 8 ? WS_SZB : WS_SZC))) + (s8 & 3) * 256; ld = 1024; mode = EP_SILU; }
        else if (f < 44) { const int q8 = f - 36; B8 = (const u16*)(p.ws + WS_WQ8) + (size_t)q8 * 256 * 1024; ld = 1024;
            if (q8 < 4) { dst = (u16*)(p.ws + WS_AQ) + q8 * 256; mode = EP_NORM128; g = p.a_q_norm_g; scale = A_SCALE; }
            else { dst = (u16*)(p.ws + WS_CQ) + (q8 - 4) * 256; mode = EP_NORM256; g = p.c_q_norm_g; scale = C_SCALE; } }
        else if (f == 44) { B8 = (const u16*)(p.ws + WS_WKV8); dst = (u16*)(p.ws + WS_KVA); ld = 0; mode = EP_NORM128; g = p.a_k_norm_g; k8 = true; }
        else if (f == 45) { B8 = (const u16*)(p.ws + WS_WKV8) + (size_t)256 * 1024; dst = (u16*)(p.ws + WS_KVA + 128); ld = KV_TOK / 2; half_skip = KV_GRP / 2 - 128; mode = EP_RAW; }
        else { const int mtile = pm * 2 + (f - 46);
            A8 = (const u16*)(p.ws + WS_HM); B8 = (const u16*)(p.ws + WS_WMEMT) + (size_t)mtile * 256 * 1024; brow = 0; ld = 1024;
            if (mtile < 4) { mode = EP_NORM256; dst = (u16*)(p.ws + WS_CK) + mtile * 256; g = p.c_k_norm_g; }
            else { mode = EP_RAW; dst = (u16*)(p.ws + WS_CV) + (mtile - 4) * 256; } }
        gemm_kloop<true>(A8, B8, DM / 2, brow, 0, acc);
#pragma unroll 1
        for (int half = 0; half < 2; ++half) {
            __syncthreads();
            if (half == 0) acc_half_to_lds<0>(acc); else acc_half_to_lds<1>(acc);
            __syncthreads();
            epi_rows_inproj(mode, brow + half * 128, dst, ld, half_skip, g, scale, nullptr, 0, p, 1.f / GATE_W_SCALE, k8);
        }
        __syncthreads();
    }
    if (!lowpm && ni >= 6) {
        const int tid2 = opaque_tid(); const int wv2 = __builtin_amdgcn_readfirstlane(tid2 >> 6);
        prep_tiles_late(p, PREP_T3 + ((pm - 4) * 2 + (ni - 6)) * 8 + wv2, 448, tid2 & 63);
    }
}

__device__ __forceinline__ void epi_rows_mla_q(const int grow0, const int h, const Params& p) {
    extern __shared__ __attribute__((aligned(16))) char smem[];
    const float* T = (const float*)smem;
    const int tid_ = opaque_tid(); const int wid = tid_ >> 6, lane = tid_ & 63, col = lane * 4;
    typedef const __attribute__((address_space(1))) float gcf_t; typedef const __attribute__((address_space(1))) f32x4 gcf4_t; typedef __attribute__((address_space(1))) int gi_t;
    gcf_t* LATQ = (gcf_t*)(const float*)(p.ws + WS_LATQ); gcf_t* COS = (gcf_t*)(const float*)(p.ws + WS_COS); gcf_t* SIN = (gcf_t*)(const float*)(p.ws + WS_SIN);
    unsigned char* QB = (unsigned char*)(p.dout + DO_QB) + (size_t)h * SEQ * 192;
    const int pp = (col - 128) & 63, blk = pp >> 5, within = pp & 31, second = within >> 4, jj = blk * 16 + (within & 15);
    f32x4 gg = {0.f, 0.f, 0.f, 0.f};
    if (lane < 32) gg = *(const f32x4*)(p.b_q_norm_g + col);
    else if (lane < 48) gg = *(const f32x4*)(p.b_q_norm_g + 128 + second * 32 + jj);
    const bool ropel = lane >= 32 && lane < 48;
    const float lq_all = (lane < 32) ? LATQ[(size_t)(grow0 + wid * 16) * 2 + lane] : 0.f;
    const f32x4 z4 = {0.f, 0.f, 0.f, 0.f};
    f32x4 ccn[2] = {z4, z4}, snn[2] = {z4, z4};
#define MLAQ_PF(r4_) do { const size_t tn_ = (size_t)(grow0 + wid * 16 + (r4_) * 2); _Pragma("unroll") for (int u = 0; u < 2; ++u) \
        if (ropel) { ccn[u] = *(gcf4_t*)(COS + (tn_ + u) * 32 + jj); snn[u] = *(gcf4_t*)(SIN + (tn_ + u) * 32 + jj); } } while (0)
    MLAQ_PF(0);
#pragma unroll 1
    for (int r4 = 0; r4 < 8; ++r4) {
        const int lr0 = wid * 16 + r4 * 2; const size_t t0 = (size_t)(grow0 + lr0);
        f32x4 v[2], cc[2], sn[2]; float rlat[2], ss[2];
#pragma unroll
        for (int u = 0; u < 2; ++u) { v[u] = *(const f32x4*)(T + (lr0 + u) * EPT_LD + col);
            const float la = __builtin_amdgcn_readlane(lq_all, 2 * (r4 * 2 + u)), lb = __builtin_amdgcn_readlane(lq_all, 2 * (r4 * 2 + u) + 1);
            rlat[u] = rsqrtf((la + lb) * (1.f / 512.f) + EPS) * (1.f / (LAT8_SCALE * GATE_W_SCALE)); cc[u] = ccn[u]; sn[u] = snn[u]; }
        if (r4 + 1 < 8) MLAQ_PF(r4 + 1);
#pragma unroll
        for (int u = 0; u < 2; ++u) { v[u][0] *= rlat[u]; v[u][1] *= rlat[u]; v[u][2] *= rlat[u]; v[u][3] *= rlat[u];
            ss[u] = v[u][0] * v[u][0] + v[u][1] * v[u][1] + v[u][2] * v[u][2] + v[u][3] * v[u][3]; }
#pragma unroll
        for (int u = 0; u < 2; ++u) ss[u] = wave_sum64(ss[u]);
#pragma unroll
        for (int u = 0; u < 2; ++u) {
            const float rinv = rsqrtf(ss[u] * (1.f / 192.f) + EPS);
            v[u][0] *= rinv * gg[0]; v[u][1] *= rinv * gg[1]; v[u][2] *= rinv * gg[2]; v[u][3] *= rinv * gg[3];
            f32x4 o;
            o[0] = xchg_xor4(v[u][0]); o[1] = xchg_xor4(v[u][1]); o[2] = xchg_xor4(v[u][2]); o[3] = xchg_xor4(v[u][3]);
            if (lane >= 32 && lane < 48) {
#pragma unroll
                for (int e = 0; e < 4; ++e) v[u][e] = second ? (v[u][e] * cc[u][e] + o[e] * sn[u][e]) : (v[u][e] * cc[u][e] - o[e] * sn[u][e]);
            }
            if (lane < 48) { constexpr float QS = B_SCALE * MQ8_SCALE; int w8 = 0; w8 = __builtin_amdgcn_cvt_pk_fp8_f32(v[u][0] * QS, v[u][1] * QS, w8, false); w8 = __builtin_amdgcn_cvt_pk_fp8_f32(v[u][2] * QS, v[u][3] * QS, w8, true);
                *(gi_t*)(int*)(QB + (t0 + u) * 192 + col) = w8; }
        }
    }
#undef MLAQ_PF
}
__device__ __forceinline__ void epi_rows_mla_kv(const int grow0, const int h, const Params& p) {
    extern __shared__ __attribute__((aligned(16))) char smem[];
    const float* T = (const float*)smem;
    const int tid_ = opaque_tid(); const int wid = tid_ >> 6, lane = tid_ & 63, col = lane * 4;
    typedef const __attribute__((address_space(1))) float gcf_t; typedef const __attribute__((address_space(1))) f32x4 gcf4_t; typedef __attribute__((address_space(1))) int gi_t; typedef __attribute__((address_space(1))) u32x2 gu2_t;
    gcf_t* LATKV = (gcf_t*)(const float*)(p.ws + WS_LATKV); gcf_t* PESS = (gcf_t*)(const float*)(p.ws + WS_PESS); gcf_t* BKPE = (gcf_t*)(const float*)(p.ws + WS_BKPE);
    gcf_t* COS = (gcf_t*)(const float*)(p.ws + WS_COS); gcf_t* SIN = (gcf_t*)(const float*)(p.ws + WS_SIN);
    unsigned char* KB = (unsigned char*)(p.dout + DO_KB) + (size_t)h * SEQ * 192;
    u16* VB = (u16*)(p.dout + DO_VB) + (size_t)h * SEQ * 128;
    f32x4 gg = {1.f, 1.f, 1.f, 1.f};
    if (lane < 32) gg = *(const f32x4*)(p.b_k_norm_g + col);
    const int jj = (lane & 7) * 4;
    const f32x4 g1 = *(const f32x4*)(p.b_k_norm_g + 128 + jj), g2 = *(const f32x4*)(p.b_k_norm_g + 160 + jj);
    const float sc_all = (lane < 16) ? LATKV[(size_t)(grow0 + wid * 16) + lane] : ((lane < 32) ? PESS[(size_t)(grow0 + wid * 16) + (lane - 16)] : 0.f);
    const f32x4 z4 = {0.f, 0.f, 0.f, 0.f};
    f32x4 x1n[2] = {z4, z4}, x2n[2] = {z4, z4}, ccn[2] = {z4, z4}, snn[2] = {z4, z4};
#define MLAKV_PF(r4_) do { const size_t tn_ = (size_t)(grow0 + wid * 16 + (r4_) * 2); _Pragma("unroll") for (int u = 0; u < 2; ++u) \
        if (lane < 8) { x1n[u] = *(gcf4_t*)(BKPE + (tn_ + u) * 64 + jj); x2n[u] = *(gcf4_t*)(BKPE + (tn_ + u) * 64 + 32 + jj); \
            ccn[u] = *(gcf4_t*)(COS + (tn_ + u) * 32 + jj); snn[u] = *(gcf4_t*)(SIN + (tn_ + u) * 32 + jj); } } while (0)
    MLAKV_PF(0);
#pragma unroll 1
    for (int r4 = 0; r4 < 8; ++r4) {
        const int lr0 = wid * 16 + r4 * 2; const size_t t0 = (size_t)(grow0 + lr0);
        f32x4 v[2], x1[2], x2[2], cc[2], sn[2]; float rlat[2], ss[2], pess[2];
#pragma unroll
        for (int u = 0; u < 2; ++u) { v[u] = *(const f32x4*)(T + (lr0 + u) * EPT_LD + col);
            rlat[u] = rsqrtf(__builtin_amdgcn_readlane(sc_all, r4 * 2 + u) * (1.f / 256.f) + EPS) * (1.f / (LAT8_SCALE * GATE_W_SCALE)); pess[u] = __builtin_amdgcn_readlane(sc_all, 16 + r4 * 2 + u);
            x1[u] = x1n[u]; x2[u] = x2n[u]; cc[u] = ccn[u]; sn[u] = snn[u]; }
        if (r4 + 1 < 8) MLAKV_PF(r4 + 1);
#pragma unroll
        for (int u = 0; u < 2; ++u) { v[u][0] *= rlat[u]; v[u][1] *= rlat[u]; v[u][2] *= rlat[u]; v[u][3] *= rlat[u];
            ss[u] = v[u][0] * v[u][0] + v[u][1] * v[u][1] + v[u][2] * v[u][2] + v[u][3] * v[u][3]; }
#pragma unroll
        for (int u = 0; u < 2; ++u) ss[u] = wave_sum32(ss[u]);
#pragma unroll
        for (int u = 0; u < 2; ++u) {
            const size_t t = t0 + u;
            const float rinv = rsqrtf((ss[u] + pess[u]) * (1.f / 192.f) + EPS);
            const float rk = rinv * MK8_SCALE;
            if (lane < 32) { int w8 = 0; w8 = __builtin_amdgcn_cvt_pk_fp8_f32(v[u][0] * rk * gg[0], v[u][1] * rk * gg[1], w8, false); w8 = __builtin_amdgcn_cvt_pk_fp8_f32(v[u][2] * rk * gg[2], v[u][3] * rk * gg[3], w8, true);
                *(gi_t*)(int*)(KB + t * 192 + col) = w8; }
            else { const u32x2 wv = {cvtpk(v[u][0], v[u][1]), cvtpk(v[u][2], v[u][3])}; *(gu2_t*)(u32x2*)(VB + t * 128 + (col - 128)) = wv; }
            if (lane < 8) {
                float o1[4], o2[4];
#pragma unroll
                for (int e = 0; e < 4; ++e) { const float a = x1[u][e] * rinv * g1[e], b = x2[u][e] * rinv * g2[e]; o1[e] = a * cc[u][e] - b * sn[u][e]; o2[e] = b * cc[u][e] + a * sn[u][e]; }
                int wa = 0, wb = 0;
                wa = __builtin_amdgcn_cvt_pk_fp8_f32(o1[0] * MK8_SCALE, o1[1] * MK8_SCALE, wa, false); wa = __builtin_amdgcn_cvt_pk_fp8_f32(o1[2] * MK8_SCALE, o1[3] * MK8_SCALE, wa, true);
                wb = __builtin_amdgcn_cvt_pk_fp8_f32(o2[0] * MK8_SCALE, o2[1] * MK8_SCALE, wb, false); wb = __builtin_amdgcn_cvt_pk_fp8_f32(o2[2] * MK8_SCALE, o2[3] * MK8_SCALE, wb, true);
                *(gi_t*)(int*)(KB + t * 192 + 128 + rope_phys(jj, 0)) = wa;
                *(gi_t*)(int*)(KB + t * 192 + 128 + rope_phys(jj, 1)) = wb;
            }
        }
    }
#undef MLAKV_PF
}
__device__ __forceinline__ void phase_mla_up(const Params& p) {
    const int r = blockIdx.x, xcd = r & 7, slot = r >> 3, pm = xcd * 4 + (slot >> 3), h = slot & 7;
    f32x4 acc[2][2][4][2];
#pragma unroll 1
    for (int which = 0; which < 2; ++which) {
        if (which == 0) gemm_kloop<true>((const u16*)(p.ws + WS_BCQ), (const u16*)(p.ws + WS_WUQT), 256, pm * 256, h * 256, acc);
        else gemm_kloop<true>((const u16*)(p.ws + WS_BCKV), (const u16*)(p.ws + WS_WUKVT), 128, pm * 256, h * 256, acc);
#pragma unroll 1
        for (int half = 0; half < 2; ++half) {
            __syncthreads();
            if (half == 0) acc_half_to_lds<0>(acc); else acc_half_to_lds<1>(acc);
            __syncthreads();
            if (which == 0) epi_rows_mla_q(pm * 256 + half * 128, h, p); else epi_rows_mla_kv(pm * 256 + half * 128, h, p);
        }
        __syncthreads();
    }
}

__device__ __forceinline__ void epi_rows_merge(const int grow0, const int pd, const int n, const Params& p) {
    extern __shared__ __attribute__((aligned(16))) char smem[];
    const float* T = (const float*)smem;
    const int tid_ = opaque_tid(); const int wid = tid_ >> 6, lane = tid_ & 63, col = lane * 4;
    const unsigned char* G = (const unsigned char*)(p.ws + WS_G); u16* M = (u16*)(p.ws + WS_MERGED);
#pragma unroll 1
    for (int r4 = 0; r4 < 4; ++r4) {
        const int lr0 = wid * 16 + r4 * 4; const size_t t0 = (size_t)(grow0 + lr0);
        f32x4 v[4]; unsigned gw[4]; u32x2 mw[4];
#pragma unroll
        for (int u = 0; u < 4; ++u) { v[u] = *(const f32x4*)(T + (lr0 + u) * EPT_LD + col); gw[u] = __builtin_nontemporal_load((const unsigned*)(G + (t0 + u) * 6144 + n * 2048 + pd * 256 + col));
            if (n > 0) mw[u] = *(const u32x2*)(M + (t0 + u) * DM + pd * 256 + col); }
#pragma unroll
        for (int u = 0; u < 4; ++u) {
            constexpr float YS = 1.f / (U8_SCALE * WBR8_SCALE * G8_SCALE);
            const auto glo = __builtin_amdgcn_cvt_pk_f32_fp8((int)gw[u], false), ghi = __builtin_amdgcn_cvt_pk_f32_fp8((int)gw[u], true);
            v[u][0] *= YS * glo[0]; v[u][1] *= YS * glo[1]; v[u][2] *= YS * ghi[0]; v[u][3] *= YS * ghi[1];
            if (n > 0) { v[u][0] += __uint_as_float(mw[u][0] << 16); v[u][1] += __uint_as_float(mw[u][0] & 0xffff0000u); v[u][2] += __uint_as_float(mw[u][1] << 16); v[u][3] += __uint_as_float(mw[u][1] & 0xffff0000u); }
        }
#pragma unroll
        for (int u = 0; u < 4; ++u) {
            if (n < 2) store4_bf16(M + (t0 + u) * DM + pd * 256 + col, v[u][0], v[u][1], v[u][2], v[u][3]);
            else store4_fp8((unsigned char*)(p.ws + WS_M8) + (t0 + u) * DM + pd * 256 + col, v[u][0] * M8_SCALE, v[u][1] * M8_SCALE, v[u][2] * M8_SCALE, v[u][3] * M8_SCALE);
        }
    }
}
__device__ __forceinline__ void phase_merge(const Params& p) {
    const int r = blockIdx.x, xcd = r & 7, slot = r >> 3, pm = xcd * 4 + (slot >> 3), pd = slot & 7;
    f32x4 acc[2][2][4][2];
#pragma unroll 1
    for (int n = 0; n < 3; ++n) {
        const u16* U = (const u16*)(p.ws + (n == 0 ? WS_UA : (n == 1 ? WS_UB : WS_UC)));
        gemm_kloop<true>(U, (const u16*)(p.ws + WS_WBRT + (size_t)n * DM * 1024), 512, pm * 256, pd * 256, acc);
#pragma unroll 1
        for (int half = 0; half < 2; ++half) {
            __syncthreads();
            if (half == 0) acc_half_to_lds<0>(acc); else acc_half_to_lds<1>(acc);
            __syncthreads();
            epi_rows_merge(pm * 256 + half * 128, pd, n, p);
        }
        __syncthreads();
    }
}
__device__ __forceinline__ void epi_rows_out(const int grow0, const int pd, const Params& p) {
    extern __shared__ __attribute__((aligned(16))) char smem[];
    const float* T = (const float*)smem;
    const int tid_ = opaque_tid(); const int wid = tid_ >> 6, lane = tid_ & 63, col = lane * 4;
    float* OUT = (float*)p.dout;
#pragma unroll 1
    for (int r4 = 0; r4 < 4; ++r4) {
        const int lr0 = wid * 16 + r4 * 4; const size_t t0 = (size_t)(grow0 + lr0);
        f32x4 v[4], xv[4];
#pragma unroll
        for (int u = 0; u < 4; ++u) { v[u] = *(const f32x4*)(T + (lr0 + u) * EPT_LD + col); xv[u] = __builtin_nontemporal_load((const f32x4*)(p.x + (t0 + u) * DM + pd * 256 + col)); }
#pragma unroll
        for (int u = 0; u < 4; ++u) { constexpr float OS = 1.f / (M8_SCALE * WOUT8_SCALE);
            v[u][0] = fmaf(v[u][0], OS, xv[u][0]); v[u][1] = fmaf(v[u][1], OS, xv[u][1]); v[u][2] = fmaf(v[u][2], OS, xv[u][2]); v[u][3] = fmaf(v[u][3], OS, xv[u][3]); __builtin_nontemporal_store(v[u], (f32x4*)(OUT + (t0 + u) * DM + pd * 256 + col)); }
    }
}
__device__ __forceinline__ void phase_out(const Params& p) {
    const int r = blockIdx.x, xcd = r & 7, slot = r >> 3, pm = xcd * 4 + (slot >> 3), pd = slot & 7;
    f32x4 acc[2][2][4][2];
    gemm_kloop<true>((const u16*)(p.ws + WS_M8), (const u16*)(p.ws + WS_WOUTT), DM / 2, pm * 256, pd * 256, acc);
#pragma unroll 1
    for (int half = 0; half < 2; ++half) {
        __syncthreads();
        if (half == 0) acc_half_to_lds<0>(acc); else acc_half_to_lds<1>(acc);
        __syncthreads();
        epi_rows_out(pm * 256 + half * 128, pd, p);
    }
    __syncthreads();
}

typedef short s16x4 __attribute__((ext_vector_type(4)));
constexpr float LOG2E = 1.4426950408889634f;
constexpr int MLA_KT = 12288, MLA_VT = 8192, MLA_GRP = MLA_KT + MLA_VT, MLA_BUF = 2 * MLA_GRP;
__device__ __forceinline__ int crow16(int r, int hi) { return (r & 3) + 8 * (r >> 2) + 4 * hi; }

constexpr int IDX_CAP = 1024, IDX_WAVE_LDS = 2 * IDX_CAP * 4 + 2 * IDX_CAP * 2 + 1024;
__device__ __forceinline__ unsigned ordk(unsigned b) { return (b & 0x80000000u) ? ~b : (b | 0x80000000u); }

#define DPP_SHL(v, n, oldv, bc) ((unsigned)__builtin_amdgcn_update_dpp((int)(oldv), (int)(v), 0x100 + (n), 0xf, 0xf, bc))
__device__ __forceinline__ unsigned wave_max_u32(unsigned m) {
    unsigned t;
    t = DPP_SHL(m, 1, 0u, true); m = t > m ? t : m;
    t = DPP_SHL(m, 2, 0u, true); m = t > m ? t : m;
    t = DPP_SHL(m, 4, 0u, true); m = t > m ? t : m;
    t = DPP_SHL(m, 8, 0u, true); m = t > m ? t : m;
    const unsigned a = __builtin_amdgcn_readlane(m, 0), b = __builtin_amdgcn_readlane(m, 16), c = __builtin_amdgcn_readlane(m, 32), d = __builtin_amdgcn_readlane(m, 48);
    const unsigned ab = a > b ? a : b, cd = c > d ? c : d;
    return ab > cd ? ab : cd;
}
__device__ __forceinline__ unsigned wave_min_u32(unsigned m) {
    unsigned t;
    t = DPP_SHL(m, 1, 0xffffffffu, false); m = t < m ? t : m;
    t = DPP_SHL(m, 2, 0xffffffffu, false); m = t < m ? t : m;
    t = DPP_SHL(m, 4, 0xffffffffu, false); m = t < m ? t : m;
    t = DPP_SHL(m, 8, 0xffffffffu, false); m = t < m ? t : m;
    const unsigned a = __builtin_amdgcn_readlane(m, 0), b = __builtin_amdgcn_readlane(m, 16), c = __builtin_amdgcn_readlane(m, 32), d = __builtin_amdgcn_readlane(m, 48);
    const unsigned ab = a < b ? a : b, cd = c < d ? c : d;
    return ab < cd ? ab : cd;
}
__device__ __forceinline__ int wave_suffix_sum(int s, const int lane) {
    int v = s;
    v += (int)DPP_SHL(v, 1, 0u, true); v += (int)DPP_SHL(v, 2, 0u, true); v += (int)DPP_SHL(v, 4, 0u, true); v += (int)DPP_SHL(v, 8, 0u, true);
    const int t1 = __builtin_amdgcn_readlane(v, 16), t2 = __builtin_amdgcn_readlane(v, 32), t3 = __builtin_amdgcn_readlane(v, 48);
    const int a3 = t3, a2 = t2 + t3, a1 = t1 + t2 + t3;
    return v + (lane < 16 ? a1 : (lane < 32 ? a2 : (lane < 48 ? a3 : 0)));
}
constexpr int IDX_KEEP = 320;
template<bool EXACT>
__device__ __forceinline__ float idx_prune(unsigned* lk, u16* li, unsigned* hist, const int n, const int lane, const float tau_q, const float smax_lane, const bool mine, int& n_out) {
    unsigned kk[16], ix[16];
#pragma unroll
    for (int j = 0; j < 16; ++j) { const int e = lane + 64 * j; const bool in = e < n; kk[j] = in ? lk[e] : 0u; ix[j] = in ? (unsigned)li[e] : 0u; }
#pragma unroll
    for (int j = 0; j < 16; ++j) kk[j] = (lane + 64 * j < n) ? ordk(kk[j]) : 0u;
    unsigned kmax = wave_max_u32(mine ? ordk(__float_as_uint(smax_lane)) : 0u), kmin;
    if (tau_q == -INFINITY) {
        kmin = 0xffffffffu;
#pragma unroll
        for (int j = 0; j < 16; ++j) if (lane + 64 * j < n) kmin = kk[j] < kmin ? kk[j] : kmin;
        kmin = wave_min_u32(kmin);
    } else kmin = ordk(__float_as_uint(tau_q));
    const unsigned range = kmax - kmin;
    int hib = range ? (32 - __builtin_clz(range)) : 0;
    unsigned pre = 0; int need = TOPK; bool first = true;
    const int hbase = (int)(uintptr_t)hist;
    while (hib > 0) {
        const int wbits = hib < 8 ? hib : 8, sh = hib - wbits;
        const unsigned dmask = (1u << wbits) - 1u;
        *(u32x4*)(hist + lane * 4) = (u32x4){0u, 0u, 0u, 0u};
#pragma unroll
        for (int j = 0; j < 16; ++j) {
            if (64 * j < n) { const unsigned rel = kk[j] - kmin;
                const bool match = (lane + 64 * j < n) && (first || ((hib < 32 ? (rel >> hib) : 0u) == (hib < 32 ? (pre >> hib) : 0u)));
                if (match) { const int ha = hbase + (int)(((rel >> sh) & dmask) << 2); const unsigned one = 1u; asm volatile("ds_add_u32 %0, %1" :: "v"(ha), "v"(one) : "memory"); } }
        }
        const u32x4 hv = *(const u32x4*)(hist + lane * 4);
        const int s = (int)(hv[0] + hv[1] + hv[2] + hv[3]);
        const int S = wave_suffix_sum(s, lane);
        const int above = S - s;
        const bool cross = (above < need) && (S >= need);
        const unsigned long long bm = __builtin_amdgcn_ballot_w64(cross);
        const int L = __ffsll((long long)bm) - 1;
        int dsel = 0, nneed = 0, hsel = 0, acc = above; bool found = false;
#pragma unroll
        for (int i = 3; i >= 0; --i) { const int hc = (int)hv[i];
            if (!found && acc + hc >= need) { dsel = lane * 4 + i; nneed = need - acc; hsel = hc; found = true; }
            acc += hc; }
        dsel = __builtin_amdgcn_readlane(dsel, L); nneed = __builtin_amdgcn_readlane(nneed, L);
        pre |= ((unsigned)dsel) << sh; need = nneed; hib = sh; first = false;
        if (!EXACT) {
            hsel = __builtin_amdgcn_readlane(hsel, L);
            const int nge = TOPK - nneed + hsel;
            if (nge <= IDX_KEEP && hib > 0) {
                const unsigned thr = kmin + pre;
                int outc = 0;
#pragma unroll
                for (int j = 0; j < 16; ++j) {
                    if (64 * j < n) {
                        const unsigned k = kk[j];
                        const bool keep = (lane + 64 * j < n) && k >= thr;
                        const unsigned long long bk = __builtin_amdgcn_ballot_w64(keep);
                        const int pos = outc + __popcll(bk & ((1ull << lane) - 1ull));
                        if (keep) { lk[pos] = (k & 0x80000000u) ? (k & 0x7fffffffu) : ~k; li[pos] = (u16)ix[j]; }
                        outc += __popcll(bk);
                    }
                }
                n_out = outc;
                const unsigned t1 = thr - 1u;
                return __uint_as_float((t1 & 0x80000000u) ? (t1 & 0x7fffffffu) : ~t1);
            }
        }
    }
    n_out = TOPK;
    const unsigned prefix = kmin + pre;
    int outc = 0, eqc = 0;
#pragma unroll
    for (int j = 0; j < 16; ++j) {
        if (64 * j < n) {
            const bool in = lane + 64 * j < n; const unsigned k = kk[j];
            const bool gt = in && k > prefix, eq = in && k == prefix;
            const unsigned long long beq = __builtin_amdgcn_ballot_w64(eq);
            const int eqr = eqc + __popcll(beq & ((1ull << lane) - 1ull));
            const bool keep = gt || (eq && eqr < need);
            const unsigned long long bk = __builtin_amdgcn_ballot_w64(keep);
            const int pos = outc + __popcll(bk & ((1ull << lane) - 1ull));
            if (keep) { lk[pos] = (k & 0x80000000u) ? (k & 0x7fffffffu) : ~k; li[pos] = (u16)ix[j]; }
            outc += __popcll(bk); eqc += __popcll(beq);
        }
    }
    const unsigned tb = (prefix & 0x80000000u) ? (prefix & 0x7fffffffu) : ~prefix;
    return __uint_as_float(tb);
}

constexpr int IDX_RING_OFF = 8 * IDX_WAVE_LDS;
__device__ __forceinline__ void idx_round(const Params& p, const int pr, const int pr_max, char* wlds, const int wid, const int lane) {
    extern __shared__ __attribute__((aligned(16))) char smem[];
    const int t0 = 2 * pr, c = lane & 31, hi = lane >> 5, tq = t0 + hi;
    int* SEL = (int*)(p.ws + WS_SEL); int* CNT = (int*)(p.ws + WS_CNT);
    const bool direct = (t0 + 1 < TOPK);
    if (direct) {
        for (int q = 0; q < 2; ++q) { const int t = t0 + q; for (int i = lane; i <= t; i += 64) SEL[(size_t)t * TOPK + i] = i; if (lane == 0) CNT[t] = t + 1; }
    }
    const int maxkeys = 2 * pr_max + 2;
    if (maxkeys <= TOPK) return;
    const int nch = (maxkeys + 127) >> 7;
    unsigned* lkA = (unsigned*)wlds; unsigned* lkB = lkA + IDX_CAP; u16* liA = (u16*)(lkB + IDX_CAP); u16* liB = liA + IDX_CAP; unsigned* hist = (unsigned*)(liB + IDX_CAP);
    unsigned* lk = hi ? lkB : lkA; u16* li = hi ? liB : liA;
    const u16* IQ = (const u16*)(p.ws + WS_IQ); const float* IW = (const float*)(p.ws + WS_IW);
    const __amdgpu_buffer_rsrc_t rs = __builtin_amdgcn_make_buffer_rsrc((void*)(p.ws + WS_IK), (short)0, 0x7fffffff, 0x00020000);
    bf16x8 af[4]; float w[16];
    if (!direct) {
        const int aq = (c >> 2) & 1, ah = (c & 3) + 4 * (c >> 3);
        const u16* ap = IQ + (size_t)(t0 + aq) * 1024 + ah * 64 + hi * 8;
#pragma unroll
        for (int s = 0; s < 4; ++s) af[s] = *(const bf16x8*)(ap + 16 * s);
        const f32x4* wp = (const f32x4*)(IW + (size_t)tq * 16);
#pragma unroll
        for (int i = 0; i < 4; ++i) { const f32x4 v = wp[i]; w[4 * i] = v[0]; w[4 * i + 1] = v[1]; w[4 * i + 2] = v[2]; w[4 * i + 3] = v[3]; }
    } else {
#pragma unroll
        for (int s = 0; s < 4; ++s) af[s] = (bf16x8){0, 0, 0, 0, 0, 0, 0, 0};
#pragma unroll
        for (int i = 0; i < 16; ++i) w[i] = 0.f;
    }
    asm volatile("s_waitcnt vmcnt(0)" : "+v"(af[0]), "+v"(af[1]), "+v"(af[2]), "+v"(af[3]) :: "memory");
    asm volatile("" : "+v"(w[0]), "+v"(w[1]), "+v"(w[2]), "+v"(w[3]), "+v"(w[4]), "+v"(w[5]), "+v"(w[6]), "+v"(w[7]));
    asm volatile("" : "+v"(w[8]), "+v"(w[9]), "+v"(w[10]), "+v"(w[11]), "+v"(w[12]), "+v"(w[13]), "+v"(w[14]), "+v"(w[15]));
    int voff[2];
#pragma unroll
    for (int i = 0; i < 2; ++i) { const int kl = (2 * wid + i) * 8 + (lane >> 3), cpos = lane & 7; voff[i] = kl * 128 + ((cpos ^ ((kl >> 1) & 7)) << 4); }
#define IDX_DMA(ch_) do { char* dst_ = smem + IDX_RING_OFF + ((ch_) % 3) * 16384; \
    _Pragma("unroll") for (int i = 0; i < 2; ++i) \
        __builtin_amdgcn_raw_ptr_buffer_load_lds(rs, (__attribute__((address_space(3))) void*)(dst_ + (2 * wid + i) * 1024), 16, voff[i], (ch_) * 16384, 0, 0); } while (0)
    int kadr[4];
    { const int f = (c >> 1) & 7;
#pragma unroll
      for (int s = 0; s < 4; ++s) kadr[s] = c * 128 + (((2 * s + hi) ^ f) << 4); }
    int cntA = 0, cntB = 0; float tau = -INFINITY, tauA = -INFINITY, tauB = -INFINITY, smax = -INFINITY;
    asm volatile("s_waitcnt vmcnt(0)" ::: "memory");
    __builtin_amdgcn_s_barrier();
    unsigned* flag = (unsigned*)(smem + IDX_RING_OFF + 49152);
    if (wid == 0 && lane < 3) flag[lane] = 0u;
    IDX_DMA(0);
    if (nch > 1) IDX_DMA(1);
    for (int ch = 0; ch < nch; ++ch) {
        if (ch + 1 < nch) asm volatile("s_waitcnt vmcnt(2)" ::: "memory"); else asm volatile("s_waitcnt vmcnt(0)" ::: "memory");
        asm volatile("s_waitcnt lgkmcnt(0)" ::: "memory");
        __builtin_amdgcn_s_barrier();
        if (ch + 2 < nch) IDX_DMA(ch + 2);
        {
            const unsigned fl = (ch > 0) ? flag[(ch + 2) % 3] : 0u;
            if (wid == 0 && lane == 0) flag[(ch + 1) % 3] = 0u;
            if (fl != 0u && !direct) {
                if (cntA > 512) { int no; tauA = idx_prune<false>(lkA, liA, hist, cntA, lane, tauA, smax, hi == 0, no); cntA = no; if (!hi) tau = tauA; }
                if (cntB > 512) { int no; tauB = idx_prune<false>(lkB, liB, hist, cntB, lane, tauB, smax, hi == 1, no); cntB = no; if (hi) tau = tauB; }
            }
        }
        if (!direct) {
            const char* buf = smem + IDX_RING_OFF + (ch % 3) * 16384;
#pragma unroll 1
            for (int tp = 0; tp < 2; ++tp) {
                const int key0 = ch * 128 + tp * 64;
                if (key0 > t0 + 1) break;
                f32x16 d0, d1;
#pragma unroll
                for (int r = 0; r < 16; ++r) { d0[r] = 0.f; d1[r] = 0.f; }
#pragma unroll
                for (int s = 0; s < 4; ++s) { const bf16x8 b0 = *(const bf16x8*)(buf + tp * 8192 + kadr[s]); const bf16x8 b1 = *(const bf16x8*)(buf + tp * 8192 + 4096 + kadr[s]);
                    d0 = __builtin_amdgcn_mfma_f32_32x32x16_bf16(af[s], b0, d0, 0, 0, 0);
                    d1 = __builtin_amdgcn_mfma_f32_32x32x16_bf16(af[s], b1, d1, 0, 0, 0); }
                f32x2_cv pa0[2] = {{0.f, 0.f}, {0.f, 0.f}}, pa1[2] = {{0.f, 0.f}, {0.f, 0.f}};
#pragma unroll
                for (int r = 0; r < 16; r += 2) {
                    const int i0 = __float_as_int(d0[r]), i1 = __float_as_int(d1[r]), j0 = __float_as_int(d0[r + 1]), j1 = __float_as_int(d1[r + 1]);
                    const f32x2_cv x0 = {__int_as_float(i0 > 0 ? i0 : 0), __int_as_float(j0 > 0 ? j0 : 0)}, x1 = {__int_as_float(i1 > 0 ? i1 : 0), __int_as_float(j1 > 0 ? j1 : 0)};
                    const f32x2_cv wv = {w[r], w[r + 1]};
                    pa0[(r >> 1) & 1] = __builtin_elementwise_fma(wv, x0, pa0[(r >> 1) & 1]); pa1[(r >> 1) & 1] = __builtin_elementwise_fma(wv, x1, pa1[(r >> 1) & 1]); }
                const f32x2_cv s0v = pa0[0] + pa0[1], s1v = pa1[0] + pa1[1];
                const float sc0 = s0v[0] + s0v[1], sc1 = s1v[0] + s1v[1];
#pragma unroll
                for (int hf = 0; hf < 2; ++hf) {
                    const float sc = hf ? sc1 : sc0;
                    const int key = key0 + hf * 32 + c;
                    const bool pass = (key <= tq) && (sc > tau);
                    const unsigned long long mask = __builtin_amdgcn_ballot_w64(pass);
                    if (mask != 0ull) {
                        const unsigned mA = (unsigned)mask, mB = (unsigned)(mask >> 32);
                        const unsigned mq = hi ? mB : mA;
                        const int pos = (hi ? cntB : cntA) + __popc(mq & ((1u << c) - 1u));
                        if (pass) { lk[pos] = __float_as_uint(sc); li[pos] = (u16)key; smax = fmaxf(smax, sc); }
                        cntA += __popc(mA); cntB += __popc(mB);
                    }
                }
            }
        }
        if ((cntA > IDX_CAP - 128 || cntB > IDX_CAP - 128) && lane == 0) flag[ch % 3] = 1u;
    }
#undef IDX_DMA
    if (!direct) {
        int no;
        if (cntA > TOPK) { idx_prune<true>(lkA, liA, hist, cntA, lane, tauA, smax, hi == 0, no); }
        if (cntB > TOPK) { idx_prune<true>(lkB, liB, hist, cntB, lane, tauB, smax, hi == 1, no); }
#pragma unroll
        for (int i = 0; i < 4; ++i) { SEL[(size_t)t0 * TOPK + lane + 64 * i] = (int)liA[lane + 64 * i]; SEL[(size_t)(t0 + 1) * TOPK + lane + 64 * i] = (int)liB[lane + 64 * i]; }
        if (lane == 0) { int tk = TOPK; asm volatile("" : "+v"(tk)); CNT[t0] = tk; CNT[t0 + 1] = tk; }
    }
}
__device__ __forceinline__ void phase_indexer(const Params& p) {
    extern __shared__ __attribute__((aligned(16))) char smem[];
    const int tid_ = opaque_tid();
    const int wid = __builtin_amdgcn_readfirstlane(tid_ >> 6), lane = tid_ & 63;
    char* wlds = smem + wid * IDX_WAVE_LDS;
    const int gw = blockIdx.x * 8 + wid;
    __syncthreads();
#pragma unroll 1
    for (int rnd = 0; rnd < 2; ++rnd) {
        const int pr = rnd ? gw : 4095 - gw, prmax = rnd ? (int)blockIdx.x * 8 + 7 : 4095 - (int)blockIdx.x * 8;
        idx_round(p, pr, prmax, wlds, wid, lane);
    }
    __syncthreads();
}

__device__ __forceinline__ float softmax_cols16(f32x4 (&S)[16]) {
    float mx = S[0][0];
#pragma unroll
    for (int kb = 0; kb < 16; ++kb)
#pragma unroll
        for (int i = 0; i < 4; ++i) mx = fmaxf(mx, S[kb][i]);
    mx = max_xor16_32(mx);
    const float mneg = -mx * LOG2E;
    float sum = 0.f;
#pragma unroll
    for (int kb = 0; kb < 16; ++kb)
#pragma unroll
        for (int i = 0; i < 4; ++i) { S[kb][i] = __builtin_amdgcn_exp2f(fmaf(S[kb][i], LOG2E, mneg)); sum += S[kb][i]; }
    sum = sum_xor16_32(sum);
    return sum;
}
__device__ __forceinline__ bf16x8 pack_p(const f32x4& a, const f32x4& b) {
    u32x4 w = {cvtpk(a[0], a[1]), cvtpk(a[2], a[3]), cvtpk(b[0], b[1]), cvtpk(b[2], b[3])};
    return *reinterpret_cast<bf16x8*>(&w);
}
#define TRRD16(dst, base, off) asm volatile("ds_read_b64_tr_b16 %0, %1 offset:%2" : "=&v"(dst) : "v"(base), "i"(off) : "memory")

constexpr int SP_KD = 8;
constexpr int SP_WAVE_LDS = 1024 + 2 * 8192;
constexpr int SP_RELB_OFF = 8 * SP_WAVE_LDS;
__device__ __forceinline__ void sp_item(const Params& p, const int t, const int g, char* wl, const float* relb_l, const int lane, const int (&selv)[4], const int cnt) {
    const unsigned char* bktab = (const unsigned char*)(relb_l + 256);
    u16* sel_l = (u16*)wl; unsigned char* bkt_l = (unsigned char*)(wl + 512); char* vtile = wl + 1024;
    const int i16 = lane & 15, c = lane >> 4;
    const __amdgpu_buffer_rsrc_t rs = __builtin_amdgcn_make_buffer_rsrc((void*)(p.ws + WS_KVA), (short)0, 0x7fffffff, 0x00020000);
#pragma unroll
    for (int i = 0; i < 4; ++i) sel_l[lane + 64 * i] = (u16)selv[i];
    int koff[16];
#pragma unroll
    for (int kb = 0; kb < 16; ++kb) koff[kb] = (int)sel_l[16 * kb + i16] * KV_TOK + g * KV_GRP + 32 * c;
    u32x4 kq[SP_KD][2];
#pragma unroll
    for (int kb = 0; kb < SP_KD; ++kb) { kq[kb][0] = __builtin_amdgcn_raw_buffer_load_b128(rs, koff[kb], 0, 0); kq[kb][1] = __builtin_amdgcn_raw_buffer_load_b128(rs, koff[kb] + 16, 0, 0); }
    {
        const int pt = p.positions[t];
        int ps[4];
#pragma unroll
        for (int i = 0; i < 4; ++i) ps[i] = p.positions[selv[i]];
#pragma unroll
        for (int i = 0; i < 4; ++i) { int dist = pt - ps[i]; dist = dist > 0 ? dist : 0; bkt_l[lane + 64 * i] = (dist < 128) ? bktab[dist] : (unsigned char)31; }
    }
    i32x8 qf8;
    { const u16* qp = (const u16*)(p.ws + WS_AQ) + (size_t)t * 1024 + (g * 4 + (i16 & 3)) * 128 + 32 * c;
#pragma unroll
      for (int s = 0; s < 4; ++s) { const u32x4 w = *(const u32x4*)(qp + 8 * s);
          int lo = 0, hi = 0;
          lo = __builtin_amdgcn_cvt_pk_fp8_f32(__uint_as_float(w[0] << 16) * Q8_SCALE, __uint_as_float(w[0] & 0xffff0000u) * Q8_SCALE, lo, false);
          lo = __builtin_amdgcn_cvt_pk_fp8_f32(__uint_as_float(w[1] << 16) * Q8_SCALE, __uint_as_float(w[1] & 0xffff0000u) * Q8_SCALE, lo, true);
          hi = __builtin_amdgcn_cvt_pk_fp8_f32(__uint_as_float(w[2] << 16) * Q8_SCALE, __uint_as_float(w[2] & 0xffff0000u) * Q8_SCALE, hi, false);
          hi = __builtin_amdgcn_cvt_pk_fp8_f32(__uint_as_float(w[3] << 16) * Q8_SCALE, __uint_as_float(w[3] & 0xffff0000u) * Q8_SCALE, hi, true);
          qf8[2 * s] = (i16 < 4) ? lo : 0; qf8[2 * s + 1] = (i16 < 4) ? hi : 0; } }
    f32x4 S[16];
#pragma unroll
    for (int kb = 0; kb < 16; ++kb) {
        const u32x4 k0 = kq[kb % SP_KD][0], k1 = kq[kb % SP_KD][1];
        const i32x8 kf8 = {(int)k0[0], (int)k0[1], (int)k0[2], (int)k0[3], (int)k1[0], (int)k1[1], (int)k1[2], (int)k1[3]};
        S[kb] = __builtin_amdgcn_mfma_scale_f32_16x16x128_f8f6f4(kf8, qf8, (f32x4){0.f, 0.f, 0.f, 0.f}, 0, 0, 0, 0x7f7f7f7f, 0, 0x7f7f7f7f);
        if (kb + SP_KD < 16) { kq[kb % SP_KD][0] = __builtin_amdgcn_raw_buffer_load_b128(rs, koff[kb + SP_KD], 0, 0); kq[kb % SP_KD][1] = __builtin_amdgcn_raw_buffer_load_b128(rs, koff[kb + SP_KD] + 16, 0, 0); }
    }
#define SP_VDMA(u_) do { char* dst_ = vtile + ((u_) & 1) * 8192; \
    _Pragma("unroll") for (int m = 0; m < 8; ++m) { const int kl_ = 8 * (m >> 1) + (i16 >> 1), ch_ = 8 * (m & 1) + 2 * c + (lane & 1); \
        const int tok_ = sel_l[(u_) * 32 + kl_]; \
        __builtin_amdgcn_raw_ptr_buffer_load_lds(rs, (__attribute__((address_space(3))) void*)(dst_ + m * 1024), 16, tok_ * KV_TOK + g * KV_GRP + 128 + ch_ * 16, 0, 0, 0); } } while (0)
    SP_VDMA(0); SP_VDMA(1);
#pragma unroll
    for (int kb = 0; kb < 16; ++kb) {
        const unsigned bw = *(const unsigned*)(bkt_l + 16 * kb + 4 * c);
#pragma unroll
        for (int i = 0; i < 4; ++i) { const int slot = 16 * kb + 4 * c + i; const int b = (bw >> (8 * i)) & 255;
            const float bias = relb_l[b * 8 + g * 4 + (i16 & 3)];
            S[kb][i] = fmaf(S[kb][i], 1.f / (K8_SCALE * Q8_SCALE), bias) + ((slot < cnt) ? 0.f : -INFINITY); }
    }
    const float lsum = softmax_cols16(S);
    f32x4 O[8];
#pragma unroll
    for (int d = 0; d < 8; ++d) O[d] = f32x4{0.f, 0.f, 0.f, 0.f};
    const int vlane = (c >> 1) * 2048 + (c & 1) * 128 + (i16 >> 2) * 32 + (i16 & 3) * 8;
#pragma unroll
    for (int u = 0; u < 8; ++u) {
        if (u < 7) asm volatile("s_waitcnt vmcnt(8)" ::: "memory"); else asm volatile("s_waitcnt vmcnt(0)" ::: "memory");
        const int vb = (int)(uintptr_t)(vtile + (u & 1) * 8192) + vlane;
        const bf16x8 pf = pack_p(S[2 * u], S[2 * u + 1]);
        {
            s16x4 xa[8][2];
#define SP_TR(d0) TRRD16(xa[d0][0], vb, (d0) * 256); TRRD16(xa[d0][1], vb, (d0) * 256 + 4096)
            SP_TR(0); SP_TR(1); SP_TR(2); SP_TR(3); SP_TR(4); SP_TR(5); SP_TR(6); SP_TR(7);
#undef SP_TR
            asm volatile("s_waitcnt lgkmcnt(0)" ::: "memory"); __builtin_amdgcn_sched_barrier(0);
#pragma unroll
            for (int d0 = 0; d0 < 8; ++d0)
                O[d0] = __builtin_amdgcn_mfma_f32_16x16x32_bf16((bf16x8){xa[d0][0][0], xa[d0][0][1], xa[d0][0][2], xa[d0][0][3], xa[d0][1][0], xa[d0][1][1], xa[d0][1][2], xa[d0][1][3]}, pf, O[d0], 0, 0, 0);
        }
#define SP_PV(d0)
#undef SP_PV
        if (u + 2 < 8) SP_VDMA(u + 2);
    }
#undef SP_VDMA
    if (i16 < 4) {
        const float linv = U8_SCALE / lsum;
        const size_t ob = (size_t)t * 1024 + (g * 4 + i16) * 128 + 4 * c;
        const u16* SZ = (const u16*)(p.ws + WS_SZA) + ob; unsigned char* UA = (unsigned char*)(p.ws + WS_UA) + ob;
        u32x2 zws[8];
#pragma unroll
        for (int d = 0; d < 8; ++d) zws[d] = *(const u32x2*)(SZ + d * 16);
#pragma unroll
        for (int d = 0; d < 8; ++d) { const u32x2 zw = zws[d];
            store4_fp8(UA + d * 16, O[d][0] * linv * __uint_as_float(zw[0] << 16), O[d][1] * linv * __uint_as_float(zw[0] & 0xffff0000u),
                        O[d][2] * linv * __uint_as_float(zw[1] << 16), O[d][3] * linv * __uint_as_float(zw[1] & 0xffff0000u)); }
    }
}
__device__ __forceinline__ void phase_sparse_attn(const Params& p) {
    extern __shared__ __attribute__((aligned(16))) char smem[];
    const int tid_ = opaque_tid();
    const int wid = __builtin_amdgcn_readfirstlane(tid_ >> 6), lane = tid_ & 63;
    float* relb_l = (float*)(smem + SP_RELB_OFF);
    __syncthreads();
    if (tid_ < 256) relb_l[tid_] = p.rel_bias[tid_];
    if (tid_ < 32) ((unsigned*)(smem + SP_RELB_OFF + 1024))[tid_] = ((const unsigned*)(p.ws + WS_BKT))[tid_];
    __syncthreads();
    char* wl = smem + wid * SP_WAVE_LDS;
    const int g = blockIdx.x & 1, wg = (blockIdx.x >> 1) * 8 + wid;
    const int* SEL = (const int*)(p.ws + WS_SEL); const int* CNT = (const int*)(p.ws + WS_CNT);
    int seln[4], cntn = CNT[wg];
#pragma unroll
    for (int i = 0; i < 4; ++i) seln[i] = (lane + 64 * i < cntn) ? SEL[(size_t)wg * TOPK + lane + 64 * i] : 0;
#pragma unroll 1
    for (int t = wg; t < SEQ; t += 1024) {
        int selv[4]; const int cnt = cntn;
#pragma unroll
        for (int i = 0; i < 4; ++i) selv[i] = seln[i];
        if (t + 1024 < SEQ) {
            cntn = CNT[t + 1024];
#pragma unroll
            for (int i = 0; i < 4; ++i) seln[i] = SEL[(size_t)(t + 1024) * TOPK + lane + 64 * i];
        }
        sp_item(p, t, g, wl, relb_l, lane, selv, cnt);
    }
    asm volatile("s_waitcnt vmcnt(0)" ::: "memory");
    __syncthreads();
}

constexpr int P4_SP_OFF = 0;
constexpr int P4_RING_OFF = 4 * SP_WAVE_LDS;
constexpr int P4_SP2_OFF = P4_RING_OFF;
constexpr int P4_RELB_OFF = P4_RING_OFF + 81920;
constexpr int P4_BAR_OFF = P4_RELB_OFF + 1024 + 128;
static_assert(4 * SP_WAVE_LDS <= 81920, "the MLA waves' sparse scratch must fit in the ring");
__device__ __forceinline__ void sw_barrier4(unsigned* cnt, const unsigned target, const int lane) {
    asm volatile("s_waitcnt lgkmcnt(0)" ::: "memory");
    if (lane == 0) {
        const int ca = (int)(uintptr_t)cnt; const unsigned one = 1u; unsigned v;
        asm volatile("ds_add_u32 %0, %1" :: "v"(ca), "v"(one) : "memory");
        for (;;) {
            asm volatile("ds_read_b32 %0, %1\n\ts_waitcnt lgkmcnt(0)" : "=v"(v) : "v"(ca) : "memory");
            if (v >= target) break;
        }
    }
    asm volatile("" ::: "memory");
}
constexpr int MLA4_KROW = 208, MLA4_KIMG = 7168, MLA4_TILE = MLA4_KIMG + MLA_VT;
constexpr float MLA4_C2 = LOG2E / (MK8_SCALE * MQ8_SCALE);
#define MLA4_KRD(ka_, s, j) (*(const __attribute__((address_space(3))) u32x4*)((ka_) + (s) * 64 + (j) * 16))
#define MLA4_KF(k0_, k1_) ((i32x8){(int)(k0_)[0], (int)(k0_)[1], (int)(k0_)[2], (int)(k0_)[3], (int)(k1_)[0], (int)(k1_)[1], (int)(k1_)[2], (int)(k1_)[3]})
#define MLA4_MMA(a_, b_, c_) __builtin_amdgcn_mfma_scale_f32_32x32x64_f8f6f4((a_), (b_), (c_), 0, 0, 0, 0x7f7f7f7f, 0, 0x7f7f7f7f)
__device__ __forceinline__ void mla4_qk(const int ka, const i32x8 (&qf)[3], f32x16& pt) {
#pragma unroll
    for (int r = 0; r < 16; ++r) pt[r] = 0.f;
    u32x4 k0[3], k1[3];
#pragma unroll
    for (int s = 0; s < 3; ++s) { k0[s] = MLA4_KRD(ka, s, 0); k1[s] = MLA4_KRD(ka, s, 1); }
#pragma unroll
    for (int s = 0; s < 3; ++s) pt = MLA4_MMA(MLA4_KF(k0[s], k1[s]), qf[s], pt);
}
__device__ __forceinline__ constexpr int mla4_es(int d) { return d <= 0 ? 0 : (d == 1 ? 6 : (d == 2 ? 11 : 16)); }
__device__ __forceinline__ float mla4_rowmax(const f32x16& pt) {
    float a = fmaxf(pt[0], pt[1]), b = fmaxf(pt[2], pt[3]), c = fmaxf(pt[4], pt[5]), d = fmaxf(pt[6], pt[7]);
    a = fmaxf(a, fmaxf(pt[8], pt[9])); b = fmaxf(b, fmaxf(pt[10], pt[11])); c = fmaxf(c, fmaxf(pt[12], pt[13])); d = fmaxf(d, fmaxf(pt[14], pt[15]));
    float pmax = fmaxf(fmaxf(a, b), fmaxf(c, d));
    auto rr = __builtin_amdgcn_permlane32_swap(__float_as_uint(pmax), __float_as_uint(pmax), false, false);
    return fmaxf(__uint_as_float(rr[0]), __uint_as_float(rr[1]));
}
#define MLA4_TRB(off) __builtin_amdgcn_ds_read_tr16_b64_v4i16((__attribute__((address_space(3))) s16x4*)(vt + (off)))
#define MLA4_TRRD(dst, off) asm volatile("ds_read_b64_tr_b16 %0, %1 offset:%2" : "=&v"(dst) : "v"(vt), "i"(off) : "memory")
#define MLA4_TR(d0) MLA4_TRRD(va[d0][0], (d0) * 256); MLA4_TRRD(va[d0][1], (d0) * 256 + 2048); MLA4_TRRD(va[d0][2], (d0) * 256 + 4096); MLA4_TRRD(va[d0][3], (d0) * 256 + 6144)
#define MLA4_PV() do { _Pragma("unroll") for (int d0 = 0; d0 < 4; ++d0) \
        o[d0] = __builtin_amdgcn_mfma_f32_32x32x16_bf16((bf16x8){va[d0][0][0], va[d0][0][1], va[d0][0][2], va[d0][0][3], va[d0][1][0], va[d0][1][1], va[d0][1][2], va[d0][1][3]}, pa[0], o[d0], 0, 0, 0); \
    _Pragma("unroll") for (int d0 = 0; d0 < 4; ++d0) \
        o[d0] = __builtin_amdgcn_mfma_f32_32x32x16_bf16((bf16x8){va[d0][2][0], va[d0][2][1], va[d0][2][2], va[d0][2][3], va[d0][3][0], va[d0][3][1], va[d0][3][2], va[d0][3][3]}, pa[1], o[d0], 0, 0, 0); } while (0)
__device__ __forceinline__ void mla_qblock4(const Params& p, const int h, const int qb, const int wq, const int lane, unsigned* bar, unsigned& bar_k) {
    extern __shared__ __attribute__((aligned(16))) char smem[];
    const int r32 = lane & 31, hi = lane >> 5;
    const int R0 = qb * 128, wrow0 = R0 + wq * 32, qrow = wrow0 + r32;
    const int n_it = 4 * (qb + 1);
    const int n_act = (wrow0 + 31) / 32 + 1;
    const unsigned char* QB = (const unsigned char*)(p.dout + DO_QB) + ((size_t)h * SEQ + qrow) * 192;
    const __amdgpu_buffer_rsrc_t rs = __builtin_amdgcn_make_buffer_rsrc((void*)p.dout, (short)0, 0x7fffffff, 0x00020000);
    i32x8 qf[3];
#pragma unroll
    for (int s = 0; s < 3; ++s) { const u32x4 a = *(const u32x4*)(QB + 64 * s + 32 * hi), b = *(const u32x4*)(QB + 64 * s + 32 * hi + 16);
        qf[s] = MLA4_KF(a, b); }
    int voff[4], pbase[4], pmul[4], pdst[4];
#pragma unroll
    for (int i = 0; i < 4; ++i) {
        const int pc = min(wq * 4 + i, 14);
        pdst[i] = pc * 1024;
        if (pc < 7) { const int L = pc * 64 + lane; int row = L / 13, c = L - row * 13; if (row > 31) { row = 31; c = 12; } if (c > 11) c = 11;
            voff[i] = row * 192 + c * 16; pbase[i] = (int)DO_KB + h * SEQ * 192; pmul[i] = 32 * 192; }
        else { const int o = (pc - 7) * 1024 + lane * 16, sub = o >> 8, ksub = sub >> 2, csub = sub & 3, kq = (o & 255) >> 6, cc = (o & 63) >> 4;
            voff[i] = (ksub * 4 + kq) * 256 + (csub * 4 + cc) * 16; pbase[i] = (int)DO_VB + h * SEQ * 256; pmul[i] = 32 * 256; }
    }
#define MLA4_SLOT(it_) (smem + P4_RING_OFF + ((it_) & 3) * MLA4_TILE)
#define MLA4_DMA(it_) do { char* img_ = MLA4_SLOT(it_); \
    _Pragma("unroll") for (int i = 0; i < 4; ++i) \
        __builtin_amdgcn_raw_ptr_buffer_load_lds(rs, (__attribute__((address_space(3))) void*)(img_ + pdst[i]), 16, voff[i], pbase[i] + (it_) * pmul[i], 0, 0); } while (0)
    const int kal = r32 * MLA4_KROW + 32 * hi;
    const int vlane = hi * 1024 + ((lane & 15) >> 2) * 64 + ((lane >> 4) & 1) * 32 + (lane & 3) * 8;
    f32x16 o[4];
#pragma unroll
    for (int d = 0; d < 4; ++d)
#pragma unroll
        for (int r = 0; r < 16; ++r) o[d][r] = 0.f;
    float m_run = -1e30f, l_run = 0.f;
    asm volatile("s_waitcnt vmcnt(0)" : "+v"(qf[0]), "+v"(qf[1]), "+v"(qf[2]) :: "memory");
    bar_k += 4; sw_barrier4(bar, bar_k, lane);
    MLA4_DMA(0);
    if (n_it > 1) MLA4_DMA(1);
    if (n_it > 2) MLA4_DMA(2);
    if (n_it > 2) asm volatile("s_waitcnt vmcnt(8)" ::: "memory"); else if (n_it > 1) asm volatile("s_waitcnt vmcnt(4)" ::: "memory"); else asm volatile("s_waitcnt vmcnt(0)" ::: "memory");
    bar_k += 4; sw_barrier4(bar, bar_k, lane);
    f32x16 pt;
    mla4_qk((int)(uintptr_t)MLA4_SLOT(0) + kal, qf, pt);
    float pmax = mla4_rowmax(pt);
    for (int it = 0; it < n_it; ++it) {
        if (it + 1 < n_it) {
            if (it + 2 < n_it) asm volatile("s_waitcnt vmcnt(4)" ::: "memory"); else asm volatile("s_waitcnt vmcnt(0)" ::: "memory");
        }
        bar_k += 4; sw_barrier4(bar, bar_k, lane);
        if (it + 3 < n_it) MLA4_DMA(it + 3);
        if (it < n_act) {
            const int key0 = it * 32;
            const int vt = (int)(uintptr_t)(MLA4_SLOT(it) + MLA4_KIMG) + vlane;
            s16x4 va[4][4];
            bf16x8 pa[2];
            if (key0 + 31 > wrow0) {
#pragma unroll
                for (int r = 0; r < 16; ++r) if (key0 + crow16(r, hi) > qrow) pt[r] = -INFINITY;
                pmax = mla4_rowmax(pt);
            }
            if (!__all((pmax - m_run) * MLA4_C2 <= 14.f)) {
                const float mn = fmaxf(m_run, pmax);
                const float alpha = __builtin_amdgcn_exp2f((m_run - mn) * MLA4_C2);
                m_run = mn; l_run *= alpha;
#pragma unroll
                for (int d = 0; d < 4; ++d)
#pragma unroll
                    for (int r = 0; r < 16; ++r) o[d][r] *= alpha;
            }
            {
                const float mneg = -m_run * MLA4_C2;
                const int ka = (int)(uintptr_t)MLA4_SLOT(it + 1) + kal;
                f32x16 ptn;
#pragma unroll
                for (int r = 0; r < 16; ++r) ptn[r] = 0.f;
                float ps = 0.f;
                unsigned pw[8];
                u32x4 k0[3], k1[3];
#pragma unroll
                for (int s = 0; s < 3; ++s) { k0[s] = MLA4_KRD(ka, s, 0); k1[s] = MLA4_KRD(ka, s, 1); }
                __builtin_amdgcn_sched_barrier(0);
#pragma unroll
                for (int d0 = 0; d0 < 3; ++d0) {
                    ptn = MLA4_MMA(MLA4_KF(k0[d0], k1[d0]), qf[d0], ptn);
#pragma unroll
                    for (int e = mla4_es(d0); e < mla4_es(d0 + 1); ++e) { pt[e] = __builtin_amdgcn_exp2f(fmaf(pt[e], MLA4_C2, mneg)); ps += pt[e]; }
#pragma unroll
                    for (int j = mla4_es(d0 - 1) / 2; j < mla4_es(d0) / 2; ++j) pw[j] = cvtpk_b(pt[2 * j], pt[2 * j + 1]);
                    __builtin_amdgcn_sched_barrier(0);
                }
                MLA4_TR(0); MLA4_TR(1); MLA4_TR(2); MLA4_TR(3);
#pragma unroll
                for (int j = mla4_es(2) / 2; j < 8; ++j) pw[j] = cvtpk_b(pt[2 * j], pt[2 * j + 1]);
                { auto rr = __builtin_amdgcn_permlane32_swap(__float_as_uint(ps), __float_as_uint(ps), false, false);
                  ps = __uint_as_float(rr[0]) + __uint_as_float(rr[1]); }
                l_run += ps;
                { u32x4 w0 = {pw[0], pw[1], pw[2], pw[3]}, w1 = {pw[4], pw[5], pw[6], pw[7]};
                  pa[0] = *reinterpret_cast<bf16x8*>(&w0); pa[1] = *reinterpret_cast<bf16x8*>(&w1); }
                asm volatile("s_waitcnt lgkmcnt(0)" ::: "memory"); __builtin_amdgcn_sched_barrier(0);
                MLA4_PV();
                pmax = mla4_rowmax(ptn);
                pt = ptn;
            }
        }
    }
#undef MLA4_DMA
#undef MLA4_SLOT
    {
        const float linv = U8_SCALE / l_run;
        const u16* SZ = (const u16*)(p.ws + WS_SZB) + (size_t)qrow * 1024 + h * 128;
        unsigned char* UB = (unsigned char*)(p.ws + WS_UB) + (size_t)qrow * 1024 + h * 128;
        u32x2 zws[16];
#pragma unroll
        for (int d = 0; d < 4; ++d)
#pragma unroll
            for (int a = 0; a < 4; ++a) zws[d * 4 + a] = *(const u32x2*)(SZ + d * 32 + 8 * a + 4 * hi);
#pragma unroll
        for (int d = 0; d < 4; ++d)
#pragma unroll
            for (int a = 0; a < 4; ++a) {
                const int dim = d * 32 + 8 * a + 4 * hi;
                const u32x2 zw = zws[d * 4 + a];
                store4_fp8(UB + dim, o[d][4 * a + 0] * linv * __uint_as_float(zw[0] << 16), o[d][4 * a + 1] * linv * __uint_as_float(zw[0] & 0xffff0000u),
                           o[d][4 * a + 2] * linv * __uint_as_float(zw[1] << 16), o[d][4 * a + 3] * linv * __uint_as_float(zw[1] & 0xffff0000u));
            }
    }
}
__device__ __forceinline__ void phase_p4(const Params& p) {
    extern __shared__ __attribute__((aligned(16))) char smem[];
    const int tid_ = opaque_tid();
    const int wid = __builtin_amdgcn_readfirstlane(tid_ >> 6), lane = tid_ & 63;
    float* relb_l = (float*)(smem + P4_RELB_OFF);
    unsigned* bar = (unsigned*)(smem + P4_BAR_OFF);
    __syncthreads();
    if (tid_ < 256) relb_l[tid_] = p.rel_bias[tid_];
    if (tid_ < 32) ((unsigned*)(smem + P4_RELB_OFF + 1024))[tid_] = ((const unsigned*)(p.ws + WS_BKT))[tid_];
    if (tid_ == 0) { bar[0] = 0u; bar[1] = 0u; }
    __syncthreads();
    const int g = blockIdx.x & 1, t_lo = (blockIdx.x >> 1) * 4;
    unsigned* qhead = bar + 1;
    char* wl;
    if (wid < 4) {
        unsigned bar_k = 0;
        const int h = blockIdx.x & 7, i = blockIdx.x >> 3;
        mla_qblock4(p, h, 63 - i, wid, lane, bar, bar_k);
        mla_qblock4(p, h, i, wid, lane, bar, bar_k);
        bar_k += 4; sw_barrier4(bar, bar_k, lane);
        wl = smem + P4_SP2_OFF + wid * SP_WAVE_LDS;
    } else wl = smem + P4_SP_OFF + (wid - 4) * SP_WAVE_LDS;
    int lane_s = lane;
    asm volatile("" : "+v"(lane_s));
    {
        const int lane = lane_s;
        const int* SEL = (const int*)(p.ws + WS_SEL); const int* CNT = (const int*)(p.ws + WS_CNT);
#define P4_GRAB(qv) do { unsigned q_ = 0; if (lane == 0) { const int qa_ = (int)(uintptr_t)qhead; const unsigned one_ = 1u;   asm volatile("ds_add_rtn_u32 %0, %1, %2\n\ts_waitcnt lgkmcnt(0)" : "=v"(q_) : "v"(qa_), "v"(one_) : "memory"); } qv = (int)__builtin_amdgcn_readfirstlane(q_); } while (0)
#define P4_TOK(qv) (t_lo + 512 * ((qv) >> 2) + ((qv) & 3))
        int q; P4_GRAB(q);
        int seln[4] = {0, 0, 0, 0}, cntn = 0;
        if (q < 64) { const int t = P4_TOK(q); cntn = CNT[t];
#pragma unroll
            for (int i = 0; i < 4; ++i) seln[i] = (lane + 64 * i < cntn) ? SEL[(size_t)t * TOPK + lane + 64 * i] : 0; }
#pragma unroll 1
        while (q < 64) {
            int selv[4]; const int cnt = cntn; const int t = P4_TOK(q);
#pragma unroll
            for (int i = 0; i < 4; ++i) selv[i] = seln[i];
            int qn; P4_GRAB(qn);
            if (qn < 64) { const int tn = P4_TOK(qn); cntn = CNT[tn];
#pragma unroll
                for (int i = 0; i < 4; ++i) seln[i] = (lane + 64 * i < cntn) ? SEL[(size_t)tn * TOPK + lane + 64 * i] : 0; }
            sp_item(p, t, g, wl, relb_l, lane, selv, cnt);
            q = qn;
        }
#undef P4_GRAB
#undef P4_TOK
    }
    asm volatile("s_waitcnt vmcnt(0)" ::: "memory");
    __syncthreads();
}

__device__ __forceinline__ void phase_mem_attn(const Params& p) {
    extern __shared__ __attribute__((aligned(16))) char smem[];
    const int tid_ = opaque_tid();
    const int wid = __builtin_amdgcn_readfirstlane(tid_ >> 6), lane = tid_ & 63, i16 = lane & 15, c = lane >> 4;
    const int hh = blockIdx.x & 3, q0 = (blockIdx.x >> 2) * 128 + wid * 16;
    const __amdgpu_buffer_rsrc_t rsK = __builtin_amdgcn_make_buffer_rsrc((void*)(p.ws + WS_CK), (short)0, 0x7fffffff, 0x00020000);
    const __amdgpu_buffer_rsrc_t rsV = __builtin_amdgcn_make_buffer_rsrc((void*)(p.ws + WS_CV), (short)0, 0x7fffffff, 0x00020000);
    __syncthreads();
#pragma unroll 4
    for (int m = 0; m < 16; ++m) { const int o = (wid * 16 + m) * 1024 + lane * 16, key = o >> 9, cpos = (o & 511) >> 4;
        const int chunk = (cpos & 16) | ((cpos & 15) ^ (key & 15));
        __builtin_amdgcn_raw_ptr_buffer_load_lds(rsK, (__attribute__((address_space(3))) void*)(smem + (wid * 16 + m) * 1024), 16, key * 2048 + hh * 512 + chunk * 16, 0, 0, 0); }
    bf16x8 qf[8];
    { const u16* qp = (const u16*)(p.ws + WS_CQ) + (size_t)(q0 + i16) * 1024 + hh * 256 + 8 * c;
#pragma unroll
      for (int s = 0; s < 8; ++s) qf[s] = *(const bf16x8*)(qp + 32 * s); }
    asm volatile("s_waitcnt vmcnt(0)" ::: "memory");
    __syncthreads();
    f32x4 S[16];
    {
        int kbase[4];
#pragma unroll
        for (int a = 0; a < 4; ++a) kbase[a] = i16 * 512 + 16 * ((4 * a + c) ^ i16);
#pragma unroll
        for (int kb = 0; kb < 16; ++kb) {
            f32x4 acc = {0.f, 0.f, 0.f, 0.f};
            int kofs = kb * 8192; asm volatile("" : "+v"(kofs));
#pragma unroll
            for (int s = 0; s < 8; ++s) { const bf16x8 kf = *(const bf16x8*)(smem + kofs + kbase[s & 3] + (s >> 2) * 256);
                acc = __builtin_amdgcn_mfma_f32_16x16x32_bf16(kf, qf[s], acc, 0, 0, 0); }
            asm volatile("" : "+v"(acc));
            S[kb] = acc;
        }
    }
    __syncthreads();
#pragma unroll 4
    for (int m = 0; m < 16; ++m) { const int o = (wid * 16 + m) * 1024 + lane * 16, sub = o >> 8, key = (sub >> 4) * 8 + ((o & 255) >> 5), chunk = (sub & 15) * 2 + ((o >> 4) & 1);
        __builtin_amdgcn_raw_ptr_buffer_load_lds(rsV, (__attribute__((address_space(3))) void*)(smem + (wid * 16 + m) * 1024), 16, key * 2048 + hh * 512 + chunk * 16, 0, 0, 0); }
    const float lsum = softmax_cols16(S);
    asm volatile("s_waitcnt vmcnt(0)" ::: "memory");
    __syncthreads();
    f32x4 O[16];
#pragma unroll
    for (int d = 0; d < 16; ++d) O[d] = f32x4{0.f, 0.f, 0.f, 0.f};
    const int vlane = (int)(uintptr_t)smem + (c >> 1) * 4096 + (c & 1) * 128 + (i16 >> 2) * 32 + (i16 & 3) * 8;
#pragma unroll
    for (int u = 0; u < 8; ++u) {
        const int vb = vlane + u * 16384;
        const bf16x8 pf = pack_p(S[2 * u], S[2 * u + 1]);
#pragma unroll
        for (int hb = 0; hb < 2; ++hb) {
            s16x4 xa[8][2];
#define MEM_TR(d0) TRRD16(xa[d0][0], vb, (d0) * 256); TRRD16(xa[d0][1], vb, (d0) * 256 + 8192)
            if (hb == 0) { MEM_TR(0); MEM_TR(1); MEM_TR(2); MEM_TR(3); MEM_TR(4); MEM_TR(5); MEM_TR(6); MEM_TR(7); }
#undef MEM_TR
#define MEM_TR(d0) TRRD16(xa[d0][0], vb, (d0 + 8) * 256); TRRD16(xa[d0][1], vb, (d0 + 8) * 256 + 8192)
            if (hb == 1) { MEM_TR(0); MEM_TR(1); MEM_TR(2); MEM_TR(3); MEM_TR(4); MEM_TR(5); MEM_TR(6); MEM_TR(7); }
#undef MEM_TR
            asm volatile("s_waitcnt lgkmcnt(0)" ::: "memory"); __builtin_amdgcn_sched_barrier(0);
#pragma unroll
            for (int d0 = 0; d0 < 8; ++d0)
                O[hb * 8 + d0] = __builtin_amdgcn_mfma_f32_16x16x32_bf16((bf16x8){xa[d0][0][0], xa[d0][0][1], xa[d0][0][2], xa[d0][0][3], xa[d0][1][0], xa[d0][1][1], xa[d0][1][2], xa[d0][1][3]}, pf, O[hb * 8 + d0], 0, 0, 0);
        }
#define MEM_PV(d0)
#undef MEM_PV
    }
    {
        const float linv = U8_SCALE / lsum;
        const size_t ob = (size_t)(q0 + i16) * 1024 + hh * 256 + 4 * c;
        const u16* SZ = (const u16*)(p.ws + WS_SZC) + ob; unsigned char* UC = (unsigned char*)(p.ws + WS_UC) + ob;
        u32x2 zws[16];
#pragma unroll
        for (int d = 0; d < 16; ++d) zws[d] = *(const u32x2*)(SZ + d * 16);
#pragma unroll
        for (int d = 0; d < 16; ++d) { const u32x2 zw = zws[d];
            store4_fp8(UC + d * 16, O[d][0] * linv * __uint_as_float(zw[0] << 16), O[d][1] * linv * __uint_as_float(zw[0] & 0xffff0000u),
                        O[d][2] * linv * __uint_as_float(zw[1] << 16), O[d][3] * linv * __uint_as_float(zw[1] & 0xffff0000u)); }
    }
    __syncthreads();
}

constexpr int DUP_SEL = 0;
constexpr int MEGA_LDS = IDX_RING_OFF + 49152 + 64;
static_assert(P4_BAR_OFF + 16 <= MEGA_LDS, "phase 4 LDS");

#define XB_TMO      128
#define XB_XCNT(j)  (256  + 64 * (j))
#define XB_XSUB(j)  (1280 + 64 * (j))
#define XB_XGEN(j)  (2304 + 64 * (j))
#define XB_TOP      3328
#define XB_TOPGEN   3392
#define XCD_BAR_WORDS 3456
#define XB_SPIN_CAP (1u << 22)
#define LAS __attribute__((address_space(3)))
constexpr size_t WS_BAR = WS_CNT + 256 * 1024;
__device__ __forceinline__ unsigned xb_ld(unsigned* p)              { return __hip_atomic_load(p, __ATOMIC_RELAXED, __HIP_MEMORY_SCOPE_AGENT); }
__device__ __forceinline__ unsigned xb_add(unsigned* p, unsigned v) { return __hip_atomic_fetch_add(p, v, __ATOMIC_RELAXED, __HIP_MEMORY_SCOPE_AGENT); }
__device__ __forceinline__ unsigned xb_xcc_id() { return (unsigned)__builtin_amdgcn_s_getreg((3 << 11) | 20) & 0xFu; }
#define XB_SPIN(cond, bar) do { unsigned _sp = 0; while (cond) { __builtin_amdgcn_s_sleep(1); \
    if ((++_sp & 255u) == 0u) { if (xb_ld(&(bar)[XB_TMO])) break; if (_sp > XB_SPIN_CAP) { atomicAdd(&(bar)[XB_TMO], 1u); break; } } } } while (0)
struct XcdBarrier { unsigned* bar; unsigned x; volatile LAS unsigned* st; };
__device__ __forceinline__ XcdBarrier xcd_barrier_post(unsigned* bar, volatile LAS unsigned* st) {
    XcdBarrier b; b.bar = bar; b.x = xb_xcc_id(); b.st = st;
    if (threadIdx.x == 0) (void)xb_add(&bar[XB_XCNT(b.x)], 1u);
    return b;
}
__device__ __forceinline__ void xcd_barrier_complete(unsigned* bar, unsigned x, unsigned& nloc, unsigned& nx) {
    const unsigned G = gridDim.x * gridDim.y * gridDim.z;
    unsigned sum, cnt, mine, sp = 0u;
    for (;;) {
        sum = 0u; cnt = 0u; mine = 0u;
#pragma unroll
        for (unsigned j = 0; j < 16; ++j) { const unsigned c = xb_ld(&bar[XB_XCNT(j)]); sum += c; cnt += (c > 0u) ? 1u : 0u; mine = (j == x) ? c : mine; }
        if (sum == G) break;
        __builtin_amdgcn_s_sleep(1);
        if ((++sp & 255u) == 0u) { if (xb_ld(&bar[XB_TMO])) break; if (sp > XB_SPIN_CAP) { atomicAdd(&bar[XB_TMO], 1u); break; } }
    }
    nloc = mine > 0u ? mine : 1u; nx = cnt > 0u ? cnt : 1u;
}
__device__ __forceinline__ void xcd_barrier(const XcdBarrier& b) {
    asm volatile("s_waitcnt vmcnt(0)" ::: "memory");
    __syncthreads();
    if (threadIdx.x == 0) {
        unsigned* bar = b.bar;
        __builtin_amdgcn_s_waitcnt(0);
        unsigned nloc = b.st[0], nx = b.st[1];
        if (nloc == 0u) { xcd_barrier_complete(bar, b.x, nloc, nx); b.st[0] = nloc; b.st[1] = nx; }
        const unsigned old = xb_add(&bar[XB_XSUB(b.x)], 1u);
        const unsigned gen = old / nloc;
        if (old + 1u == (gen + 1u) * nloc) {
            __builtin_amdgcn_fence(__ATOMIC_RELEASE, "agent");
            asm volatile("s_waitcnt vmcnt(0)" ::: "memory");
            const unsigned og = xb_add(&bar[XB_TOP], 1u);
            const unsigned tg = og / nx;
            if (og + 1u == (tg + 1u) * nx) xb_add(&bar[XB_TOPGEN], 1u);
            else XB_SPIN(xb_ld(&bar[XB_TOPGEN]) == tg, bar);
            __builtin_amdgcn_fence(__ATOMIC_ACQUIRE, "agent");
            xb_add(&bar[XB_XGEN(b.x)], 1u);
            asm volatile("s_waitcnt vmcnt(0)" ::: "memory");
        } else {
            XB_SPIN(xb_ld(&bar[XB_XGEN(b.x)]) == gen, bar);
            __builtin_amdgcn_fence(__ATOMIC_ACQUIRE, "agent");
            asm volatile("s_waitcnt vmcnt(0)" ::: "memory");
        }
    }
    __syncthreads();
}

typedef __attribute__((address_space(1))) char gchar_t;
__global__ void __launch_bounds__(512) mega_kernel(Params p_in) {
    extern __shared__ __attribute__((aligned(16))) char smem[];
    volatile LAS unsigned* st = (volatile LAS unsigned*)(smem + MEGA_LDS);
    if (threadIdx.x == 0) { st[0] = 0u; st[1] = 0u; st[2] = 0u; st[3] = 0u; }
    __syncthreads();
    const XcdBarrier xb = xcd_barrier_post((unsigned*)(p_in.ws + WS_BAR), st);
#define RUNP(id, call) do { call; if (DUP_SEL == (id) || (DUP_SEL == 10 && ((id) == 1 || (id) == 3 || (id) == 5 || (id) == 8 || (id) == 9))) { __syncthreads(); call; } } while (0)
#define FRESH_P() Params q = p_in; asm volatile("" : "+s"(q.ws), "+s"(q.dout)); const Params& p = q
    const int lo = p_in.phase_lo, hi = p_in.phase_hi;
    if (lo <= 1 && 1 < hi) { FRESH_P(); RUNP(1, phase_prep(p)); if (2 < hi) xcd_barrier(xb); }
    if (lo <= 2 && 2 < hi) { FRESH_P(); RUNP(2, phase_inproj(p)); if (3 < hi) xcd_barrier(xb); }
    if (lo <= 3 && 3 < hi) { FRESH_P(); RUNP(3, phase_mla_up(p)); RUNP(4, phase_indexer(p)); RUNP(5, phase_mem_attn(p)); if (4 < hi) xcd_barrier(xb); }
    if (lo <= 4 && 4 < hi) { FRESH_P(); RUNP(6, phase_p4(p)); if (5 < hi) xcd_barrier(xb); }
    if (lo <= 5 && 5 < hi) { FRESH_P(); RUNP(8, phase_merge(p)); if (6 < hi) xcd_barrier(xb); }
    if (lo <= 6 && 6 < hi) { FRESH_P(); RUNP(9, phase_out(p)); }
    if (DBG) {
        if (blockIdx.x == 0) {
            __syncthreads();
            const float* dbg = (const float*)(p_in.ws + WS_DBG); float* OUT = (float*)p_in.dout;
            const float y = __hip_atomic_load(&dbg[1], __ATOMIC_RELAXED, __HIP_MEMORY_SCOPE_AGENT), x = __hip_atomic_load(&dbg[0], __ATOMIC_RELAXED, __HIP_MEMORY_SCOPE_AGENT);
            for (int i = threadIdx.x; i < 65536; i += 512) OUT[(size_t)(i >> 8) * DM + (i & 255)] += y;
            __syncthreads();
            if (threadIdx.x == 0) OUT[0] += x;
        }
    }
    if (hi > 100) cooperative_groups::this_grid().sync();
}

extern "C" void kernel_launch(void* const* d_in, const int* in_sizes, int n_in, void* d_out, int out_size, void* d_ws, size_t ws_size,
                              hipStream_t stream) {
    if (ws_size < WS_END) { fprintf(stderr, "ws too small: %zu < %zu\n", ws_size, WS_END); return; }
    const float* x = (const float*)d_in[0];
    const float* mem = (const float*)d_in[1];
    const int* positions = (const int*)d_in[2];
    const float* rel_bias = (const float*)d_in[3];
    const float* norm_g = (const float*)d_in[4];
    const float* mem_norm_g = (const float*)d_in[5];
    const float* w_in = (const float*)d_in[6];
    const float* a_q_norm_g = (const float*)d_in[7];
    const float* a_k_norm_g = (const float*)d_in[8];
    const float* b_q_lat_norm_g = (const float*)d_in[9];
    const float* b_kv_lat_norm_g = (const float*)d_in[10];
    const float* w_b_uq = (const float*)d_in[11];
    const float* w_b_ukv = (const float*)d_in[12];
    const float* b_q_norm_g = (const float*)d_in[13];
    const float* b_k_norm_g = (const float*)d_in[14];
    const float* w_mem_kv = (const float*)d_in[15];
    const float* c_q_norm_g = (const float*)d_in[16];
    const float* c_k_norm_g = (const float*)d_in[17];
    const float* w_branch = (const float*)d_in[18];
    const float* w_out = (const float*)d_in[19];
    char* ws = (char*)d_ws;
    char* dout = (char*)d_out;
    u16* H = (u16*)(ws + WS_H); u16* HM = (u16*)(ws + WS_HM);
    u16* AQ = (u16*)(ws + WS_AQ); u16* KVA = (u16*)(ws + WS_KVA); u16* SZA = (u16*)(ws + WS_SZA);
    u16* IQ = (u16*)(ws + WS_IQ); u16* IK = (u16*)(ws + WS_IK); float* IW = (float*)(ws + WS_IW); float* BKPE = (float*)(ws + WS_BKPE);
    u16* BCQ = (u16*)(ws + WS_BCQ); u16* BCKV = (u16*)(ws + WS_BCKV); u16* SZB = (u16*)(ws + WS_SZB);
    u16* CQ = (u16*)(ws + WS_CQ); u16* SZC = (u16*)(ws + WS_SZC); u16* G = (u16*)(ws + WS_G);
    u16* CK = (u16*)(ws + WS_CK); u16* CV = (u16*)(ws + WS_CV);
    int* SEL = (int*)(ws + WS_SEL); int* CNT = (int*)(ws + WS_CNT);
    float* COS = (float*)(ws + WS_COS); float* SIN = (float*)(ws + WS_SIN);
    u16* UA = (u16*)(ws + WS_UA); u16* UB = (u16*)(ws + WS_UB); u16* UC = (u16*)(ws + WS_UC);
    u16* MERGED = (u16*)(ws + WS_MERGED);
    u16* QB = (u16*)(dout + DO_QB); u16* KB = (u16*)(dout + DO_KB); u16* VB = (u16*)(dout + DO_VB);
    float* RAW = (float*)(ws + WS_TMP_RAW);
    float* MF = (float*)(ws + WS_TMP_MERGEDF);
    float* Y = (float*)d_out;

    static bool attr_done = false;
    if (!attr_done) {
        attr_done = true;
        (void)hipFuncSetAttribute((const void*)nk_attn<192, 128, 64, true>, hipFuncAttributeMaxDynamicSharedMemorySize, 120 * 1024);
        (void)hipFuncSetAttribute((const void*)nk_attn<256, 256, 32, false>, hipFuncAttributeMaxDynamicSharedMemorySize, 120 * 1024);
        (void)hipFuncSetAttribute((const void*)mega_kernel, hipFuncAttributeMaxDynamicSharedMemorySize, MEGA_LDS + 16);
    }
    Params prm{};
    prm.x = x; prm.mem = mem; prm.positions = positions; prm.rel_bias = rel_bias; prm.norm_g = norm_g; prm.mem_norm_g = mem_norm_g;
    prm.w_in = w_in; prm.a_q_norm_g = a_q_norm_g; prm.a_k_norm_g = a_k_norm_g; prm.b_q_lat_norm_g = b_q_lat_norm_g; prm.b_kv_lat_norm_g = b_kv_lat_norm_g;
    prm.w_b_uq = w_b_uq; prm.w_b_ukv = w_b_ukv; prm.b_q_norm_g = b_q_norm_g; prm.b_k_norm_g = b_k_norm_g; prm.w_mem_kv = w_mem_kv;
    prm.c_q_norm_g = c_q_norm_g; prm.c_k_norm_g = c_k_norm_g; prm.w_branch = w_branch; prm.w_out = w_out;
    prm.ws = ws; prm.dout = dout;
#define GEMM(OutT, ACT, A_, lda_, B_, ldb_, C_, ldc_, M_, N_, K_, R_, ldr_) \
    nk_gemm<OutT, ACT><<<dim3(((N_) + 63) / 64, (M_) / 64), 256, 0, stream>>>(A_, lda_, B_, ldb_, C_, ldc_, M_, N_, K_, R_, ldr_)
    prm.phase_lo = 1; prm.phase_hi = 7;
    {
        (void)hipMemsetAsync(ws + WS_BAR, 0, XCD_BAR_WORDS * sizeof(unsigned), stream);
        void* args[] = {&prm};
        hipError_t e = hipLaunchCooperativeKernel((const void*)mega_kernel, dim3(256), dim3(512), args, MEGA_LDS + 16, stream);
        if (e != hipSuccess) fprintf(stderr, "cooperative launch failed: %s\n", hipGetErrorString(e));
    }
#undef GEMM
}
```
